# Optimizing an MI355X kernel written in HIP

```python
import jax
import jax.numpy as jnp
from jax import lax
import numpy as np

D_MODEL = 1024
BATCH = 16
SEQ = 2048
DEPTH = 2
DEC_BATCH = 32
DEC_SEQ = 16
PAST_LEN = 4096

CHUNK = 64
Q_BLOCK = 128
N_EVEN = (DEPTH + 1) // 2
N_ODD = DEPTH // 2
EPS = 1e-6
ROPE_THETA = 10000.0

H_A = 4
DK_A = 64
DV_A = 128
GATE_RANK = 16
GATE_TAU = 16.0
H_B = 4
DK_B = 64
DV_B = 128
IN_AB = 2 * H_A * DK_A + 2 * H_A * DV_A + GATE_RANK + 2 * H_B * DK_B + 2 * H_B * DV_B
MIX_AB = H_A * DV_A + H_B * DV_B
H_C = 8
Q_LORA = 384
KV_LORA = 512
NOPE = 128
ROPE = 64
V_C = 128
IN_C = Q_LORA + KV_LORA + ROPE
D_FF = 2816
CONV_W = 3

kernel_name = "hybrid_gla_retnet_mla_convffn_stream_step"


def split_cols(x, sizes):
    out, start = [], 0
    for s in sizes:
        out.append(x[..., start:start + s])
        start += s
    return out


def rms_norm(x, g):
    xf = x.astype(jnp.float32)
    y = xf * lax.rsqrt(jnp.mean(xf * xf, axis=-1, keepdims=True) + EPS)
    return (y * g.astype(jnp.float32)).astype(x.dtype)


def head_rms_norm(o, g):
    return o * lax.rsqrt(jnp.mean(o * o, axis=-1, keepdims=True) + EPS) * g.astype(jnp.float32)


def head_group_norm(o, g):
    return head_rms_norm(o - jnp.mean(o, axis=-1, keepdims=True), g)


def rope(x, pos):
    half = x.shape[-1] // 2
    freqs = ROPE_THETA ** (-jnp.arange(half, dtype=jnp.float32) / half)
    ang = pos.astype(jnp.float32)[:, None] * freqs[None, :]
    ang = ang.reshape((1, ang.shape[0]) + (1,) * (x.ndim - 3) + (half,))
    cos, sin = jnp.cos(ang), jnp.sin(ang)
    x1 = x[..., :half].astype(jnp.float32)
    x2 = x[..., half:].astype(jnp.float32)
    return jnp.concatenate([x1 * cos - x2 * sin, x1 * sin + x2 * cos], axis=-1).astype(x.dtype)


def decay_linear_attention(q, k, v, log_a, s0):
    B, T, H, K = q.shape
    V = v.shape[-1]
    c = min(CHUNK, T)
    n = T // c
    f32 = jnp.float32
    q = q.astype(f32).reshape(B, n, c, H, K)
    k = k.astype(f32).reshape(B, n, c, H, K)
    v = v.astype(f32).reshape(B, n, c, H, V)
    b = jnp.cumsum(log_a.astype(f32).reshape(B, n, c, H, K), axis=2)
    b_ref = b[:, :, (c - 1) // 2][:, :, None]
    b_last = b[:, :, -1][:, :, None]
    q_rel = q * jnp.exp(b - b_ref)
    k_rel = k * jnp.exp(b_ref - b)
    causal = jnp.tril(jnp.ones((c, c), dtype=bool))
    scores = jnp.where(causal, jnp.einsum('bnthk,bnshk->bnhts', q_rel, k_rel), 0.0)
    o = jnp.einsum('bnhts,bnshv->bnthv', scores, v)
    chunk_kv = jnp.einsum('bnshk,bnshv->bnhkv', k * jnp.exp(b_last - b), v)
    chunk_decay = jnp.exp(b_last[:, :, 0])

    def step(s, inp):
        d, kv_c = inp
        return d[..., None] * s + kv_c, s

    s_final, s_start = lax.scan(step, s0.astype(f32),
                                (jnp.moveaxis(chunk_decay, 1, 0), jnp.moveaxis(chunk_kv, 1, 0)))
    s_start = jnp.moveaxis(s_start, 0, 1)
    o = o + jnp.einsum('bnthk,bnhkv->bnthv', q * jnp.exp(b), s_start)
    return o.reshape(B, T, H, V), s_final


def even_mixer(h, pos, s_gla, s_ret, w_in, w_gate_up, b_gate, g_gla, g_ret, w_out):
    B, T, _ = h.shape
    q_a, k_a, v_a, r_a, lo_a, q_b, k_b, v_b, g_b = split_cols(
        h @ w_in, [H_A * DK_A, H_A * DK_A, H_A * DV_A, H_A * DV_A, GATE_RANK,
                   H_B * DK_B, H_B * DK_B, H_B * DV_B, H_B * DV_B])
    log_a = jax.nn.log_sigmoid((lo_a @ w_gate_up + b_gate).astype(jnp.float32)) / GATE_TAU
    o_a, s_gla_new = decay_linear_attention(
        q_a.reshape(B, T, H_A, DK_A) * DK_A ** -0.5, k_a.reshape(B, T, H_A, DK_A),
        v_a.reshape(B, T, H_A, DV_A), log_a.reshape(B, T, H_A, DK_A), s_gla)
    o_a = head_rms_norm(o_a, g_gla.reshape(H_A, DV_A)) * \
        jax.nn.silu(r_a.astype(jnp.float32)).reshape(B, T, H_A, DV_A)
    qr = rope(q_b.reshape(B, T, H_B, DK_B), pos)
    kr = rope(k_b.reshape(B, T, H_B, DK_B), pos) * DK_B ** -0.5
    log_gamma = jnp.log1p(-jnp.exp2(-5.0 - jnp.arange(H_B, dtype=jnp.float32)))
    log_g = jnp.broadcast_to(log_gamma[:, None], (B, T, H_B, DK_B))
    o_b, s_ret_new = decay_linear_attention(qr, kr, v_b.reshape(B, T, H_B, DV_B), log_g, s_ret)
    o_b = head_group_norm(o_b, g_ret.reshape(H_B, DV_B)) * \
        jax.nn.silu(g_b.astype(jnp.float32)).reshape(B, T, H_B, DV_B)
    mix = jnp.concatenate([o_a.reshape(B, T, -1), o_b.reshape(B, T, -1)], axis=-1).astype(h.dtype)
    return mix @ w_out, s_gla_new, s_ret_new


def mla_attention(q_nope, q_rope, ckv, krope, q_pos, k_pos, w_uk, w_uv):
    B, T, H, _ = q_nope.shape
    qb = min(Q_BLOCK, T)
    nb = T // qb
    k_chunk = k_pos // CHUNK
    scale = (NOPE + ROPE) ** -0.5

    def block(args):
        qn, qr, qp = args
        q_lat = jnp.einsum('bqhn,lhn->bqhl', qn, w_uk)
        s = jnp.einsum('bqhl,bsl->bhqs', q_lat, ckv) + jnp.einsum('bqhr,bsr->bhqs', qr, krope)
        s = s.astype(jnp.float32) * scale
        mask = k_chunk[None, :] <= (qp // CHUNK)[:, None]
        p = jax.nn.softmax(jnp.where(mask, s, -jnp.inf), axis=-1).astype(ckv.dtype)
        o_lat = jnp.einsum('bhqs,bsl->bqhl', p, ckv)
        return jnp.einsum('bqhl,lhv->bqhv', o_lat, w_uv)

    def to_blocks(a):
        return jnp.moveaxis(a.reshape((B, nb, qb) + a.shape[2:]), 1, 0)

    o = lax.map(block, (to_blocks(q_nope), to_blocks(q_rope), q_pos.reshape(nb, qb)))
    return jnp.moveaxis(o, 0, 1).reshape(B, T, H, V_C)


def odd_mixer(h, pos, ckv_past, kr_past, w_in, g_q, g_kv, w_uq, w_uk, w_uv, w_out):
    B, T, _ = h.shape
    cq, ckv, kr = split_cols(h @ w_in, [Q_LORA, KV_LORA, ROPE])
    cq = rms_norm(cq, g_q)
    ckv = rms_norm(ckv, g_kv)
    kr = rope(kr, pos)
    q = (cq @ w_uq).reshape(B, T, H_C, NOPE + ROPE)
    q_nope = q[..., :NOPE]
    q_rope = rope(q[..., NOPE:], pos)
    if ckv_past is None:
        ckv_all, kr_all, k_pos = ckv, kr, pos
    else:
        ckv_all = jnp.concatenate([ckv_past.astype(ckv.dtype), ckv], axis=1)
        kr_all = jnp.concatenate([kr_past.astype(kr.dtype), kr], axis=1)
        k_pos = jnp.concatenate([jnp.arange(ckv_past.shape[1], dtype=jnp.int32), pos])
    o = mla_attention(q_nope, q_rope, ckv_all, kr_all, pos, k_pos, w_uk, w_uv)
    return o.reshape(B, T, H_C * V_C) @ w_out, ckv, kr


def conv_ffn(h, w_in, w_dw, b_dw, w_out, conv_prev):
    T = h.shape[1]
    a, u = split_cols(h @ w_in, [D_FF, D_FF])
    a_full = jnp.concatenate([conv_prev.astype(a.dtype), a], axis=1)
    c = b_dw + a_full[:, 0:T] * w_dw[0]
    for j in range(1, CONV_W):
        c = c + a_full[:, j:j + T] * w_dw[j]
    act = jax.nn.gelu(c.astype(jnp.float32), approximate=False) * u.astype(jnp.float32)
    return act.astype(h.dtype) @ w_out, a_full[:, T:]


def run_trunk(x, pos0, gla0, ret0, ckv_past, kr_past, conv0, w):
    B, T, _ = x.shape
    pos = pos0 + jnp.arange(T, dtype=jnp.int32)
    gla_new, ret_new, ckv_new, kr_new, conv_new = [], [], [], [], []
    for layer in range(DEPTH):
        i = layer // 2
        h = rms_norm(x, w['norm_mix'][layer])
        if layer % 2 == 0:
            s_gla = jnp.zeros((B, H_A, DK_A, DV_A), jnp.float32) if gla0 is None else gla0[i]
            s_ret = jnp.zeros((B, H_B, DK_B, DV_B), jnp.float32) if ret0 is None else ret0[i]
            out, s_gla, s_ret = even_mixer(h, pos, s_gla, s_ret, w['w_in_ab'][i], w['w_gate_up'][i],
                                           w['b_gate'][i], w['g_gla'][i], w['g_ret'][i], w['w_out_ab'][i])
            gla_new.append(s_gla.astype(x.dtype))
            ret_new.append(s_ret.astype(x.dtype))
        else:
            past_c = None if ckv_past is None else ckv_past[i]
            past_r = None if kr_past is None else kr_past[i]
            out, ckv, kr = odd_mixer(h, pos, past_c, past_r, w['w_in_c'][i], w['g_q'][i], w['g_kv'][i],
                                     w['w_uq'][i], w['w_uk'][i], w['w_uv'][i], w['w_out_c'][i])
            ckv_new.append(ckv)
            kr_new.append(kr)
        x = x + out.astype(x.dtype)
        h = rms_norm(x, w['norm_ffn'][layer])
        prev = jnp.zeros((B, CONV_W - 1, D_FF), x.dtype) if conv0 is None else conv0[layer]
        out, conv_rows = conv_ffn(h, w['w_ffn_in'][layer], w['w_dwconv'][layer], w['b_dwconv'][layer],
                                  w['w_ffn_out'][layer], prev)
        x = x + out.astype(x.dtype)
        conv_new.append(conv_rows)
    y = rms_norm(x, w['norm_final'])
    return (y, jnp.stack(gla_new), jnp.stack(ret_new), jnp.stack(ckv_new),
            jnp.stack(kr_new), jnp.stack(conv_new))


def setup_inputs(seed: int = 0) -> dict:
    key = jax.random.key(seed)
    ks = iter(jax.random.split(key, 40))

    def nrm(shape, scale):
        return jax.random.normal(next(ks), shape, jnp.float32) * scale

    def gain(shape):
        return 1.0 + 0.1 * jax.random.normal(next(ks), shape, jnp.float32)

    return {
        'x_prompt': nrm((BATCH, SEQ, D_MODEL), 1.0),
        'x_sample': nrm((DEC_BATCH, DEC_SEQ, D_MODEL), 1.0),
        'state_gla': nrm((N_EVEN, DEC_BATCH, H_A, DK_A, DV_A), 0.5),
        'state_ret': nrm((N_EVEN, DEC_BATCH, H_B, DK_B, DV_B), 1.0),
        'cache_ckv': nrm((N_ODD, DEC_BATCH, PAST_LEN, KV_LORA), 1.0),
        'cache_krope': nrm((N_ODD, DEC_BATCH, PAST_LEN, ROPE), 1.0),
        'state_conv': nrm((DEPTH, DEC_BATCH, CONV_W - 1, D_FF), 1.0),
        'norm_mix': gain((DEPTH, D_MODEL)),
        'norm_ffn': gain((DEPTH, D_MODEL)),
        'norm_final': gain((D_MODEL,)),
        'w_in_ab': nrm((N_EVEN, D_MODEL, IN_AB), D_MODEL ** -0.5),
        'w_gate_up': nrm((N_EVEN, GATE_RANK, H_A * DK_A), GATE_RANK ** -0.5),
        'b_gate': nrm((N_EVEN, H_A * DK_A), 0.1),
        'g_gla': gain((N_EVEN, H_A * DV_A)),
        'g_ret': gain((N_EVEN, H_B * DV_B)),
        'w_out_ab': nrm((N_EVEN, MIX_AB, D_MODEL), MIX_AB ** -0.5),
        'w_in_c': nrm((N_ODD, D_MODEL, IN_C), D_MODEL ** -0.5),
        'g_q': gain((N_ODD, Q_LORA)),
        'g_kv': gain((N_ODD, KV_LORA)),
        'w_uq': nrm((N_ODD, Q_LORA, H_C * (NOPE + ROPE)), Q_LORA ** -0.5),
        'w_uk': nrm((N_ODD, KV_LORA, H_C, NOPE), KV_LORA ** -0.5),
        'w_uv': nrm((N_ODD, KV_LORA, H_C, V_C), KV_LORA ** -0.5),
        'w_out_c': nrm((N_ODD, H_C * V_C, D_MODEL), (H_C * V_C) ** -0.5),
        'w_ffn_in': nrm((DEPTH, D_MODEL, 2 * D_FF), D_MODEL ** -0.5),
        'w_dwconv': nrm((DEPTH, CONV_W, D_FF), CONV_W ** -0.5),
        'b_dwconv': nrm((DEPTH, D_FF), 0.02),
        'w_ffn_out': nrm((DEPTH, D_FF, D_MODEL), D_FF ** -0.5),
    }


def reference(x_prompt, x_sample, state_gla, state_ret, cache_ckv, cache_krope, state_conv,
              norm_mix, norm_ffn, norm_final, w_in_ab, w_gate_up, b_gate, g_gla, g_ret, w_out_ab,
              w_in_c, g_q, g_kv, w_uq, w_uk, w_uv, w_out_c, w_ffn_in, w_dwconv, b_dwconv, w_ffn_out):
    w = {'norm_mix': norm_mix, 'norm_ffn': norm_ffn, 'norm_final': norm_final,
         'w_in_ab': w_in_ab, 'w_gate_up': w_gate_up, 'b_gate': b_gate, 'g_gla': g_gla,
         'g_ret': g_ret, 'w_out_ab': w_out_ab, 'w_in_c': w_in_c, 'g_q': g_q, 'g_kv': g_kv,
         'w_uq': w_uq, 'w_uk': w_uk, 'w_uv': w_uv, 'w_out_c': w_out_c, 'w_ffn_in': w_ffn_in,
         'w_dwconv': w_dwconv, 'b_dwconv': b_dwconv, 'w_ffn_out': w_ffn_out}
    y_prompt, gla_p, ret_p, ckv_p, kr_p, conv_p = run_trunk(
        x_prompt, 0, None, None, None, None, None, w)
    y_sample, gla_s, ret_s, ckv_s, kr_s, conv_s = run_trunk(
        x_sample, PAST_LEN, state_gla, state_ret, cache_ckv, cache_krope, state_conv, w)
    return (y_prompt, y_sample, gla_p, gla_s, ret_p, ret_s, ckv_p, ckv_s, kr_p, kr_s, conv_p, conv_s)
```

```cpp
#include <hip/hip_runtime.h>
#include <hip/hip_cooperative_groups.h>
#include <cstdio>
#include <cstdint>
namespace cg = cooperative_groups;

#ifndef ONE_LAUNCH
#define ONE_LAUNCH 1


#endif

#define LAS __attribute__((address_space(3)))
typedef unsigned short bf16_t;
typedef short bf16x8 __attribute__((ext_vector_type(8)));
typedef float f32x4 __attribute__((ext_vector_type(4)));
typedef float f32x2 __attribute__((ext_vector_type(2)));
typedef unsigned u32x4 __attribute__((ext_vector_type(4)));
typedef unsigned u32x2 __attribute__((ext_vector_type(2)));
typedef __bf16 bf16x2_t __attribute__((ext_vector_type(2)));

__device__ __forceinline__ unsigned cvtpk(float lo, float hi) { f32x2 v = {lo, hi}; bf16x2_t b = __builtin_convertvector(v, bf16x2_t); return __builtin_bit_cast(unsigned, b); }
__device__ __forceinline__ float bf2f(unsigned short h) { return __uint_as_float(((unsigned)h) << 16); }
__device__ __forceinline__ float bflo(unsigned w) { return __uint_as_float(w << 16); }
__device__ __forceinline__ float bfhi(unsigned w) { return __uint_as_float(w & 0xffff0000u); }

constexpr int D = 1024, MP = 32768, MS = 512, M = MP + MS, SEQ = 2048, DSEQ = 16, PAST = 4096;
constexpr int KVS = PAST + DSEQ;
constexpr int NKV = MP + 32 * KVS;
constexpr int NAB = 3328;
constexpr int DFF = 2816;
constexpr float EPS = 1e-6f;
constexpr int NPOS = SEQ + DSEQ;

constexpr size_t O_Y = 0;
constexpr size_t O_GLA_P = (size_t)M * D;
constexpr size_t O_GLA_S = O_GLA_P + 16 * 4 * 64 * 128;
constexpr size_t O_RET_P = O_GLA_S + 32 * 4 * 64 * 128;
constexpr size_t O_RET_S = O_RET_P + 16 * 4 * 64 * 128;
constexpr size_t O_CKV = O_RET_S + 32 * 4 * 64 * 128;
constexpr size_t O_KR = O_CKV + (size_t)M * 512;
constexpr size_t O_CONV_P = O_KR + (size_t)M * 64;
constexpr size_t O_CONV_S = O_CONV_P + 2 * 16 * 2 * DFF;

constexpr size_t MiB = 1u << 20;
constexpr size_t WS_W_INAB = 1 * MiB;
constexpr size_t WS_W_OUTAB = 8 * MiB;
constexpr size_t WS_W_FFNIN = 10 * MiB;
constexpr size_t WS_W_FFNOUT = 32 * MiB;
constexpr size_t WS_W_INC = 43 * MiB;
constexpr size_t WS_W_UQ = 45 * MiB;
constexpr size_t WS_W_UK = 47 * MiB;
constexpr size_t WS_W_UV = 48 * MiB;
constexpr size_t WS_W_OUTC = 49 * MiB;
constexpr size_t WS_ROT = 51 * MiB;
constexpr size_t WS_SSP = 52 * MiB;
constexpr size_t WS_SSQ = 55 * MiB;
constexpr size_t WS_RS = 60 * MiB;
constexpr size_t WS_W_QL = 61 * MiB;
constexpr size_t WS_R = 64 * MiB;
constexpr size_t WS_P = WS_R;
constexpr size_t WS_MIX = WS_R + 212 * MiB;
constexpr int NBLK = MP / 64 + 32;
constexpr size_t WS_SIDEA = WS_R;
constexpr size_t WS_SIDEB = WS_R + 8 * MiB;
constexpr size_t WS_SIDEU = WS_R + 16 * MiB;
constexpr size_t WS_ACT = WS_R + 358 * MiB;
constexpr size_t WS_XB = WS_R + 540 * MiB;
constexpr size_t WS_CKVALL = WS_R;
constexpr size_t WS_AO = WS_R + 430 * MiB;
constexpr size_t WS_CQ = WS_R + 161 * MiB;
constexpr size_t WS_KRALL = WS_R + 186 * MiB;
constexpr size_t WS_Q = WS_R + 207 * MiB;
constexpr size_t WS_KN = WS_R + 305 * MiB;
constexpr size_t WS_VT = WS_R + 626 * MiB;
constexpr size_t WS_QL = WS_R + 370 * MiB;
constexpr size_t WS_PO = WS_R + 380 * MiB;
constexpr size_t WS_PM = WS_R + 420 * MiB;
constexpr size_t WS_PL = WS_R + 421 * MiB;
constexpr size_t WS_END = WS_R + 948 * MiB;
static_assert(WS_END <= 1024 * MiB, "ws map");

constexpr int LDS_BYTES = 147456;

__device__ __forceinline__ int kvtok(int row) { return row < MP ? row : MP + ((row - MP) >> 4) * KVS + PAST + ((row - MP) & 15); }
__device__ __forceinline__ int posidx(int row) { return row < MP ? (row & (SEQ - 1)) : SEQ + ((row - MP) & 15); }

namespace pg8 {
constexpr int BM = 256, BK = 64, HALF = 128, HTB = HALF * BK * 2, STAGE_BYTES = 8 * HTB, NXCD = 8, WGM = 4;
__host__ __device__ __forceinline__ int lds_byte(int r, int c) { const int st = (r >> 4) * 2 + (c >> 5), rr = r & 15, cc = c & 31, ob = rr * 64 + cc * 2; return st * 1024 + (ob ^ (((ob >> 9) & 1) << 5)); }
__host__ __device__ __forceinline__ void stage_rc(int b, int& R, int& C) { const int st = b / 1024, sb = b % 1024, swz = sb ^ (((sb >> 9) & 1) << 5); R = (st >> 1) * 16 + swz / 64; C = (st & 1) * 32 + (swz % 64) / 2; }
__host__ __device__ __forceinline__ int perm32(int rho) { const int n = rho >> 4, i = rho & 15; return 8 * (i >> 2) + 4 * n + (i & 3); }
struct Unit { int pm, pn; };
struct Gemm { const bf16_t* A; const bf16_t* Bt; int M, N, K; };
struct StaticOrder {
    int nM, nN, nwg, G, c, wgm;
    __host__ __device__ void init(int M_, int N_, int G_, int c_, int wgm_ = WGM) { nM = M_ / BM; nN = N_ / BM; nwg = nM * nN; G = G_; c = c_; wgm = wgm_; }
    __host__ __device__ bool next(int i, Unit& u) const {
        const long L = (long)i * G + c; if (L >= nwg) return false;
        int wgid = (int)L; { const int q = nwg / NXCD, r = nwg % NXCD, xcd = wgid % NXCD, off = wgid / NXCD; wgid = (xcd < r ? xcd * (q + 1) : r * (q + 1) + (xcd - r) * q) + off; }
        const int nig = wgm * nN, gid = wgid / nig, fm = gid * wgm, gsz = (nM - fm) < wgm ? (nM - fm) : wgm;
        u.pm = fm + ((wgid % nig) % gsz); u.pn = (wgid % nig) / gsz; return true;
    }
};
template <class Epi>
__device__ __forceinline__ void gemm_phase(LAS unsigned char* lds, const Gemm g, const StaticOrder& S, const Epi& E) {
    int tid_ = threadIdx.x; asm volatile("" : "+v"(tid_));
    const int tid = tid_, wid = __builtin_amdgcn_readfirstlane(tid >> 6), lane = tid & 63, wr = wid >> 2, wc = wid & 3, fr = lane & 15, fq = lane >> 4;
    const int K = g.K, nt = K / BK;
    unsigned voffA[2], voffB[2];
#pragma unroll
    for (int i = 0; i < 2; ++i) { int R, C; stage_rc(tid * 16 + i * 8192, R, C); const int Rb = Epi::PERM ? ((R & ~31) + perm32(R & 31)) : R;
        voffA[i] = (unsigned)(R * K + C) * 2u; voffB[i] = (unsigned)(Rb * K + C) * 2u; }
    const size_t kstep = (size_t)(BK * 2);
    const size_t hstep = (size_t)HALF * K * 2;
    const size_t tstep = 2 * hstep;
    const unsigned ldsw = (unsigned)wid * 1024u;
    const int aoff = lds_byte(wr * 64 + fr, fq * 8), boff = lds_byte(wc * 32 + fr, fq * 8);
#define PG8_SA(b, h) (((b) * 2 + (h)) * HTB)
#define PG8_SB(b, h) ((4 + (b) * 2 + (h)) * HTB)
#define PG8_STAGE(bufoff, gbase, voff) do { _Pragma("unroll") for (int _i = 0; _i < 2; ++_i) \
        __builtin_amdgcn_global_load_lds((const unsigned*)((const char*)(gbase) + (voff)[_i]), (LAS unsigned*)(lds + (bufoff) + ldsw + _i * 8192), 16, 0, 0); } while (0)
#define PG8_LDA(dst, b, h) do { _Pragma("unroll") for (int m = 0; m < 4; ++m) _Pragma("unroll") for (int k = 0; k < 2; ++k) dst[m][k] = *(const LAS bf16x8*)(lds + PG8_SA(b, h) + aoff + m * 2048 + k * 1024); } while (0)
#define PG8_LDB(dst, b, h) do { _Pragma("unroll") for (int n = 0; n < 2; ++n) _Pragma("unroll") for (int k = 0; k < 2; ++k) dst[n][k] = *(const LAS bf16x8*)(lds + PG8_SB(b, h) + boff + n * 2048 + k * 1024); } while (0)
#define PG8_MMA(ai, bj, At, Bt) do { __builtin_amdgcn_s_setprio(1); _Pragma("unroll") for (int m = 0; m < 4; ++m) _Pragma("unroll") for (int n = 0; n < 2; ++n) _Pragma("unroll") for (int k = 0; k < 2; ++k) \
        acc[ai][bj][m][n] = __builtin_amdgcn_mfma_f32_16x16x32_bf16(Bt[n][k], At[m][k], acc[ai][bj][m][n], 0, 0, 0); __builtin_amdgcn_s_setprio(0); } while (0)
#define PG8_WAIT_V(n) asm volatile("s_waitcnt vmcnt(" #n ")" ::: "memory")
#define PG8_WAIT_L(n) asm volatile("s_waitcnt lgkmcnt(" #n ")" ::: "memory")
#define PG8_BAR __builtin_amdgcn_s_barrier()
#define PG8_SCHED __builtin_amdgcn_sched_barrier(0)
    Unit cur, nxt; int ui = 0;
    if (!S.next(0, cur)) return;
    f32x4 acc[2][2][4][2];
#pragma unroll
    for (int a = 0; a < 2; ++a)
#pragma unroll
        for (int b = 0; b < 2; ++b)
#pragma unroll
            for (int m = 0; m < 4; ++m)
#pragma unroll
                for (int n = 0; n < 2; ++n) acc[a][b][m][n] = (f32x4){0.f, 0.f, 0.f, 0.f};
    bf16x8 At[4][2], B0[2][2], B1[2][2];
    const char* cA = (const char*)g.A + (size_t)cur.pm * tstep; const char* cB = (const char*)g.Bt + (size_t)cur.pn * tstep;
    PG8_STAGE(PG8_SB(0, 0), cB, voffB); PG8_STAGE(PG8_SB(0, 1), cB + hstep, voffB); PG8_STAGE(PG8_SA(0, 0), cA, voffA); PG8_STAGE(PG8_SA(0, 1), cA + hstep, voffA);
    if (wr == 1) PG8_BAR;
    PG8_WAIT_V(2); PG8_BAR;
    PG8_STAGE(PG8_SB(1, 0), cB + kstep, voffB); PG8_STAGE(PG8_SA(1, 0), cA + kstep, voffA); PG8_STAGE(PG8_SB(1, 1), cB + hstep + kstep, voffB);
    PG8_WAIT_V(6); PG8_BAR;
    for (;;) {
        const bool has_next = S.next(ui + 1, nxt);
        const char* nA = has_next ? (const char*)g.A + (size_t)nxt.pm * tstep : cA; const char* nB = has_next ? (const char*)g.Bt + (size_t)nxt.pn * tstep : cB;
        for (int t = 0; t < nt; t += 2) {
            const bool last = (t == nt - 2);
            const char* a1 = cA + (size_t)(t + 1) * kstep;
            const char* a2 = last ? nA : cA + (size_t)(t + 2) * kstep; const char* b2 = last ? nB : cB + (size_t)(t + 2) * kstep;
            const char* a3 = a2 + kstep; const char* b3 = b2 + kstep;
            PG8_LDB(B0, 0, 0); PG8_LDB(B1, 0, 1); PG8_SCHED; PG8_LDA(At, 0, 0); PG8_STAGE(PG8_SA(1, 1), a1 + hstep, voffA);
            PG8_WAIT_V(8); PG8_WAIT_L(0); PG8_BAR; PG8_MMA(0, 0, At, B0); PG8_MMA(0, 1, At, B1); PG8_BAR; PG8_SCHED;
            PG8_LDA(At, 0, 1); PG8_STAGE(PG8_SB(0, 0), b2, voffB); PG8_STAGE(PG8_SB(0, 1), b2 + hstep, voffB); PG8_STAGE(PG8_SA(0, 0), a2, voffA);
            PG8_WAIT_V(8); PG8_WAIT_L(0); PG8_BAR; PG8_MMA(1, 0, At, B0); PG8_MMA(1, 1, At, B1); PG8_BAR; PG8_SCHED;
            PG8_LDB(B0, 1, 0); PG8_LDB(B1, 1, 1); PG8_SCHED; PG8_LDA(At, 1, 0); PG8_STAGE(PG8_SA(0, 1), a2 + hstep, voffA);
            PG8_WAIT_V(8); PG8_WAIT_L(0); PG8_BAR; PG8_MMA(0, 0, At, B0); PG8_MMA(0, 1, At, B1); PG8_BAR; PG8_SCHED;
            PG8_LDA(At, 1, 1); PG8_STAGE(PG8_SB(1, 0), b3, voffB); PG8_STAGE(PG8_SB(1, 1), b3 + hstep, voffB); PG8_STAGE(PG8_SA(1, 0), a3, voffA);
            PG8_WAIT_V(8); PG8_WAIT_L(0); PG8_BAR; PG8_MMA(1, 0, At, B0); PG8_MMA(1, 1, At, B1); PG8_BAR; PG8_SCHED;
        }
        if (wr == 0) PG8_BAR;
        E(acc, cur, wr, wc, fr, fq);
        if (!has_next) break;
#pragma unroll
        for (int a = 0; a < 2; ++a)
#pragma unroll
            for (int b = 0; b < 2; ++b)
#pragma unroll
                for (int m = 0; m < 4; ++m)
#pragma unroll
                    for (int n = 0; n < 2; ++n) acc[a][b][m][n] = (f32x4){0.f, 0.f, 0.f, 0.f};
        cur = nxt; cA = nA; cB = nB; ++ui;
        if (wr == 1) PG8_BAR;
    }
    PG8_WAIT_V(0);
    PG8_BAR;
#undef PG8_SA
#undef PG8_SB
#undef PG8_STAGE
#undef PG8_LDA
#undef PG8_LDB
#undef PG8_MMA
#undef PG8_WAIT_V
#undef PG8_WAIT_L
#undef PG8_BAR
#undef PG8_SCHED
}
}

struct Params { const float* in[27]; float* out; unsigned char* ws; int ph_lo, ph_hi; };
enum { I_XP = 0, I_XS, I_SGLA, I_SRET, I_CCKV, I_CKR, I_SCONV, I_NMIX, I_NFFN, I_NFIN, I_WINAB, I_WGU, I_BG, I_GGLA, I_GRET, I_WOUTAB, I_WINC, I_GQ, I_GKV, I_WUQ, I_WUK, I_WUV, I_WOUTC, I_WFFNIN, I_WDW, I_BDW, I_WFFNOUT };

__device__ __forceinline__ float sum4(f32x4 a) { return (a.x + a.y) + (a.z + a.w); }
__device__ __forceinline__ float rstd_from16(const float* ssp, int row) {
    const f32x4* p = (const f32x4*)(ssp + (size_t)row * 16);
    const f32x4 a = p[0], b = p[1], c = p[2], d = p[3];
    const float s = (sum4(a) + sum4(b)) + (sum4(c) + sum4(d));
    return rsqrtf(s * (1.0f / 1024.0f) + EPS);
}
__device__ __forceinline__ f32x4 rope4(f32x4 v, f32x4 cs) { f32x4 r; r.x = v.x * cs.x - v.y * cs.y; r.y = v.x * cs.y + v.y * cs.x; r.z = v.z * cs.z - v.w * cs.w; r.w = v.z * cs.w + v.w * cs.z; return r; }
__device__ __forceinline__ float logsig(float x) { return fminf(x, 0.f) - log1pf(__expf(-fabsf(x))); }

struct EpiBf {
    static constexpr bool PERM = true;
    const Params* pp; int job;
    __device__ __forceinline__ void operator()(const f32x4 (&acc)[2][2][4][2], const pg8::Unit& u, int wr, int wc, int fr, int fq) const {
        const Params* q_ = pp; asm volatile("" : "+s"(q_));
        unsigned char* ws = q_->ws;
        const int MODE = job == 1 ? 2 : (job == 90 || job == 93 || job == 94) ? 3 : 0;
        bf16_t* O = (bf16_t*)(ws + (job == 1 ? WS_P : (job == 90 || job == 94) ? WS_Q : job == 91 ? WS_KN : job == 93 ? WS_QL : WS_VT)) + (job == 94 ? (size_t)MP * 1536 : 0);
        const int ldc = job == 1 ? NAB : (job == 90 || job == 94) ? 1536 : job == 91 ? 1024 : job == 93 ? 4096 : NKV;
        const int rowoff = (job == 93 || job == 94) ? MP : 0;
        const float* ssp = (const float*)(ws + ((job == 90 || job == 93 || job == 94) ? WS_SSQ : WS_SSP));
        const float* rot = (const float*)(ws + WS_ROT);
        const float* bgate = q_->in[I_BG];
        const int row0 = u.pm * 256 + wr * 64 + fr, col0 = u.pn * 256 + wc * 32 + 8 * fq;
        float rsv[2][4];
#pragma unroll
        for (int ai = 0; ai < 2; ++ai) {
#pragma unroll
            for (int m = 0; m < 4; ++m) {
                const int row = row0 + ai * 128 + m * 16;
                float r_ = 1.f;
                if (MODE == 1 || MODE == 2) r_ = rstd_from16(ssp, row);
                if (MODE == 3) { const f32x4* p = (const f32x4*)(ssp + (size_t)(row + rowoff) * 32); const float s = sum4(p[0]) + sum4(p[1]) + sum4(p[2]); r_ = rsqrtf(s * (1.0f / 384.0f) + EPS); }
                rsv[ai][m] = r_;
                if (m & 1) asm volatile("" ::: "memory");
            }
        }
#pragma unroll
        for (int ai = 0; ai < 2; ++ai)
#pragma unroll
            for (int m = 0; m < 4; ++m) {
                const int row = row0 + ai * 128 + m * 16;
                const float rs = rsv[ai][m];
#pragma unroll
                for (int bj = 0; bj < 2; ++bj) {
                    const int col = col0 + bj * 128;
                    f32x4 v0 = acc[ai][bj][m][0] * rs, v1 = acc[ai][bj][m][1] * rs;
                    bool dorope = false; int i0 = 0;
                    if (MODE == 2) { if (u.pn == 6 || u.pn == 7) { dorope = true; i0 = (col & 63) >> 1; } }
                    if (MODE == 3 && job != 93) { const int within = col % 192; if (within >= 128) { dorope = true; i0 = (within - 128) >> 1; } }
                    if (dorope) {
                        const f32x4* cs = (const f32x4*)(rot + ((size_t)posidx(row + rowoff) * 32 + i0) * 2);
                        const f32x4 c0 = cs[0], c1 = cs[1];
                        v0 = rope4(v0, c0);
                        v1 = rope4(v1, c1);
                    }
                    if (MODE == 2) { if (u.pn == 12) {
                        const f32x4 b0 = *(const f32x4*)(bgate + (col - 3072)), b1 = *(const f32x4*)(bgate + (col - 3072) + 4);
                        v0.x = logsig(v0.x + b0.x) * 0.0625f; v0.y = logsig(v0.y + b0.y) * 0.0625f; v0.z = logsig(v0.z + b0.z) * 0.0625f; v0.w = logsig(v0.w + b0.w) * 0.0625f;
                        v1.x = logsig(v1.x + b1.x) * 0.0625f; v1.y = logsig(v1.y + b1.y) * 0.0625f; v1.z = logsig(v1.z + b1.z) * 0.0625f; v1.w = logsig(v1.w + b1.w) * 0.0625f;
                    } }
                    u32x4 w; w.x = cvtpk(v0.x, v0.y); w.y = cvtpk(v0.z, v0.w); w.z = cvtpk(v1.x, v1.y); w.w = cvtpk(v1.z, v1.w);
                    *(u32x4*)(O + (size_t)row * ldc + col) = w;
                }
            }
    }
};

struct EpiRes {
    static constexpr bool PERM = false;
    const Params* pp; int job;
    __device__ __forceinline__ void operator()(const f32x4 (&acc)[2][2][4][2], const pg8::Unit& u, int wr, int wc, int fr, int fq) const {
        const Params* q_ = pp; asm volatile("" : "+s"(q_));
        bf16_t* XB = (bf16_t*)(q_->ws + WS_XB); float* ssp = (float*)(q_->ws + WS_SSP);
        const int row0 = u.pm * 256 + wr * 64 + fr, col0 = u.pn * 256 + wc * 32 + 4 * fq;
#pragma unroll
        for (int ai = 0; ai < 2; ++ai)
#pragma unroll
            for (int m = 0; m < 4; ++m) {
                const int row = row0 + ai * 128 + m * 16;
                float ss = 0.f;
#pragma unroll
                for (int bj = 0; bj < 2; ++bj)
#pragma unroll
                    for (int n = 0; n < 2; ++n) {
                        const int col = col0 + bj * 128 + n * 16;
                        const u32x2 rb = *(const u32x2*)(XB + (size_t)row * D + col);
                        const f32x4 r = (f32x4){bflo(rb.x), bfhi(rb.x), bflo(rb.y), bfhi(rb.y)};
                        const f32x4 x = r + acc[ai][bj][m][n];
                        { u32x2 w; w.x = cvtpk(x.x, x.y); w.y = cvtpk(x.z, x.w); *(u32x2*)(XB + (size_t)row * D + col) = w; }
                        ss += (x.x * x.x + x.y * x.y) + (x.z * x.z + x.w * x.w);
                    }
                ss += __shfl_xor(ss, 16); ss += __shfl_xor(ss, 32);
                if (fq == 0) ssp[(size_t)row * 16 + u.pn * 4 + wc] = ss;
                if (m & 1) asm volatile("" ::: "memory");
            }
    }
};

struct EpiInC {
    static constexpr bool PERM = false;
    const Params* pp;
    __device__ __forceinline__ void operator()(const f32x4 (&acc)[2][2][4][2], const pg8::Unit& u, int wr, int wc, int fr, int fq) const {
        const Params* q_ = pp; asm volatile("" : "+s"(q_));
        unsigned char* ws = q_->ws;
        const float* ssp = (const float*)(ws + WS_SSP); const float* rot = (const float*)(ws + WS_ROT); bf16_t* CQ = (bf16_t*)(ws + WS_CQ);
        bf16_t* CKVALL = (bf16_t*)(ws + WS_CKVALL); float* krout = q_->out + O_KR; bf16_t* KRALL = (bf16_t*)(ws + WS_KRALL); float* ssq = (float*)(ws + WS_SSQ);
        const int row0 = u.pm * 256 + wr * 64 + fr, col0 = u.pn * 256 + wc * 32 + 4 * fq;

#pragma unroll
        for (int ai = 0; ai < 2; ++ai)
#pragma unroll
            for (int m = 0; m < 4; ++m) {
                const int row = row0 + ai * 128 + m * 16;
                const float rs = rstd_from16(ssp, row);
#pragma unroll
                for (int bj = 0; bj < 2; ++bj) {
                    const int blk = u.pn * 2 + bj;
                    float ss = 0.f;
#pragma unroll
                    for (int n = 0; n < 2; ++n) {
                        const int col = col0 + bj * 128 + n * 16;
                        f32x4 v = acc[ai][bj][m][n] * rs;
                        if (blk < 3) {
                            u32x2 w; w.x = cvtpk(v.x, v.y); w.y = cvtpk(v.z, v.w);
                            *(u32x2*)(CQ + (size_t)row * 384 + col) = w;
                        } else if (blk < 7) {
                            u32x2 w; w.x = cvtpk(v.x, v.y); w.y = cvtpk(v.z, v.w);
                            *(u32x2*)(CKVALL + (size_t)kvtok(row) * 512 + (col - 384)) = w;
                        } else if (col < 960) {
                            const int j = col - 896, i0 = j >> 1;
                            const f32x4 cs = *(const f32x4*)(rot + ((size_t)posidx(row) * 32 + i0) * 2);
                            v = rope4(v, cs);
                            float* ko = krout + (size_t)row * 64;
                            ko[i0] = v.x; ko[32 + i0] = v.y; ko[i0 + 1] = v.z; ko[33 + i0] = v.w;
                            u32x2 w; w.x = cvtpk(v.x, v.y); w.y = cvtpk(v.z, v.w);
                            *(u32x2*)(KRALL + (size_t)kvtok(row) * 64 + j) = w;
                        }
                        ss += (v.x * v.x + v.y * v.y) + (v.z * v.z + v.w * v.w);
                    }
                    ss += __shfl_xor(ss, 16); ss += __shfl_xor(ss, 32);
                    if (fq == 0) ssq[(size_t)row * 32 + blk * 4 + wc] = ss;
                }
                asm volatile("" ::: "memory");
            }
    }
};

__device__ __forceinline__ f32x2 gelu_pk(f32x2 v) {
    const f32x2 av = __builtin_elementwise_abs(v), d = av * 0.2316418882f + 1.0f;
    f32x2 t; t.x = __builtin_amdgcn_rcpf(d.x); t.y = __builtin_amdgcn_rcpf(d.y);
    f32x2 q = t * 0.5307027145f + (-0.7265760135f); q = q * t + 0.7107068705f; q = q * t + (-0.142248368f); q = q * t + 0.127414796f; q = q * t;
    const f32x2 sx = (v * v) * (-0.72134752044f);
    f32x2 e; e.x = __builtin_amdgcn_exp2f(sx.x); e.y = __builtin_amdgcn_exp2f(sx.y);
    const f32x2 m = v * (q * e), r = v - m;
    f32x2 o; o.x = v.x < 0.f ? m.x : r.x; o.y = v.y < 0.f ? m.y : r.y; return o;
}
__device__ __forceinline__ void attn_sample_unit(const Params& p, LAS unsigned char* lds, int b, int h) {
    int tid_ = threadIdx.x; asm volatile("" : "+v"(tid_));
    const int tid = tid_, lane = tid & 63, w = tid >> 6, fr = lane & 15, fq = lane >> 4;
    const bf16_t* Q = (const bf16_t*)(p.ws + WS_Q); const bf16_t* KN = (const bf16_t*)(p.ws + WS_KN);
    const bf16_t* KRA = (const bf16_t*)(p.ws + WS_KRALL); const bf16_t* VT = (const bf16_t*)(p.ws + WS_VT);
    bf16_t* AO = (bf16_t*)(p.ws + WS_AO);
    const int qrow0 = MP + b * DSEQ, kv0 = MP + b * KVS;
    bf16x8 qf[6];
#pragma unroll
    for (int ks = 0; ks < 6; ++ks) qf[ks] = *(const bf16x8*)(Q + (size_t)(qrow0 + fr) * 1536 + h * 192 + ks * 32 + fq * 8);
    f32x4 oacc[8];
#pragma unroll
    for (int dt = 0; dt < 8; ++dt) oacc[dt] = (f32x4){0.f, 0.f, 0.f, 0.f};
    float mrun = -1e30f, lrun = 0.f;
    constexpr int NSTEP = (KVS + 31) / 32;
    bf16x8 kf[2][6];
#define SMP_KLOAD(ss) do { const int kb_ = (ss) * 32; \
        _Pragma("unroll") for (int e = 0; e < 2; ++e) { const size_t tok = (size_t)(kv0 + kb_ + e * 16 + fr); \
            _Pragma("unroll") for (int ks = 0; ks < 4; ++ks) kf[e][ks] = *(const bf16x8*)(KN + tok * 1024 + h * 128 + ks * 32 + fq * 8); \
            _Pragma("unroll") for (int ks = 4; ks < 6; ++ks) kf[e][ks] = *(const bf16x8*)(KRA + tok * 64 + (ks - 4) * 32 + fq * 8); } } while (0)
    if (w < NSTEP) SMP_KLOAD(w);
    for (int st = w; st < NSTEP; st += 8) {
        const int kb = st * 32;
        u32x2 va0[8], va1[8];
#pragma unroll
        for (int dt = 0; dt < 8; ++dt) { const bf16_t* vp = VT + (size_t)(h * 128 + dt * 16 + fr) * NKV + kv0 + kb + fq * 4;
            va0[dt] = *(const u32x2*)vp; va1[dt] = *(const u32x2*)(vp + 16); }
        f32x4 s0 = (f32x4){0.f, 0.f, 0.f, 0.f}, s1 = (f32x4){0.f, 0.f, 0.f, 0.f};
#pragma unroll
        for (int ks = 0; ks < 6; ++ks) { s0 = __builtin_amdgcn_mfma_f32_16x16x32_bf16(kf[0][ks], qf[ks], s0, 0, 0, 0); s1 = __builtin_amdgcn_mfma_f32_16x16x32_bf16(kf[1][ks], qf[ks], s1, 0, 0, 0); }
        if (st + 8 < NSTEP) SMP_KLOAD(st + 8);
        if (kb + 32 > KVS) {
#pragma unroll
            for (int j = 0; j < 4; ++j) { if (kb + fq * 4 + j >= KVS) s0[j] = -1e30f; if (kb + 16 + fq * 4 + j >= KVS) s1[j] = -1e30f; }
        }
        float mx = fmaxf(fmaxf(fmaxf(s0[0], s0[1]), fmaxf(s0[2], s0[3])), fmaxf(fmaxf(s1[0], s1[1]), fmaxf(s1[2], s1[3])));
        mx = fmaxf(mx, __shfl_xor(mx, 16)); mx = fmaxf(mx, __shfl_xor(mx, 32));
        const float mnew = fmaxf(mrun, mx), alpha = __builtin_amdgcn_exp2f(mrun - mnew);
        mrun = mnew;
        float ps = 0.f;
#pragma unroll
        for (int j = 0; j < 4; ++j) { s0[j] = __builtin_amdgcn_exp2f(s0[j] - mnew); s1[j] = __builtin_amdgcn_exp2f(s1[j] - mnew); ps += s0[j] + s1[j]; }
        lrun = lrun * alpha + ps;
        u32x4 wv; wv.x = cvtpk(s0[0], s0[1]); wv.y = cvtpk(s0[2], s0[3]); wv.z = cvtpk(s1[0], s1[1]); wv.w = cvtpk(s1[2], s1[3]);
        const bf16x8 pf = __builtin_bit_cast(bf16x8, wv);
#pragma unroll
        for (int dt = 0; dt < 8; ++dt) {
            const bf16x8 vf = __builtin_bit_cast(bf16x8, (u32x4){va0[dt].x, va0[dt].y, va1[dt].x, va1[dt].y});
            oacc[dt] = __builtin_amdgcn_mfma_f32_16x16x32_bf16(vf, pf, oacc[dt] * alpha, 0, 0, 0);
        }
    }
#undef SMP_KLOAD
    { float l = lrun; l += __shfl_xor(l, 16); l += __shfl_xor(l, 32);
      LAS float* OW = (LAS float*)(lds + w * 8192); LAS float* ML = (LAS float*)(lds + 65536 + w * 128);
#pragma unroll
      for (int dt = 0; dt < 8; ++dt)
#pragma unroll
          for (int j = 0; j < 4; ++j) OW[(dt * 16 + fq * 4 + j) * 16 + fr] = oacc[dt][j];
      if (fq == 0) { ML[fr] = mrun; ML[16 + fr] = l; } }
    __syncthreads();
    { const int q = tid & 15, dc = tid >> 4;
      float mw[8], M_ = -1e30f;
#pragma unroll
      for (int ww = 0; ww < 8; ++ww) { mw[ww] = ((LAS float*)(lds + 65536 + ww * 128))[q]; M_ = fmaxf(M_, mw[ww]); }
      float L_ = 0.f, o[4] = {0.f, 0.f, 0.f, 0.f};
#pragma unroll
      for (int ww = 0; ww < 8; ++ww) { const float sc = __builtin_amdgcn_exp2f(mw[ww] - M_); L_ += sc * ((LAS float*)(lds + 65536 + ww * 128))[16 + q];
          const LAS float* OW = (LAS float*)(lds + ww * 8192);
#pragma unroll
          for (int i = 0; i < 4; ++i) o[i] += sc * OW[(dc * 4 + i) * 16 + q]; }
      const float inv = 1.f / L_;
      u32x2 wv; wv.x = cvtpk(o[0] * inv, o[1] * inv); wv.y = cvtpk(o[2] * inv, o[3] * inv);
      *(u32x2*)(AO + (size_t)(qrow0 + q) * D + h * 128 + dc * 4) = wv; }
    __syncthreads();
}

struct EpiFfn {
    static constexpr bool PERM = true;
    const Params* pp; int layer;
    __device__ __forceinline__ void operator()(f32x4 (&acc)[2][2][4][2], const pg8::Unit& u, int wr_, int wc_, int fr_, int fq_) const {
        const Params* q_ = pp; asm volatile("" : "+s"(q_));
        int wr = wr_, wc = wc_, fr = fr_, fq = fq_;
        asm volatile("" : "+s"(wr), "+s"(wc), "+v"(fr), "+v"(fq));
        unsigned char* ws = q_->ws;
        const float* rsp = (const float*)(ws + WS_RS);
        const int row0 = u.pm * 256 + wr * 64 + fr;
#pragma unroll
        for (int ai = 0; ai < 2; ++ai)
#pragma unroll
            for (int m = 0; m < 4; ++m) {
                const float rs = rsp[row0 + ai * 128 + m * 16];
#pragma unroll
                for (int bj = 0; bj < 2; ++bj)
#pragma unroll
                    for (int n = 0; n < 2; ++n) acc[ai][bj][m][n] *= rs;
                if (m & 1) asm volatile("" ::: "memory");
            }
        bf16_t* ACT = (bf16_t*)(ws + WS_ACT); bf16_t* SA = (bf16_t*)(ws + WS_SIDEA); bf16_t* SB = (bf16_t*)(ws + WS_SIDEB); bf16_t* SU = (bf16_t*)(ws + WS_SIDEU);
        const float* wd = q_->in[I_WDW] + (size_t)layer * 3 * DFF; const float* bd = q_->in[I_BDW] + (size_t)layer * DFF;
        const int lane = fq * 16 + fr, src1 = (lane & 48) | ((fr + 15) & 15), src2 = (lane & 48) | ((fr + 14) & 15);
        const bool smp = u.pm * 256 >= MP;
#pragma unroll
        for (int n = 0; n < 2; ++n) {
            asm volatile("" ::: "memory");
            int col = u.pn * 128 + wc * 32 + 8 * fq + 4 * n;
            asm volatile("" : "+v"(col));
            const f32x4 w0 = *(const f32x4*)(wd + col), w1 = *(const f32x4*)(wd + DFF + col), w2 = *(const f32x4*)(wd + 2 * DFF + col), bi = *(const f32x4*)(bd + col);
#pragma unroll
            for (int ai = 0; ai < 2; ++ai) {
                f32x4 pr1 = (f32x4){0.f, 0.f, 0.f, 0.f}, pr2 = pr1;
#pragma unroll
                for (int m = 0; m < 4; ++m) {
                    int row = row0 + ai * 128 + m * 16;
                    asm volatile("" : "+v"(row));
                    const f32x4 a = acc[ai][0][m][n], uu = acc[ai][1][m][n];
                    f32x4 r1, r2;
#pragma unroll
                    for (int e = 0; e < 4; ++e) { r1[e] = __shfl(a[e], src1); r2[e] = __shfl(a[e], src2); }
                    const f32x4 p1 = fr >= 1 ? r1 : pr1, p2 = fr >= 2 ? r2 : pr2;
                    const bool deferred = smp ? (fr < 2) : (m == 0 && fr < 2);
                    const int blk = smp ? (MP / 64 + ((row - MP) >> 4)) : (row >> 6);
                    if (!deferred) {
                        const f32x4 cv = bi + p2 * w0 + p1 * w1 + a * w2;
                        const f32x2 g0 = gelu_pk((f32x2){cv.x, cv.y}), g1 = gelu_pk((f32x2){cv.z, cv.w});
                        u32x2 o; o.x = cvtpk(g0.x * uu.x, g0.y * uu.y); o.y = cvtpk(g1.x * uu.z, g1.y * uu.w);
                        *(u32x2*)(ACT + (size_t)row * DFF + col) = o;
                    } else {
                        u32x2 oa, ou; oa.x = cvtpk(a.x, a.y); oa.y = cvtpk(a.z, a.w); ou.x = cvtpk(uu.x, uu.y); ou.y = cvtpk(uu.z, uu.w);
                        *(u32x2*)(SB + ((size_t)blk * 2 + fr) * DFF + col) = oa; *(u32x2*)(SU + ((size_t)blk * 2 + fr) * DFF + col) = ou;
                    }
                    if (fr >= 14 && (smp || m == 3)) { u32x2 oa; oa.x = cvtpk(a.x, a.y); oa.y = cvtpk(a.z, a.w); *(u32x2*)(SA + ((size_t)blk * 2 + (fr - 14)) * DFF + col) = oa; }
                    pr1 = r1; pr2 = r2;
                    __builtin_amdgcn_sched_barrier(0);
                }
            }
        }
    }
};

template <class F> __device__ __forceinline__ void tr_item(const F& f, int K, bf16_t* WT, int item, int nblk, LAS float* scr, int lane) {
    const int kb = item / nblk, nb = item % nblk, k0 = 64 * kb, n0 = 32 * nb;
#pragma unroll 4
    for (int i = 0; i < 32; ++i) { const int kk = 2 * i + (lane >> 5); scr[kk * 33 + (lane & 31)] = f(k0 + kk, n0 + (lane & 31)); }
    asm volatile("s_waitcnt lgkmcnt(0)" ::: "memory");
    const int c = lane & 7;
#pragma unroll
    for (int j = 0; j < 4; ++j) { const int n = (lane >> 3) + 8 * j; const LAS float* s = scr + (8 * c) * 33 + n;
        u32x4 o; o.x = cvtpk(s[0 * 33], s[1 * 33]); o.y = cvtpk(s[2 * 33], s[3 * 33]); o.z = cvtpk(s[4 * 33], s[5 * 33]); o.w = cvtpk(s[6 * 33], s[7 * 33]);
        *(u32x4*)(WT + (size_t)(n0 + n) * K + k0 + 8 * c) = o; }
    asm volatile("s_waitcnt lgkmcnt(0)" ::: "memory");
}
template <bool FFNPERM = false>
__device__ __forceinline__ void tr_item_plain(const float* W, int ldw, const float* g, int K, bf16_t* WT, int item, int nblk, LAS float* scr, int lane) {
    const int kb = item / nblk, nb = item % nblk, k0 = 64 * kb, n0 = 32 * nb;
    const int c4 = (lane & 7) * 4, kr = lane >> 3;
    const int ns = FFNPERM ? (((n0 & 255) >> 7) * DFF + (n0 >> 8) * 128 + (n0 & 127)) : n0;
#pragma unroll
    for (int i = 0; i < 8; ++i) { const int kk = i * 8 + kr; f32x4 v = *(const f32x4*)(W + (size_t)(k0 + kk) * ldw + ns + c4);
        if (g) v = v * g[k0 + kk];
        scr[kk * 33 + c4] = v.x; scr[kk * 33 + c4 + 1] = v.y; scr[kk * 33 + c4 + 2] = v.z; scr[kk * 33 + c4 + 3] = v.w; }
    asm volatile("s_waitcnt lgkmcnt(0)" ::: "memory");
    const int c = lane & 7;
#pragma unroll
    for (int j = 0; j < 4; ++j) { const int n = (lane >> 3) + 8 * j; const LAS float* s = scr + (8 * c) * 33 + n;
        u32x4 o; o.x = cvtpk(s[0 * 33], s[1 * 33]); o.y = cvtpk(s[2 * 33], s[3 * 33]); o.z = cvtpk(s[4 * 33], s[5 * 33]); o.w = cvtpk(s[6 * 33], s[7 * 33]);
        *(u32x4*)(WT + (size_t)(n0 + n) * K + k0 + 8 * c) = o; }
    asm volatile("s_waitcnt lgkmcnt(0)" ::: "memory");
}
struct FPlain { const float* W; int ldw; const float* g; float sc;
    __device__ __forceinline__ float operator()(int k, int n) const { float v = W[(size_t)k * ldw + n] * sc; if (g) v *= g[k]; return v; } };
struct FInAB { const float* W; const float* g; const float* wgu;
    __device__ __forceinline__ float operator()(int k, int n) const {
        const float* wr = W + (size_t)k * 3088; float v;
        if (n < 1536) { v = wr[n]; if (n < 256) v *= 0.125f; }
        else if (n < 2048) { const int q = n - 1536, isk = q >> 8, r = q & 255, h = r >> 6, j = r & 63, i = j >> 1, hf = j & 1;
            v = wr[(isk ? 1808 : 1552) + h * 64 + hf * 32 + i]; if (isk) v *= 0.125f; }
        else if (n < 3072) { v = wr[n + 16]; }
        else { const int c = n - 3072; float s = 0.f;
#pragma unroll
            for (int r = 0; r < 16; ++r) s += wr[1536 + r] * wgu[r * 256 + c];
            v = s; }
        return v * g[k];
    } };
struct FInC { const float* W; const float* g;
    __device__ __forceinline__ float operator()(int k, int n) const {
        const float* wr = W + (size_t)k * 960; float v;
        if (n < 896) v = wr[n];
        else if (n < 960) { const int j = n - 896; v = wr[896 + (j & 1) * 32 + (j >> 1)]; }
        else v = 0.f;
        return v * g[k];
    } };
struct FUq { const float* W; const float* g; float sc;
    __device__ __forceinline__ float operator()(int k, int n) const {
        const int h = n / 192, j = n % 192; int src = n;
        if (j >= 128) { const int jj = j - 128; src = h * 192 + 128 + (jj & 1) * 32 + (jj >> 1); }
        return W[(size_t)k * 1536 + src] * g[k] * sc;
    } };

struct FQl { const float* wuq; const float* wuk; const float* g; float sc;
    __device__ __forceinline__ float operator()(int k, int n) const {
        const int h = n >> 9, l = n & 511; const float* a = wuq + (size_t)k * 1536 + h * 192; const float* b = wuk + ((size_t)l * 8 + h) * 128;
        float s0 = 0.f, s1 = 0.f;
#pragma unroll 8
        for (int q = 0; q < 128; q += 2) { s0 += a[q] * b[q]; s1 += a[q + 1] * b[q + 1]; }
        return (s0 + s1) * g[k] * sc;
    } };

__device__ __forceinline__ bf16x8 cvt8(const float* p) { const f32x4 a = *(const f32x4*)p, b = *(const f32x4*)(p + 4); u32x4 w; w.x = cvtpk(a.x, a.y); w.y = cvtpk(a.z, a.w); w.z = cvtpk(b.x, b.y); w.w = cvtpk(b.z, b.w); return __builtin_bit_cast(bf16x8, w); }
__device__ __forceinline__ void fold_wql(const Params& p, int vb, int nvb) {
    int tid_ = threadIdx.x; asm volatile("" : "+v"(tid_));
    const int lane = tid_ & 63, wave = tid_ >> 6, fr = lane & 15, fq = lane >> 4;
    const float* wuq = p.in[I_WUQ]; const float* wuk = p.in[I_WUK]; const float* g = p.in[I_GQ];
    bf16_t* WQL = (bf16_t*)(p.ws + WS_W_QL);
    const float sc = 0.07216878364870322f * 1.4426950408889634f;
    for (int it = vb * 8 + wave; it < 8 * 32 * 24; it += nvb * 8) {
        const int h = it / (32 * 24), lt = (it / 24) % 32, kt = it % 24;
        const float* ap = wuk + ((size_t)(lt * 16 + fr) * 8 + h) * 128 + fq * 8;
        const float* bp = wuq + (size_t)(kt * 16 + fr) * 1536 + h * 192 + fq * 8;
        f32x4 acc = (f32x4){0.f, 0.f, 0.f, 0.f};
#pragma unroll
        for (int ks = 0; ks < 4; ++ks) acc = __builtin_amdgcn_mfma_f32_16x16x32_bf16(cvt8(ap + ks * 32), cvt8(bp + ks * 32), acc, 0, 0, 0);
        const int kk = kt * 16 + fr; const float gs = g[kk] * sc;
#pragma unroll
        for (int j = 0; j < 4; ++j) WQL[(size_t)(h * 512 + lt * 16 + fq * 4 + j) * 384 + kk] = (bf16_t)(cvtpk(acc[j] * gs, 0.f) & 0xffff);
    }
}

__device__ __forceinline__ float wave_sum(float v) {
#pragma unroll
    for (int o = 1; o < 64; o <<= 1) v += __shfl_xor(v, o);
    return v;
}

__device__ __forceinline__ void phase_prologue(const Params& p, LAS unsigned char* lds, int which, int vb, int nvb) {
    int tid_ = threadIdx.x; asm volatile("" : "+v"(tid_));
    const int tid = tid_, lane = tid & 63, wave = tid >> 6;
    const int gw = vb * 8 + wave, NGW = nvb * 8;
    LAS float* scr = (LAS float*)(lds + wave * 16384);
    unsigned char* ws = p.ws;
    constexpr int I1 = 16 * (NAB / 32), I2 = 16 * 32, I3 = 16 * (5632 / 32), I4 = 44 * 32, I5 = 16 * 32, I6 = 6 * 48, I7 = 8 * 32, I8 = 8 * 32, I9 = 16 * 32;
    constexpr int NIT = I1 + I2 + 2 * I3 + 2 * I4 + I5 + I6 + I7 + I8 + I9;
    for (int it = gw; it < NIT; it += NGW) {
        int r = it;
        { int cls = it < I1 ? 0 : (it < I1 + I2 ? 3 : 1);
          const int r3 = it - (I1 + I2); if (r3 >= I3 && r3 < 2 * I3) cls = 2;
          const int r4 = r3 - 2 * I3; if (r4 >= I4 && r4 < 2 * I4) cls = 2;
          if (r4 >= 0 && r4 < I4) cls = 3;
          if (!((which >> cls) & 1)) continue; }
        if (r < I1) { FInAB f{p.in[I_WINAB], p.in[I_NMIX], p.in[I_WGU]}; tr_item(f, 1024, (bf16_t*)(ws + WS_W_INAB), r, NAB / 32, scr, lane); continue; } r -= I1;
        if (r < I2) { tr_item_plain(p.in[I_WOUTAB], 1024, nullptr, 1024, (bf16_t*)(ws + WS_W_OUTAB), r, 32, scr, lane); continue; } r -= I2;
        if (r < 2 * I3) { const int l = r / I3; r -= l * I3; tr_item_plain<true>(p.in[I_WFFNIN] + (size_t)l * 1024 * 5632, 5632, p.in[I_NFFN] + l * 1024, 1024, (bf16_t*)(ws + WS_W_FFNIN) + (size_t)l * 5632 * 1024, r, 176, scr, lane); continue; } r -= 2 * I3;
        if (r < 2 * I4) { const int l = r / I4; r -= l * I4; tr_item_plain(p.in[I_WFFNOUT] + (size_t)l * 2816 * 1024, 1024, nullptr, 2816, (bf16_t*)(ws + WS_W_FFNOUT) + (size_t)l * 1024 * 2816, r, 32, scr, lane); continue; } r -= 2 * I4;
        if (r < I5) { FInC f{p.in[I_WINC], p.in[I_NMIX] + 1024}; tr_item(f, 1024, (bf16_t*)(ws + WS_W_INC), r, 32, scr, lane); continue; } r -= I5;
        if (r < I6) { FUq f{p.in[I_WUQ], p.in[I_GQ], 0.07216878364870322f * 1.4426950408889634f}; tr_item(f, 384, (bf16_t*)(ws + WS_W_UQ), r, 48, scr, lane); continue; } r -= I6;
        if (r < I7) { tr_item_plain(p.in[I_WUK], 1024, nullptr, 512, (bf16_t*)(ws + WS_W_UK), r, 32, scr, lane); continue; } r -= I7;
        if (r < I8) { tr_item_plain(p.in[I_WUV], 1024, nullptr, 512, (bf16_t*)(ws + WS_W_UV), r, 32, scr, lane); continue; } r -= I8;
        { tr_item_plain(p.in[I_WOUTC], 1024, nullptr, 1024, (bf16_t*)(ws + WS_W_OUTC), r, 32, scr, lane); }
    }
    if (!(which & 1)) return;
    bf16_t* XB = (bf16_t*)(ws + WS_XB); float* ssp = (float*)(ws + WS_SSP);
    for (int row = gw; row < M; row += NGW) {
        const float* x = row < MP ? p.in[I_XP] + (size_t)row * D : p.in[I_XS] + (size_t)(row - MP) * D;
        float ss = 0.f;
#pragma unroll
        for (int j = 0; j < 4; ++j) { const f32x4 v = *(const f32x4*)(x + j * 256 + lane * 4); ss += (v.x * v.x + v.y * v.y) + (v.z * v.z + v.w * v.w);
            u32x2 w; w.x = cvtpk(v.x, v.y); w.y = cvtpk(v.z, v.w); *(u32x2*)(XB + (size_t)row * D + j * 256 + lane * 4) = w; }
        ss = wave_sum(ss);
        if (lane < 16) ssp[(size_t)row * 16 + lane] = lane == 0 ? ss : 0.f;
    }
    float* rot = (float*)(ws + WS_ROT);
    for (int idx = vb * 512 + tid; idx < NPOS * 32; idx += nvb * 512) {
        const int pi = idx >> 5, i = idx & 31; const double pos = (double)(pi < SEQ ? pi : PAST + (pi - SEQ));
        double fr = 1.0; for (int q = 0; q < i; ++q) fr *= 0.7498942093324559;
        const double ang = pos * fr; const double TWO_PI = 6.283185307179586476925287;
        const double kq = __builtin_rint(ang / TWO_PI); const double r = ang - kq * TWO_PI; const double r2 = r * r;
        double sn = 0.0, cn = 0.0, ts = r, tc = 1.0;
        for (int q = 0; q < 15; ++q) { sn += ts; cn += tc; tc = -tc * r2 / (double)((2 * q + 1) * (2 * q + 2)); ts = -ts * r2 / (double)((2 * q + 2) * (2 * q + 3)); }
        rot[(size_t)idx * 2] = (float)cn; rot[(size_t)idx * 2 + 1] = (float)sn;
    }
}

constexpr int SK = 72;
constexpr int L_QR = 0, L_KR = 9216, L_QD = 18432, L_KD = 27648, L_SC = 36864, L_VT = 46080, L_ST = 64512, L_O = 82944, L_SEG = 116736, L_BREF = 118784, L_BLAST = 119040;
constexpr int OS = 132;

__device__ __forceinline__ bf16x8 ldfrag(const LAS unsigned char* base, int row, int col) { return *(const LAS bf16x8*)(base + (row * SK + col) * 2); }

__device__ __forceinline__ void dla_unit(const Params& p, LAS unsigned char* lds, int u) {
    int tid_ = threadIdx.x; asm volatile("" : "+v"(tid_));
    const int tid = tid_, lane = tid & 63, w = tid >> 6, fr = lane & 15, fq = lane >> 4;
    int mixer, b, h, row0, T, c; const float* s_in; float* s_out;
    if (u < 128) { mixer = u >> 6; b = (u & 63) >> 2; h = u & 3; row0 = b * SEQ; T = SEQ; c = 64; s_in = nullptr;
        s_out = p.out + (mixer ? O_RET_P : O_GLA_P) + (size_t)(b * 4 + h) * 64 * 128; }
    else { const int v = u - 128; mixer = v >> 7; b = (v & 127) >> 2; h = v & 3; row0 = MP + b * DSEQ; T = DSEQ; c = 16;
        s_in = p.in[mixer ? I_SRET : I_SGLA] + (size_t)(b * 4 + h) * 64 * 128;
        s_out = p.out + (mixer ? O_RET_S : O_GLA_S) + (size_t)(b * 4 + h) * 64 * 128; }
    const bf16_t* P = (const bf16_t*)(p.ws + WS_P);
    bf16_t* MIX = (bf16_t*)(p.ws + WS_MIX);
    const int qc = (mixer ? 1536 : 0) + h * 64, kc = (mixer ? 1792 : 256) + h * 64, vc0 = (mixer ? 2048 : 512) + h * 128, gc0 = (mixer ? 2560 : 1024) + h * 128, lac = 3072 + h * 64;
    const float* gn = p.in[mixer ? I_GRET : I_GGLA] + h * 128;
    const float lgam = log1pf(-exp2f(-5.0f - (float)h));
    const int tref = (c - 1) >> 1;
    LAS float* SEG = (LAS float*)(lds + L_SEG); LAS float* BREF = (LAS float*)(lds + L_BREF); LAS float* BLAST = (LAS float*)(lds + L_BLAST);
    LAS float* OL = (LAS float*)(lds + L_O);
    const int kr = w & 3, vt0 = (w >> 2) * 4;
    f32x4 Sacc[4];
#pragma unroll
    for (int i = 0; i < 4; ++i) {
        if (s_in) { for (int j = 0; j < 4; ++j) { const int km = kr * 16 + fq * 4 + j, ko = mixer ? ((km & 1) * 32 + (km >> 1)) : km;
            Sacc[i][j] = s_in[(size_t)ko * 128 + (vt0 + i) * 16 + fr]; } }
        else Sacc[i] = (f32x4){0.f, 0.f, 0.f, 0.f};
    }
    __syncthreads();
#pragma unroll
    for (int i = 0; i < 4; ++i) { u32x2 wv; wv.x = cvtpk(Sacc[i][0], Sacc[i][1]); wv.y = cvtpk(Sacc[i][2], Sacc[i][3]);
        *(LAS u32x2*)(lds + L_ST + (((vt0 + i) * 16 + fr) * SK + kr * 16 + fq * 4) * 2) = wv; }
    const int kcol = lane, seg = w;
    const int nch = T / c;
    unsigned short la_r[8], q_r[8], k_r[8], v_r[16];
    const int vv_ = tid & 127, sg_ = tid >> 7;
#define DLA_LOAD(rr) do { \
        _Pragma("unroll") for (int i = 0; i < 8; ++i) { const int t = seg * 8 + i; const bool ok = t < c; const size_t ro = (size_t)((rr) + (ok ? t : 0)) * NAB; \
            la_r[i] = (ok && !mixer) ? P[ro + lac + kcol] : (unsigned short)0; q_r[i] = ok ? P[ro + qc + kcol] : (unsigned short)0; k_r[i] = ok ? P[ro + kc + kcol] : (unsigned short)0; } \
        _Pragma("unroll") for (int i = 0; i < 16; ++i) { const int s_ = sg_ * 16 + i; v_r[i] = (s_ < c) ? P[(size_t)((rr) + s_) * NAB + vc0 + vv_] : (unsigned short)0; } } while (0)
    DLA_LOAD(row0);
    float gnv[16];
#pragma unroll
    for (int i = 0; i < 16; ++i) gnv[i] = gn[(tid & 7) * 16 + i];
    for (int n = 0; n < nch; ++n) {
        const int r0 = row0 + n * c;
        float bb[8];
        {
            float run = 0.f;
#pragma unroll
            for (int i = 0; i < 8; ++i) { const int t = seg * 8 + i; float la = 0.f;
                if (t < c) la = mixer ? lgam : bf2f(la_r[i]);
                run += la; bb[i] = run; }
            SEG[seg * 64 + kcol] = run;
        }
        __syncthreads();
        {
            float off = 0.f;
            for (int s = 0; s < seg; ++s) off += SEG[s * 64 + kcol];
#pragma unroll
            for (int i = 0; i < 8; ++i) { bb[i] += off; if (seg * 8 + i == tref) BREF[kcol] = bb[i]; if (seg * 8 + i == 63) BLAST[kcol] = bb[i]; }
        }
        __syncthreads();
        {
            const float bref = BREF[kcol], blast = BLAST[kcol];
            float kd[8];
#pragma unroll
            for (int i = 0; i < 8; ++i) { const int t = seg * 8 + i; const float q = bf2f(q_r[i]), k = bf2f(k_r[i]);
                const float e1 = __expf(bb[i] - bref), e2 = __expf(bref - bb[i]), e3 = __expf(bb[i]), e4 = __expf(blast - bb[i]);
                *(LAS bf16_t*)(lds + L_QR + (t * SK + kcol) * 2) = (bf16_t)(cvtpk(q * e1, 0.f) & 0xffff);
                *(LAS bf16_t*)(lds + L_KR + (t * SK + kcol) * 2) = (bf16_t)(cvtpk(k * e2, 0.f) & 0xffff);
                *(LAS bf16_t*)(lds + L_QD + (t * SK + kcol) * 2) = (bf16_t)(cvtpk(q * e3, 0.f) & 0xffff);
                kd[i] = k * e4; }
            u32x4 wv; wv.x = cvtpk(kd[0], kd[1]); wv.y = cvtpk(kd[2], kd[3]); wv.z = cvtpk(kd[4], kd[5]); wv.w = cvtpk(kd[6], kd[7]);
            *(LAS u32x4*)(lds + L_KD + (kcol * SK + seg * 8) * 2) = wv;
            const int v = tid & 127, sg = tid >> 7;
            float vv[16];
#pragma unroll
            for (int i = 0; i < 16; ++i) vv[i] = bf2f(v_r[i]);
            u32x4 w0, w1; w0.x = cvtpk(vv[0], vv[1]); w0.y = cvtpk(vv[2], vv[3]); w0.z = cvtpk(vv[4], vv[5]); w0.w = cvtpk(vv[6], vv[7]);
            w1.x = cvtpk(vv[8], vv[9]); w1.y = cvtpk(vv[10], vv[11]); w1.z = cvtpk(vv[12], vv[13]); w1.w = cvtpk(vv[14], vv[15]);
            *(LAS u32x4*)(lds + L_VT + (v * SK + sg * 16) * 2) = w0; *(LAS u32x4*)(lds + L_VT + (v * SK + sg * 16 + 8) * 2) = w1;
        }
        if (n + 1 < nch) DLA_LOAD(r0 + c);
        u32x4 gate0, gate1;
        { const int tj = tid >> 3, vsj = (tid & 7) * 16; const size_t rowg = (size_t)(r0 + (tj < c ? tj : 0));
          gate0 = *(const u32x4*)(P + rowg * NAB + gc0 + vsj); gate1 = *(const u32x4*)(P + rowg * NAB + gc0 + vsj + 8); }
        __syncthreads();
        {
            const int tr = w & 3;
#pragma unroll
            for (int e = 0; e < 2; ++e) { const int sc = (w >> 2) * 2 + e; f32x4 a = (f32x4){0.f, 0.f, 0.f, 0.f};
#pragma unroll
                for (int ks = 0; ks < 2; ++ks) a = __builtin_amdgcn_mfma_f32_16x16x32_bf16(ldfrag(lds + L_QR, tr * 16 + fr, ks * 32 + fq * 8), ldfrag(lds + L_KR, sc * 16 + fr, ks * 32 + fq * 8), a, 0, 0, 0);
#pragma unroll
                for (int j = 0; j < 4; ++j) { const int t = tr * 16 + fq * 4 + j, s = sc * 16 + fr; const float val = (s <= t) ? a[j] : 0.f;
                    *(LAS bf16_t*)(lds + L_SC + (t * SK + s) * 2) = (bf16_t)(cvtpk(val, 0.f) & 0xffff); } }
        }
        __syncthreads();
        {
            const int tr = w & 3;
#pragma unroll
            for (int i = 0; i < 4; ++i) { const int vt = vt0 + i; f32x4 a = (f32x4){0.f, 0.f, 0.f, 0.f};
#pragma unroll
                for (int ks = 0; ks < 2; ++ks) {
                    a = __builtin_amdgcn_mfma_f32_16x16x32_bf16(ldfrag(lds + L_SC, tr * 16 + fr, ks * 32 + fq * 8), ldfrag(lds + L_VT, vt * 16 + fr, ks * 32 + fq * 8), a, 0, 0, 0);
                    a = __builtin_amdgcn_mfma_f32_16x16x32_bf16(ldfrag(lds + L_QD, tr * 16 + fr, ks * 32 + fq * 8), ldfrag(lds + L_ST, vt * 16 + fr, ks * 32 + fq * 8), a, 0, 0, 0); }
#pragma unroll
                for (int j = 0; j < 4; ++j) OL[(tr * 16 + fq * 4 + j) * OS + vt * 16 + fr] = a[j]; }
            float dec[4];
#pragma unroll
            for (int j = 0; j < 4; ++j) dec[j] = __expf(BLAST[kr * 16 + fq * 4 + j]);
#pragma unroll
            for (int i = 0; i < 4; ++i) { const int vt = vt0 + i; f32x4 a = Sacc[i];
#pragma unroll
                for (int j = 0; j < 4; ++j) a[j] *= dec[j];
#pragma unroll
                for (int ks = 0; ks < 2; ++ks) a = __builtin_amdgcn_mfma_f32_16x16x32_bf16(ldfrag(lds + L_KD, kr * 16 + fr, ks * 32 + fq * 8), ldfrag(lds + L_VT, vt * 16 + fr, ks * 32 + fq * 8), a, 0, 0, 0);
                Sacc[i] = a; }
        }
        __syncthreads();
#pragma unroll
        for (int i = 0; i < 4; ++i) { u32x2 wv; wv.x = cvtpk(Sacc[i][0], Sacc[i][1]); wv.y = cvtpk(Sacc[i][2], Sacc[i][3]);
            *(LAS u32x2*)(lds + L_ST + (((vt0 + i) * 16 + fr) * SK + kr * 16 + fq * 4) * 2) = wv; }
        {
            const int t = tid >> 3, vs = (tid & 7) * 16;
            float o[16]; float s1 = 0.f, s2 = 0.f;
#pragma unroll
            for (int i = 0; i < 16; ++i) { o[i] = OL[t * OS + vs + i]; s1 += o[i]; s2 += o[i] * o[i]; }
            s1 += __shfl_xor(s1, 1); s1 += __shfl_xor(s1, 2); s1 += __shfl_xor(s1, 4);
            s2 += __shfl_xor(s2, 1); s2 += __shfl_xor(s2, 2); s2 += __shfl_xor(s2, 4);
            float mu = 0.f, rs;
            if (mixer) { mu = s1 * (1.f / 128.f); const float var = fmaxf(s2 * (1.f / 128.f) - mu * mu, 0.f); rs = rsqrtf(var + EPS); }
            else rs = rsqrtf(s2 * (1.f / 128.f) + EPS);
            if (t < c) {
                const size_t rowg = (size_t)(r0 + t);
                const unsigned gw[8] = {gate0.x, gate0.y, gate0.z, gate0.w, gate1.x, gate1.y, gate1.z, gate1.w};
                unsigned ow[8];
#pragma unroll
                for (int i = 0; i < 8; ++i) {
                    const float ga = bflo(gw[i]), gb = bfhi(gw[i]);
                    const float ya = (o[2 * i] - mu) * rs * gnv[2 * i] * (ga / (1.f + __expf(-ga)));
                    const float yb = (o[2 * i + 1] - mu) * rs * gnv[2 * i + 1] * (gb / (1.f + __expf(-gb)));
                    ow[i] = cvtpk(ya, yb); }
                bf16_t* mo = MIX + rowg * D + mixer * 512 + h * 128 + vs;
                *(u32x4*)mo = (u32x4){ow[0], ow[1], ow[2], ow[3]}; *(u32x4*)(mo + 8) = (u32x4){ow[4], ow[5], ow[6], ow[7]};
            }
        }
    }
#pragma unroll
    for (int i = 0; i < 4; ++i)
#pragma unroll
        for (int j = 0; j < 4; ++j) { const int km = kr * 16 + fq * 4 + j, ko = mixer ? ((km & 1) * 32 + (km >> 1)) : km;
            s_out[(size_t)ko * 128 + (vt0 + i) * 16 + fr] = Sacc[i][j]; }
    __syncthreads();
}

constexpr int KST = 200;
constexpr int L_AK = 0, L_AV = 64 * KST * 2;

__device__ __forceinline__ void attn_tile(const LAS unsigned char* lds, int kb, int klim, int fr, int fq, const bf16x8 (&qf)[2][6], f32x4 (&oacc)[8][2], float (&mrun)[2], float (&lrun)[2]) {
#pragma unroll 1
        for (int half = 0; half < 2; ++half) {
            const int kb2 = kb + half * 32;
            if (kb2 >= klim) break;
            const bool first0 = mrun[0] < -1e29f, first1 = mrun[1] < -1e29f;
            const float mref0 = first0 ? 0.f : mrun[0], mref1 = first1 ? 0.f : mrun[1];
            f32x4 s[2][2];
#pragma unroll
            for (int e = 0; e < 2; ++e) {
                s[e][0] = (f32x4){-mref0, -mref0, -mref0, -mref0}; s[e][1] = (f32x4){-mref1, -mref1, -mref1, -mref1};
#pragma unroll
                for (int kg = 0; kg < 2; ++kg) {
                    bf16x8 kfr[3];
#pragma unroll
                    for (int k3 = 0; k3 < 3; ++k3) kfr[k3] = *(const LAS bf16x8*)(lds + L_AK + (((half * 2 + e) * 16 + fr) * KST + (kg * 3 + k3) * 32 + fq * 8) * 2);
                    __builtin_amdgcn_sched_barrier(0);
#pragma unroll
                    for (int k3 = 0; k3 < 3; ++k3) {
                        s[e][0] = __builtin_amdgcn_mfma_f32_16x16x32_bf16(kfr[k3], qf[0][kg * 3 + k3], s[e][0], 0, 0, 0);
                        s[e][1] = __builtin_amdgcn_mfma_f32_16x16x32_bf16(kfr[k3], qf[1][kg * 3 + k3], s[e][1], 0, 0, 0); }
                    __builtin_amdgcn_sched_barrier(0);
                }
            }
            if (kb2 + 32 > klim) {
#pragma unroll
                for (int e = 0; e < 2; ++e)
#pragma unroll
                    for (int j = 0; j < 4; ++j) if (kb2 + e * 16 + fq * 4 + j >= klim) { s[e][0][j] = -1e30f; s[e][1][j] = -1e30f; }
            }
            float dl[2];
#pragma unroll
            for (int qt = 0; qt < 2; ++qt) {
                float mx = fmaxf(fmaxf(fmaxf(s[0][qt][0], s[0][qt][1]), fmaxf(s[0][qt][2], s[0][qt][3])), fmaxf(fmaxf(s[1][qt][0], s[1][qt][1]), fmaxf(s[1][qt][2], s[1][qt][3])));
                mx = fmaxf(mx, __shfl_xor(mx, 16)); mx = fmaxf(mx, __shfl_xor(mx, 32));
                dl[qt] = (qt ? first1 : first0) ? mx : fmaxf(mx, 0.f);
            }
            if (__any(dl[0] != 0.f || dl[1] != 0.f)) {
#pragma unroll
                for (int qt = 0; qt < 2; ++qt) {
                    const float alpha = __builtin_amdgcn_exp2f(-dl[qt]);
                    const float al = (qt ? first1 : first0) ? 0.f : alpha;
                    mrun[qt] = (qt ? mref1 : mref0) + dl[qt];
                    lrun[qt] *= al;
#pragma unroll
                    for (int dt = 0; dt < 8; ++dt) oacc[dt][qt] *= al;
#pragma unroll
                    for (int e = 0; e < 2; ++e)
#pragma unroll
                        for (int j = 0; j < 4; ++j) s[e][qt][j] -= dl[qt];
                }
            }
            bf16x8 pf[2];
#pragma unroll
            for (int qt = 0; qt < 2; ++qt) {
                float ps = 0.f;
#pragma unroll
                for (int e = 0; e < 2; ++e)
#pragma unroll
                    for (int j = 0; j < 4; ++j) { const float ex = __builtin_amdgcn_exp2f(s[e][qt][j]); s[e][qt][j] = ex; ps += ex; }
                lrun[qt] += ps;
                u32x4 wv;
                wv.x = cvtpk(s[0][qt][0], s[0][qt][1]); wv.y = cvtpk(s[0][qt][2], s[0][qt][3]);
                wv.z = cvtpk(s[1][qt][0], s[1][qt][1]); wv.w = cvtpk(s[1][qt][2], s[1][qt][3]);
                pf[qt] = __builtin_bit_cast(bf16x8, wv);
            }
#pragma unroll
            for (int dg = 0; dg < 2; ++dg) {
                u32x2 va0[4], va1[4];
#pragma unroll
                for (int d4 = 0; d4 < 4; ++d4) { const int dt = dg * 4 + d4;
                    va0[d4] = *(const LAS u32x2*)(lds + L_AV + ((dt * 16 + fr) * SK + half * 32 + fq * 4) * 2);
                    va1[d4] = *(const LAS u32x2*)(lds + L_AV + ((dt * 16 + fr) * SK + half * 32 + 16 + fq * 4) * 2); }
                __builtin_amdgcn_sched_barrier(0);
#pragma unroll
                for (int d4 = 0; d4 < 4; ++d4) { const int dt = dg * 4 + d4;
                    const bf16x8 vf = __builtin_bit_cast(bf16x8, (u32x4){va0[d4].x, va0[d4].y, va1[d4].x, va1[d4].y});
                    oacc[dt][0] = __builtin_amdgcn_mfma_f32_16x16x32_bf16(vf, pf[0], oacc[dt][0], 0, 0, 0);
                    oacc[dt][1] = __builtin_amdgcn_mfma_f32_16x16x32_bf16(vf, pf[1], oacc[dt][1], 0, 0, 0); }
                __builtin_amdgcn_sched_barrier(0);
            }
        }
}

__device__ __forceinline__ void attn_unit(const Params& p, LAS unsigned char* lds, int qrow0, int nqv, int kv0, int nkeys_unit, int h, bool causal) {
    int tid_ = threadIdx.x; asm volatile("" : "+v"(tid_));
    const int tid = tid_, lane = tid & 63, w = tid >> 6, fr = lane & 15, fq = lane >> 4;
    const bf16_t* Q = (const bf16_t*)(p.ws + WS_Q); const bf16_t* KN = (const bf16_t*)(p.ws + WS_KN);
    const bf16_t* KRA = (const bf16_t*)(p.ws + WS_KRALL); const bf16_t* VT = (const bf16_t*)(p.ws + WS_VT);
    bf16_t* AO = (bf16_t*)(p.ws + WS_AO);
    const int klim = causal ? 64 * ((w >> 1) + 1) + (nkeys_unit - 256) : nkeys_unit;
    const bool active = (w * 32) < nqv;
    bf16x8 qf[2][6];
#pragma unroll
    for (int qt = 0; qt < 2; ++qt) { int qi = w * 32 + qt * 16 + fr; if (qi >= nqv) qi = 0;
#pragma unroll
        for (int ks = 0; ks < 6; ++ks) qf[qt][ks] = *(const bf16x8*)(Q + (size_t)(qrow0 + qi) * 1536 + h * 192 + ks * 32 + fq * 8); }
    f32x4 oacc[8][2];
#pragma unroll
    for (int dt = 0; dt < 8; ++dt) { oacc[dt][0] = (f32x4){0.f, 0.f, 0.f, 0.f}; oacc[dt][1] = (f32x4){0.f, 0.f, 0.f, 0.f}; }
    float mrun[2] = {-1e30f, -1e30f}, lrun[2] = {0.f, 0.f};
    const int ntile = (nkeys_unit + 63) >> 6;
    u32x4 kregA[3], vregA[2];
#define ATT_LOAD(KR_, VR_, tt) do { const int kb_ = (tt) * 64; \
        _Pragma("unroll") for (int i = 0; i < 3; ++i) { const int ch = tid + i * 512, r = ch / 24, cc = ch % 24; const size_t tok = (size_t)(kv0 + kb_ + r); \
            KR_[i] = (cc < 16) ? *(const u32x4*)(KN + tok * 1024 + h * 128 + cc * 8) : *(const u32x4*)(KRA + tok * 64 + (cc - 16) * 8); } \
        _Pragma("unroll") for (int i = 0; i < 2; ++i) { const int ch = tid + i * 512, r = ch >> 3, cc = ch & 7; \
            VR_[i] = *(const u32x4*)(VT + (size_t)(h * 128 + r) * NKV + kv0 + kb_ + cc * 8); } } while (0)
#define ATT_STORE(KR_, VR_) do { \
        _Pragma("unroll") for (int i = 0; i < 3; ++i) { const int ch = tid + i * 512, r = ch / 24, cc = ch % 24; *(LAS u32x4*)(lds + L_AK + (r * KST + cc * 8) * 2) = KR_[i]; } \
        _Pragma("unroll") for (int i = 0; i < 2; ++i) { const int ch = tid + i * 512, r = ch >> 3, cc = ch & 7; *(LAS u32x4*)(lds + L_AV + (r * SK + cc * 8) * 2) = VR_[i]; } } while (0)
#define ATT_BAR() asm volatile("s_waitcnt lgkmcnt(0)\n\ts_barrier" ::: "memory")
    u32x4 kregB[3], vregB[2];
    ATT_LOAD(kregA, vregA, 0);
    if (ntile > 1) ATT_LOAD(kregB, vregB, 1);
    for (int t = 0; t < ntile; t += 2) {
        ATT_BAR();
        ATT_STORE(kregA, vregA);
        ATT_BAR();
        if (t + 2 < ntile) ATT_LOAD(kregA, vregA, t + 2);
        if (active && t * 64 < klim) attn_tile(lds, t * 64, klim, fr, fq, qf, oacc, mrun, lrun);
        if (t + 1 < ntile) {
            ATT_BAR();
            ATT_STORE(kregB, vregB);
            ATT_BAR();
            if (t + 3 < ntile) ATT_LOAD(kregB, vregB, t + 3);
            if (active && (t + 1) * 64 < klim) attn_tile(lds, (t + 1) * 64, klim, fr, fq, qf, oacc, mrun, lrun);
        }
    }
    if (active) {
#pragma unroll
        for (int qt = 0; qt < 2; ++qt) {
            float l = lrun[qt]; l += __shfl_xor(l, 16); l += __shfl_xor(l, 32);
            const float inv = 1.f / l; const int qi = w * 32 + qt * 16 + fr;
            if (qi < nqv) {
#pragma unroll
                for (int dt = 0; dt < 8; ++dt) { u32x2 wv; wv.x = cvtpk(oacc[dt][qt][0] * inv, oacc[dt][qt][1] * inv); wv.y = cvtpk(oacc[dt][qt][2] * inv, oacc[dt][qt][3] * inv);
                    *(u32x2*)(AO + (size_t)(qrow0 + qi) * D + h * 128 + dt * 16 + fq * 4) = wv; }
            }
        }
    }
    __syncthreads();
}

constexpr int LKS = 584;
constexpr int LVS = 40;
constexpr int LKT = 5 * 512 * 16;
constexpr int L_LK = 0, L_LV = 3 * LKT;
constexpr int KSPLIT = KVS / 4;
__device__ __forceinline__ void attn_latent_unit(const Params& p, LAS unsigned char* lds, int b, int dh, int ks) {
    int tid_ = threadIdx.x; asm volatile("" : "+v"(tid_));
    const int tid = tid_, lane = tid & 63, fr = lane & 15, fq = lane >> 4;
    const int w = __builtin_amdgcn_readfirstlane(tid >> 6);
    const bf16_t* CK = (const bf16_t*)(p.ws + WS_CKVALL); const bf16_t* KRA = (const bf16_t*)(p.ws + WS_KRALL);
    const bf16_t* QL = (const bf16_t*)(p.ws + WS_QL); const bf16_t* Q = (const bf16_t*)(p.ws + WS_Q);
    float* PO = (float*)(p.ws + WS_PO); float* PM = (float*)(p.ws + WS_PM); float* PL = (float*)(p.ws + WS_PL);
    const int kv0 = MP + b * KVS + ks * KSPLIT;
    bf16x8 qf[18];
#pragma unroll
    for (int kq = 0; kq < 16; ++kq) qf[kq] = *(const bf16x8*)(QL + (size_t)(b * 16 + fr) * 4096 + w * 512 + kq * 32 + fq * 8);
#pragma unroll
    for (int kq = 16; kq < 18; ++kq) qf[kq] = *(const bf16x8*)(Q + (size_t)(MP + b * 16 + fr) * 1536 + w * 192 + 128 + (kq - 16) * 32 + fq * 8);
    f32x4 oacc[16];
#pragma unroll
    for (int dt = 0; dt < 16; ++dt) oacc[dt] = (f32x4){0.f, 0.f, 0.f, 0.f};
    float mrun = -1e30f, lrun = 0.f;
    constexpr int NST = (KSPLIT + 31) / 32;
#define LAT_DMA(ss, bufi) do { _Pragma("unroll") for (int i = 0; i < 5; ++i) { const int slot = i * 512 + tid; int r = slot / 73, cc = slot % 73; if (r > 31) { r = 31; cc = 0; } if (cc > 71) cc = 0; \
            const size_t tok = (size_t)(kv0 + (ss) * 32 + r); const bf16_t* src = (cc < 64) ? CK + tok * 512 + cc * 8 : KRA + tok * 64 + (cc - 64) * 8; \
            __builtin_amdgcn_global_load_lds((const unsigned*)src, (LAS unsigned*)(lds + L_LK + (bufi) * LKT + (i * 512 + w * 64) * 16), 16, 0, 0); } } while (0)
    LAT_DMA(0, 0);
    LAT_DMA(1, 1);
    int bufc = 0, bufn = 2;
    for (int st = 0; st < NST; ++st) {
        if (st + 1 < NST) asm volatile("s_waitcnt vmcnt(5) lgkmcnt(0)\n\ts_barrier" ::: "memory");
        else asm volatile("s_waitcnt vmcnt(0) lgkmcnt(0)\n\ts_barrier" ::: "memory");
        if (st + 2 < NST) LAT_DMA(st + 2, bufn);
        const LAS unsigned char* kt = lds + L_LK + bufc * LKT;
#pragma unroll
        for (int ps_ = 0; ps_ < 2; ++ps_) {
            const int r = tid & 31, c32 = (tid >> 5) + ps_ * 16;
            const u32x4 v = *(const LAS u32x4*)(kt + (r * LKS + dh * 256 + c32 * 8) * 2);
            const unsigned ww[4] = {v.x, v.y, v.z, v.w};
#pragma unroll
            for (int e = 0; e < 4; ++e) { *(LAS bf16_t*)(lds + L_LV + ((c32 * 8 + 2 * e) * LVS + r) * 2) = (bf16_t)(ww[e] & 0xffffu); *(LAS bf16_t*)(lds + L_LV + ((c32 * 8 + 2 * e + 1) * LVS + r) * 2) = (bf16_t)(ww[e] >> 16); }
        }
        asm volatile("s_waitcnt lgkmcnt(0)\n\ts_barrier" ::: "memory");
        const int kb = st * 32;
        f32x4 s0 = (f32x4){0.f, 0.f, 0.f, 0.f}, s1 = (f32x4){0.f, 0.f, 0.f, 0.f};
#pragma unroll
        for (int kg = 0; kg < 9; ++kg) {
            bf16x8 k0[2], k1[2];
#pragma unroll
            for (int k3 = 0; k3 < 2; ++k3) { const int kq = kg * 2 + k3;
                k0[k3] = *(const LAS bf16x8*)(kt + (fr * LKS + kq * 32 + fq * 8) * 2);
                k1[k3] = *(const LAS bf16x8*)(kt + ((16 + fr) * LKS + kq * 32 + fq * 8) * 2); }
            __builtin_amdgcn_sched_barrier(0);
#pragma unroll
            for (int k3 = 0; k3 < 2; ++k3) { const int kq = kg * 2 + k3;
                s0 = __builtin_amdgcn_mfma_f32_16x16x32_bf16(k0[k3], qf[kq], s0, 0, 0, 0); s1 = __builtin_amdgcn_mfma_f32_16x16x32_bf16(k1[k3], qf[kq], s1, 0, 0, 0); }
            __builtin_amdgcn_sched_barrier(0);
        }
        if (kb + 32 > KSPLIT) {
#pragma unroll
            for (int j = 0; j < 4; ++j) { if (kb + fq * 4 + j >= KSPLIT) s0[j] = -1e30f; if (kb + 16 + fq * 4 + j >= KSPLIT) s1[j] = -1e30f; }
        }
        float mx = fmaxf(fmaxf(fmaxf(s0[0], s0[1]), fmaxf(s0[2], s0[3])), fmaxf(fmaxf(s1[0], s1[1]), fmaxf(s1[2], s1[3])));
        mx = fmaxf(mx, __shfl_xor(mx, 16)); mx = fmaxf(mx, __shfl_xor(mx, 32));
        const float mnew = fmaxf(mrun, mx), alpha = __builtin_amdgcn_exp2f(mrun - mnew);
        mrun = mnew;
        float ps = 0.f;
#pragma unroll
        for (int j = 0; j < 4; ++j) { s0[j] = __builtin_amdgcn_exp2f(s0[j] - mnew); s1[j] = __builtin_amdgcn_exp2f(s1[j] - mnew); ps += s0[j] + s1[j]; }
        lrun = lrun * alpha + ps;
        u32x4 wv; wv.x = cvtpk(s0[0], s0[1]); wv.y = cvtpk(s0[2], s0[3]); wv.z = cvtpk(s1[0], s1[1]); wv.w = cvtpk(s1[2], s1[3]);
        const bf16x8 pf = __builtin_bit_cast(bf16x8, wv);
#pragma unroll
        for (int dg = 0; dg < 8; ++dg) {
            u32x2 va0[2], va1[2];
#pragma unroll
            for (int d4 = 0; d4 < 2; ++d4) { const int dt = dg * 2 + d4;
                va0[d4] = *(const LAS u32x2*)(lds + L_LV + ((dt * 16 + fr) * LVS + fq * 4) * 2);
                va1[d4] = *(const LAS u32x2*)(lds + L_LV + ((dt * 16 + fr) * LVS + 16 + fq * 4) * 2); }
            __builtin_amdgcn_sched_barrier(0);
#pragma unroll
            for (int d4 = 0; d4 < 2; ++d4) { const int dt = dg * 2 + d4;
                const bf16x8 vf = __builtin_bit_cast(bf16x8, (u32x4){va0[d4].x, va0[d4].y, va1[d4].x, va1[d4].y});
                oacc[dt] = __builtin_amdgcn_mfma_f32_16x16x32_bf16(vf, pf, oacc[dt] * alpha, 0, 0, 0); }
            __builtin_amdgcn_sched_barrier(0);
        }
        bufc = bufc == 2 ? 0 : bufc + 1; bufn = bufn == 2 ? 0 : bufn + 1;
    }
#undef LAT_DMA
    { float l = lrun; l += __shfl_xor(l, 16); l += __shfl_xor(l, 32);
      const size_t prow = (size_t)((b * 4 + ks) * 8 + w) * 16 + fr;
#pragma unroll
      for (int dt = 0; dt < 16; ++dt) *(f32x4*)(PO + prow * 512 + dh * 256 + dt * 16 + fq * 4) = oacc[dt];
      if (dh == 0 && fq == 0) { PM[prow] = mrun; PL[prow] = l; } }
    asm volatile("s_waitcnt vmcnt(0) lgkmcnt(0)\n\ts_barrier" ::: "memory");
}

constexpr int OLS = 520;
__device__ __forceinline__ void attn_latent_combine(const Params& p, LAS unsigned char* lds, int b, int h) {
    int tid_ = threadIdx.x; asm volatile("" : "+v"(tid_));
    const int tid = tid_, lane = tid & 63, w = tid >> 6, fr = lane & 15, fq = lane >> 4;
    const float* PO = (const float*)(p.ws + WS_PO); const float* PM = (const float*)(p.ws + WS_PM); const float* PL = (const float*)(p.ws + WS_PL);
    const bf16_t* WUV = (const bf16_t*)(p.ws + WS_W_UV); bf16_t* AO = (bf16_t*)(p.ws + WS_AO);
    {
        const int t = tid >> 5, d0 = (tid & 31) * 16;
        float mk[4], M_ = -1e30f;
#pragma unroll
        for (int k = 0; k < 4; ++k) { mk[k] = PM[(size_t)((b * 4 + k) * 8 + h) * 16 + t]; M_ = fmaxf(M_, mk[k]); }
        float L_ = 0.f; f32x4 o[4];
#pragma unroll
        for (int i = 0; i < 4; ++i) o[i] = (f32x4){0.f, 0.f, 0.f, 0.f};
#pragma unroll
        for (int k = 0; k < 4; ++k) { const size_t prow = (size_t)((b * 4 + k) * 8 + h) * 16 + t; const float sc = __builtin_amdgcn_exp2f(mk[k] - M_); L_ += sc * PL[prow];
#pragma unroll
            for (int i = 0; i < 4; ++i) o[i] += *(const f32x4*)(PO + prow * 512 + d0 + i * 4) * sc; }
        const float inv = 1.f / L_;
        u32x4 w0, w1; w0.x = cvtpk(o[0].x * inv, o[0].y * inv); w0.y = cvtpk(o[0].z * inv, o[0].w * inv); w0.z = cvtpk(o[1].x * inv, o[1].y * inv); w0.w = cvtpk(o[1].z * inv, o[1].w * inv);
        w1.x = cvtpk(o[2].x * inv, o[2].y * inv); w1.y = cvtpk(o[2].z * inv, o[2].w * inv); w1.z = cvtpk(o[3].x * inv, o[3].y * inv); w1.w = cvtpk(o[3].z * inv, o[3].w * inv);
        *(LAS u32x4*)(lds + (t * OLS + d0) * 2) = w0; *(LAS u32x4*)(lds + (t * OLS + d0 + 8) * 2) = w1;
    }
    __syncthreads();
    {
        f32x4 acc = (f32x4){0.f, 0.f, 0.f, 0.f};
#pragma unroll 4
        for (int kq = 0; kq < 16; ++kq) {
            const bf16x8 a = *(const LAS bf16x8*)(lds + (fr * OLS + kq * 32 + fq * 8) * 2);
            const bf16x8 bb = *(const bf16x8*)(WUV + (size_t)(h * 128 + w * 16 + fr) * 512 + kq * 32 + fq * 8);
            acc = __builtin_amdgcn_mfma_f32_16x16x32_bf16(a, bb, acc, 0, 0, 0);
        }
#pragma unroll
        for (int j = 0; j < 4; ++j) AO[(size_t)(MP + b * 16 + fq * 4 + j) * D + h * 128 + w * 16 + fr] = (bf16_t)(cvtpk(acc[j], 0.f) & 0xffff);
    }
    __syncthreads();
}

__device__ __forceinline__ void unpack8(const u32x4 w, float (&f)[8]) { f[0] = bflo(w.x); f[1] = bfhi(w.x); f[2] = bflo(w.y); f[3] = bfhi(w.y); f[4] = bflo(w.z); f[5] = bfhi(w.z); f[6] = bflo(w.w); f[7] = bfhi(w.w); }
__device__ __forceinline__ void phase_ffn_fix(const Params& p, int layer) {
    const bf16_t* SA = (const bf16_t*)(p.ws + WS_SIDEA); const bf16_t* SB = (const bf16_t*)(p.ws + WS_SIDEB); const bf16_t* SU = (const bf16_t*)(p.ws + WS_SIDEU);
    bf16_t* ACT = (bf16_t*)(p.ws + WS_ACT);
    const float* wd = p.in[I_WDW] + (size_t)layer * 3 * DFF; const float* bd = p.in[I_BDW] + (size_t)layer * DFF;
    constexpr int NCC = DFF / 8;
    int tid_ = threadIdx.x; asm volatile("" : "+v"(tid_));
    for (int item = blockIdx.x * 512 + tid_; item < NBLK * NCC; item += gridDim.x * 512) {
        const int blk = item / NCC, cc = item % NCC, c0 = cc * 8;
        const bool smp = blk >= MP / 64;
        const int row0 = smp ? MP + (blk - MP / 64) * 16 : blk * 64;
        float w0[8], w1[8], w2[8], bi[8], am2[8], am1[8], a0[8], a1[8], u0[8], u1[8];
#pragma unroll
        for (int i = 0; i < 8; ++i) { w0[i] = wd[c0 + i]; w1[i] = wd[DFF + c0 + i]; w2[i] = wd[2 * DFF + c0 + i]; bi[i] = bd[c0 + i]; }
        if (smp) { const float* sc = p.in[I_SCONV] + ((size_t)(layer * 32 + (blk - MP / 64)) * 2) * DFF + c0;
#pragma unroll
            for (int i = 0; i < 8; ++i) { am2[i] = sc[i]; am1[i] = sc[DFF + i]; } }
        else if ((blk & 31) == 0) {
#pragma unroll
            for (int i = 0; i < 8; ++i) { am2[i] = 0.f; am1[i] = 0.f; } }
        else { unpack8(*(const u32x4*)(SA + ((size_t)(blk - 1) * 2) * DFF + c0), am2); unpack8(*(const u32x4*)(SA + ((size_t)(blk - 1) * 2 + 1) * DFF + c0), am1); }
        unpack8(*(const u32x4*)(SB + ((size_t)blk * 2) * DFF + c0), a0); unpack8(*(const u32x4*)(SB + ((size_t)blk * 2 + 1) * DFF + c0), a1);
        unpack8(*(const u32x4*)(SU + ((size_t)blk * 2) * DFF + c0), u0); unpack8(*(const u32x4*)(SU + ((size_t)blk * 2 + 1) * DFF + c0), u1);
        float y0[8], y1[8];
#pragma unroll
        for (int i = 0; i < 8; i += 2) {
            f32x2 c0v, c1v;
            c0v.x = bi[i] + am2[i] * w0[i] + am1[i] * w1[i] + a0[i] * w2[i]; c0v.y = bi[i + 1] + am2[i + 1] * w0[i + 1] + am1[i + 1] * w1[i + 1] + a0[i + 1] * w2[i + 1];
            c1v.x = bi[i] + am1[i] * w0[i] + a0[i] * w1[i] + a1[i] * w2[i]; c1v.y = bi[i + 1] + am1[i + 1] * w0[i + 1] + a0[i + 1] * w1[i + 1] + a1[i + 1] * w2[i + 1];
            const f32x2 g0 = gelu_pk(c0v), g1 = gelu_pk(c1v);
            y0[i] = g0.x * u0[i]; y0[i + 1] = g0.y * u0[i + 1]; y1[i] = g1.x * u1[i]; y1[i + 1] = g1.y * u1[i + 1]; }
        u32x4 o; o.x = cvtpk(y0[0], y0[1]); o.y = cvtpk(y0[2], y0[3]); o.z = cvtpk(y0[4], y0[5]); o.w = cvtpk(y0[6], y0[7]);
        *(u32x4*)(ACT + (size_t)row0 * DFF + c0) = o;
        o.x = cvtpk(y1[0], y1[1]); o.y = cvtpk(y1[2], y1[3]); o.z = cvtpk(y1[4], y1[5]); o.w = cvtpk(y1[6], y1[7]);
        *(u32x4*)(ACT + (size_t)(row0 + 1) * DFF + c0) = o;
        if (smp || (blk & 31) == 31) {
            float l0[8], l1[8];
            unpack8(*(const u32x4*)(SA + ((size_t)blk * 2) * DFF + c0), l0); unpack8(*(const u32x4*)(SA + ((size_t)blk * 2 + 1) * DFF + c0), l1);
            float* co = smp ? p.out + O_CONV_S + ((size_t)(layer * 32 + (blk - MP / 64)) * 2) * DFF + c0
                            : p.out + O_CONV_P + ((size_t)(layer * 16 + (blk >> 5)) * 2) * DFF + c0;
#pragma unroll
            for (int i = 0; i < 8; ++i) { co[i] = l0[i]; co[DFF + i] = l1[i]; }
        }
    }
}

__device__ __forceinline__ void phase_fix(const Params& p, int which, int vb, int nvb) {
    int tid_ = threadIdx.x; asm volatile("" : "+v"(tid_));
    const int tid = tid_, lane = tid & 63, wave = tid >> 6;
    const int gw = vb * 8 + wave, NGW = nvb * 8;
    bf16_t* CKVALL = (bf16_t*)(p.ws + WS_CKVALL); bf16_t* KRALL = (bf16_t*)(p.ws + WS_KRALL);
    const float* ssq = (const float*)(p.ws + WS_SSQ); float* ckv = p.out + O_CKV; const float* gkv = p.in[I_GKV];
    const f32x4 g0 = *(const f32x4*)(gkv + lane * 8), g1 = *(const f32x4*)(gkv + lane * 8 + 4);
    if (which & 1)
    for (int row = gw; row < M; row += NGW) {
        const f32x4* pp = (const f32x4*)(ssq + (size_t)row * 32 + 12);
        const float s = (sum4(pp[0]) + sum4(pp[1])) + (sum4(pp[2]) + sum4(pp[3]));
        const float rs = rsqrtf(s * (1.f / 512.f) + EPS);
        bf16_t* cb = CKVALL + (size_t)kvtok(row) * 512 + lane * 8;
        const u32x4 rw = *(const u32x4*)cb;
        f32x4 a = (f32x4){bflo(rw.x), bfhi(rw.x), bflo(rw.y), bfhi(rw.y)}, b = (f32x4){bflo(rw.z), bfhi(rw.z), bflo(rw.w), bfhi(rw.w)};
        a = a * rs * g0; b = b * rs * g1;
        float* cr = ckv + (size_t)row * 512 + lane * 8;
        *(f32x4*)cr = a; *(f32x4*)(cr + 4) = b;
        u32x4 o; o.x = cvtpk(a.x, a.y); o.y = cvtpk(a.z, a.w); o.z = cvtpk(b.x, b.y); o.w = cvtpk(b.z, b.w);
        *(u32x4*)cb = o;
    }
    if (!(which & 2)) return;
    const float* cc = p.in[I_CCKV];
    for (int r = gw; r < 32 * PAST; r += NGW) {
        const int b = r >> 12, s = r & (PAST - 1);
        const f32x4 a = *(const f32x4*)(cc + (size_t)r * 512 + lane * 8), b4 = *(const f32x4*)(cc + (size_t)r * 512 + lane * 8 + 4);
        u32x4 o; o.x = cvtpk(a.x, a.y); o.y = cvtpk(a.z, a.w); o.z = cvtpk(b4.x, b4.y); o.w = cvtpk(b4.z, b4.w);
        *(u32x4*)(CKVALL + (size_t)(MP + b * KVS + s) * 512 + lane * 8) = o;
    }
    const float* ck = p.in[I_CKR];
    for (int it = vb * 512 + tid; it < 32 * PAST * 16; it += nvb * 512) {
        const int r = it >> 4, q = it & 15, b = r >> 12, s = r & (PAST - 1);
        const float* src = ck + (size_t)r * 64;
        u32x2 o; o.x = cvtpk(src[2 * q], src[32 + 2 * q]); o.y = cvtpk(src[2 * q + 1], src[33 + 2 * q]);
        *(u32x2*)(KRALL + (size_t)(MP + b * KVS + s) * 64 + q * 4) = o;
    }
}

__device__ __forceinline__ void phase_final(const Params& p) {
    int tid_ = threadIdx.x; asm volatile("" : "+v"(tid_));
    const int tid = tid_, lane = tid & 63, wave = tid >> 6;
    const int gw = blockIdx.x * 8 + wave, NGW = gridDim.x * 8;
    float* Y = p.out + O_Y; const float* g = p.in[I_NFIN]; const bf16_t* XB = (const bf16_t*)(p.ws + WS_XB); const float* ssp = (const float*)(p.ws + WS_SSP);
    for (int row = gw; row < M; row += NGW) {
        const float rs = rstd_from16(ssp, row);
#pragma unroll
        for (int j = 0; j < 4; ++j) { const u32x2 xb = *(const u32x2*)(XB + (size_t)row * D + j * 256 + lane * 4);
            const f32x4 v = (f32x4){bflo(xb.x), bfhi(xb.x), bflo(xb.y), bfhi(xb.y)};
            const f32x4 gg = *(const f32x4*)(g + j * 256 + lane * 4); *(f32x4*)(Y + (size_t)row * D + j * 256 + lane * 4) = v * rs * gg; }
    }
}

__device__ __forceinline__ void skinny_res(const Params& p, LAS unsigned char* lds, const bf16_t* A, const bf16_t* Bt, int K, int job) {
    int tid_ = threadIdx.x; asm volatile("" : "+v"(tid_));
    const int tid = tid_, lane = tid & 63, w = tid >> 6, fr = lane & 15, fq = lane >> 4, rt = w >> 2, ct = w & 3;
    bf16_t* XB = (bf16_t*)(p.ws + WS_XB); float* ssp = (float*)(p.ws + WS_SSP);
    LAS float* red = (LAS float*)lds;
    for (int u = blockIdx.x; u < 256; u += gridDim.x) {
        const int rg = u >> 4, cg = u & 15, row0 = MP + rg * 32 + rt * 16, col0 = cg * 64 + ct * 16;
        const bf16_t* ap = A + (size_t)(row0 + fr) * K + fq * 8;
        const bf16_t* bp = Bt + (size_t)(col0 + fr) * K + fq * 8;
        f32x4 acc0 = (f32x4){0.f, 0.f, 0.f, 0.f}, acc1 = (f32x4){0.f, 0.f, 0.f, 0.f};
        const int nks = K >> 5;
#pragma unroll 4
        for (int ks = 0; ks < nks; ks += 2) {
            const bf16x8 a0 = *(const bf16x8*)(ap + ks * 32), b0 = *(const bf16x8*)(bp + ks * 32);
            const bf16x8 a1 = *(const bf16x8*)(ap + ks * 32 + 32), b1 = *(const bf16x8*)(bp + ks * 32 + 32);
            acc0 = __builtin_amdgcn_mfma_f32_16x16x32_bf16(a0, b0, acc0, 0, 0, 0);
            acc1 = __builtin_amdgcn_mfma_f32_16x16x32_bf16(a1, b1, acc1, 0, 0, 0);
        }
        float ssj[4];
#pragma unroll
        for (int j = 0; j < 4; ++j) {
            const int row = row0 + fq * 4 + j, col = col0 + fr;
            const float x = bf2f(XB[(size_t)row * D + col]) + (acc0[j] + acc1[j]);
            XB[(size_t)row * D + col] = (bf16_t)(cvtpk(x, 0.f) & 0xffff);
            float ss = x * x;
            ss += __shfl_xor(ss, 1); ss += __shfl_xor(ss, 2); ss += __shfl_xor(ss, 4); ss += __shfl_xor(ss, 8);
            ssj[j] = ss;
        }
        __syncthreads();
        if (fr == 0) {
#pragma unroll
            for (int j = 0; j < 4; ++j) red[(rt * 16 + fq * 4 + j) * 4 + ct] = ssj[j];
        }
        __syncthreads();
        if (tid < 32) ssp[(size_t)(MP + rg * 32 + tid) * 16 + cg] = (red[tid * 4] + red[tid * 4 + 1]) + (red[tid * 4 + 2] + red[tid * 4 + 3]);
    }
    __syncthreads();
}

#define XB_TMO      128
#define XB_XCNT(j)  (256  + 64 * (j))
#define XB_XSUB(j)  (1280 + 64 * (j))
#define XB_XGEN(j)  (2304 + 64 * (j))
#define XB_TOP      3328
#define XB_TOPGEN   3392
#define XCD_BAR_WORDS 3456
#define XB_SPIN_CAP (1u << 18)

__device__ __forceinline__ unsigned xb_ld(unsigned* p)              { return __hip_atomic_load(p, __ATOMIC_RELAXED, __HIP_MEMORY_SCOPE_AGENT); }
__device__ __forceinline__ unsigned xb_add(unsigned* p, unsigned v) { return __hip_atomic_fetch_add(p, v, __ATOMIC_RELAXED, __HIP_MEMORY_SCOPE_AGENT); }
__device__ __forceinline__ unsigned xb_xcc_id() { return (unsigned)__builtin_amdgcn_s_getreg((3 << 11) | 20) & 0xFu; }
#define XB_SPIN(cond, bar) do { unsigned _sp = 0; while (cond) { __builtin_amdgcn_s_sleep(1); \
    if ((++_sp & 255u) == 0u) { if (xb_ld(&(bar)[XB_TMO])) break; if (_sp > XB_SPIN_CAP) { atomicAdd(&(bar)[XB_TMO], 1u); break; } } } } while (0)

struct XcdBarrier {
    unsigned* bar; unsigned x;
    volatile LAS unsigned* st;
};

__device__ __forceinline__ XcdBarrier xcd_barrier_post(unsigned* bar, volatile LAS unsigned* st) {
    XcdBarrier b; b.bar = bar; b.x = xb_xcc_id(); b.st = st;
    if (threadIdx.x == 0) (void)xb_add(&bar[XB_XCNT(b.x)], 1u);
    return b;
}
__device__ __forceinline__ void xcd_barrier_complete(unsigned* bar, unsigned x, unsigned& nloc, unsigned& nx) {
    const unsigned G = gridDim.x * gridDim.y * gridDim.z;
    unsigned sum, cnt, mine, sp = 0u;
    for (;;) {
        sum = 0u; cnt = 0u; mine = 0u;
#pragma unroll
        for (unsigned j = 0; j < 16; ++j) { const unsigned c = xb_ld(&bar[XB_XCNT(j)]); sum += c; cnt += (c > 0u) ? 1u : 0u; mine = (j == x) ? c : mine; }
        if (sum == G) break;
        __builtin_amdgcn_s_sleep(1);
        if ((++sp & 255u) == 0u) { if (xb_ld(&bar[XB_TMO])) break; if (sp > XB_SPIN_CAP) { atomicAdd(&bar[XB_TMO], 1u); break; } }
    }
    nloc = mine > 0u ? mine : 1u; nx = cnt > 0u ? cnt : 1u;
}

__device__ __forceinline__ void xcd_barrier(const XcdBarrier& b) {
    asm volatile("s_waitcnt vmcnt(0)" ::: "memory");
    __syncthreads();
    if (threadIdx.x == 0) {
        unsigned* bar = b.bar;
        __builtin_amdgcn_s_waitcnt(0);
        unsigned nloc = b.st[0], nx = b.st[1];
        if (nloc == 0u) { xcd_barrier_complete(bar, b.x, nloc, nx); b.st[0] = nloc; b.st[1] = nx; }
        const unsigned old = xb_add(&bar[XB_XSUB(b.x)], 1u);
        const unsigned gen = old / nloc;
        if (old + 1u == (gen + 1u) * nloc) {
            __builtin_amdgcn_fence(__ATOMIC_RELEASE, "agent");
            asm volatile("s_waitcnt vmcnt(0)" ::: "memory");
            const unsigned og = xb_add(&bar[XB_TOP], 1u);
            const unsigned tg = og / nx;
            if (og + 1u == (tg + 1u) * nx) xb_add(&bar[XB_TOPGEN], 1u);
            else XB_SPIN(xb_ld(&bar[XB_TOPGEN]) == tg, bar);
            __builtin_amdgcn_fence(__ATOMIC_ACQUIRE, "agent");
            xb_add(&bar[XB_XGEN(b.x)], 1u);
            asm volatile("s_waitcnt vmcnt(0)" ::: "memory");
        } else {
            XB_SPIN(xb_ld(&bar[XB_XGEN(b.x)]) == gen, bar);
            __builtin_amdgcn_fence(__ATOMIC_ACQUIRE, "agent");
            asm volatile("s_waitcnt vmcnt(0)" ::: "memory");
        }
    }
    __syncthreads();
}


#ifdef DBG_ZERO
constexpr int NPHASE = 17;
#else
constexpr int NPHASE = 16;
#endif
__global__ void __launch_bounds__(512, 2) mega_fwd(Params pk) {
    extern __shared__ __attribute__((aligned(16))) unsigned char smem[];
    LAS unsigned char* lds = (LAS unsigned char*)smem;
    const int G = gridDim.x, bx = blockIdx.x;
#ifndef PHMASK
#define PHMASK 0x1FFFF
#endif
#define PH(k) ((((PHMASK) >> (k)) & 1) && ph == (k))
#ifndef REPMASK
#define REPMASK 0
#endif
    volatile LAS unsigned* bst = (volatile LAS unsigned*)(lds + LDS_BYTES - 64);
    if (threadIdx.x < 2) bst[threadIdx.x] = 0u;
    __syncthreads();
    XcdBarrier xbar; xbar.bar = (unsigned*)pk.ws; xbar.x = 0; xbar.st = bst;
    if (pk.ph_hi - pk.ph_lo > 1) xbar = xcd_barrier_post((unsigned*)pk.ws, bst);
    bool first = true; int nseam = 0;
#pragma unroll 1
    for (int slot = 2 * pk.ph_lo; slot < 2 * pk.ph_hi; ++slot) {
        const int ph = slot >> 1;
        if ((slot & 1) && !((REPMASK >> ph) & 1)) continue;
        if (!first) { if (pk.ph_lo < 0) cg::this_grid().sync(); else xcd_barrier(xbar); ++nseam; }
        first = false;
        const __attribute__((address_space(4))) char* ka = (const __attribute__((address_space(4))) char*)__builtin_amdgcn_kernarg_segment_ptr();
        asm volatile("" : "+s"(ka));
        const Params& p = *(const Params*)(const char*)ka;
        unsigned char* ws = p.ws;
        bf16_t* XB = (bf16_t*)(ws + WS_XB);
        if (PH(0)) { phase_prologue(p, lds, G == 256 ? 1 : 15, bx, G); if (G != 256) fold_wql(p, bx, G); }
        else if (PH(1) || PH(8) || PH(9)) {
            const bool ql8 = (G == 256);
            int nsub = (ph == 9) ? (ql8 ? 3 : 4) : 1;
            if (ph == 8) nsub = (ql8 && bx < 44) ? 1 : 0;
#pragma unroll 1
            for (int sub = 0; sub < nsub; ++sub) {
                pg8::Gemm g; EpiBf E; E.pp = &p;
                if (ph == 1) { g = pg8::Gemm{XB, (const bf16_t*)(ws + WS_W_INAB), M, NAB, 1024}; E.job = 1; }
                else if ((ph == 8 && bx < 32) || sub == 3) { g = pg8::Gemm{(const bf16_t*)(ws + WS_CQ) + (size_t)MP * 384, (const bf16_t*)(ws + WS_W_QL), MS, 4096, 384}; E.job = 93; }
                else if (ph == 8) { g = pg8::Gemm{(const bf16_t*)(ws + WS_CQ) + (size_t)MP * 384, (const bf16_t*)(ws + WS_W_UQ), MS, 1536, 384}; E.job = 94; }
                else if (sub == 0) { g = pg8::Gemm{(const bf16_t*)(ws + WS_CQ), (const bf16_t*)(ws + WS_W_UQ), ql8 ? MP : M, 1536, 384}; E.job = 90; }
                else if (sub == 1) { g = pg8::Gemm{(const bf16_t*)(ws + WS_CKVALL), (const bf16_t*)(ws + WS_W_UK), MP, 1024, 512}; E.job = 91; }
                else { g = pg8::Gemm{(const bf16_t*)(ws + WS_W_UV), (const bf16_t*)(ws + WS_CKVALL), 1024, MP, 512}; E.job = 92; }
                pg8::StaticOrder S; S.init(g.M, g.N, ph == 8 ? (bx < 32 ? 32 : 12) : G, ph == 8 && bx >= 32 ? bx - 32 : bx);
                pg8::gemm_phase(lds, g, S, E);
            }
            if (ph == 1 && G == 256 && bx >= 154) phase_prologue(p, lds, 8, bx - 154, G - 154);
            if (ph == 8) { if (!ql8) phase_fix(p, 3, bx, G); else if (bx >= 44) phase_fix(p, 1, bx - 44, G - 44); }
        }
        else if (PH(4) || PH(12)) {
            const int layer = ph == 12;
            { int t_ = threadIdx.x; asm volatile("" : "+v"(t_)); const float* ssp = (const float*)(ws + WS_SSP); float* rsp = (float*)(ws + WS_RS);
              for (int row = bx * 512 + t_; row < M; row += G * 512) rsp[row] = rstd_from16(ssp, row); }
            xcd_barrier(xbar);
            pg8::Gemm g{XB, (const bf16_t*)(ws + WS_W_FFNIN) + (size_t)layer * 5632 * 1024, M, 5632, 1024};
            EpiFfn E{&p, layer};
#ifndef WGM_FFNUP
#define WGM_FFNUP 4
#endif
            pg8::StaticOrder S; S.init(g.M, g.N, G, bx, WGM_FFNUP);
            pg8::gemm_phase(lds, g, S, E);
            if (ph == 4 && G == 256 && bx >= 44) phase_prologue(p, lds, 4, bx - 44, G - 44);
        }
        else if (PH(2)) {
#pragma unroll 1
            for (int u = bx; u < 384; u += G) dla_unit(p, lds, u);
            if (G == 256 && bx >= 128) { __syncthreads(); phase_prologue(p, lds, 2, bx - 128, G - 128); fold_wql(p, bx - 128, G - 128); }
        }
        else if (PH(3) || PH(6) || PH(11) || PH(14)) {
            if (ph == 11) {
#pragma unroll 1
                for (int u = bx; u < 256; u += G) attn_latent_combine(p, lds, u >> 3, u & 7);
                xcd_barrier(xbar);
            }
            pg8::Gemm g; EpiRes E; E.pp = &p; E.job = ph;
            if (ph == 3) { g = pg8::Gemm{(const bf16_t*)(ws + WS_MIX), (const bf16_t*)(ws + WS_W_OUTAB), MP, 1024, 1024}; }
            else if (ph == 11) { g = pg8::Gemm{(const bf16_t*)(ws + WS_AO), (const bf16_t*)(ws + WS_W_OUTC), MP, 1024, 1024}; }
            else { const int layer = ph == 14; g = pg8::Gemm{(const bf16_t*)(ws + WS_ACT), (const bf16_t*)(ws + WS_W_FFNOUT) + (size_t)layer * 1024 * 2816, MP, 1024, 2816}; }
            pg8::StaticOrder S; S.init(g.M, g.N, G, bx);
            pg8::gemm_phase(lds, g, S, E);
            skinny_res(p, lds, g.A, g.Bt, g.K, ph);
        }
        else if (PH(5) || PH(13)) { phase_ffn_fix(p, ph == 13); }
        else if (PH(7)) {
            pg8::Gemm g{XB, (const bf16_t*)(ws + WS_W_INC), M, 1024, 1024}; pg8::StaticOrder S; S.init(M, 1024, G, bx);
            EpiInC E{&p};
            pg8::gemm_phase(lds, g, S, E);
            if (G == 256 && bx >= 8) phase_fix(p, 2, bx - 8, G - 8);
        }
        else if (PH(10)) {
#pragma unroll 1
            for (int u = bx; u < 1280; u += G) {
                const int c = u & 255, i = u >> 8;
                if (i < 4) { const int bh = c >> 1, par = c & 1; const int qb = par ? (i == 0 ? 1 : i == 1 ? 2 : i == 2 ? 5 : 6) : (i == 0 ? 0 : i == 1 ? 3 : i == 2 ? 4 : 7);
                    const int b = bh >> 3, h = bh & 7;
                    attn_unit(p, lds, b * SEQ + qb * 256, 256, b * SEQ, (qb + 1) * 256, h, true); }
                else attn_latent_unit(p, lds, c >> 3, (c >> 2) & 1, c & 3);
            }
        }
        else if (PH(15)) { phase_final(p); }
#ifdef DBG_ZERO
        else if (ph == 16) {
            int tz_ = threadIdx.x; asm volatile("" : "+v"(tz_));
#define DZ(o, lo, hi) if ((DBG_ZERO >> (o)) & 1) { for (size_t i = (size_t)(lo) + (size_t)bx * 512 + tz_; i < (size_t)(hi); i += (size_t)G * 512) p.out[i] = 0.f; }
        DZ(0, 0, (size_t)MP * D) DZ(1, (size_t)MP * D, O_GLA_P) DZ(2, O_GLA_P, O_GLA_S) DZ(3, O_GLA_S, O_RET_P) DZ(4, O_RET_P, O_RET_S) DZ(5, O_RET_S, O_CKV)
        DZ(6, O_CKV, O_CKV + (size_t)MP * 512) DZ(7, O_CKV + (size_t)MP * 512, O_KR) DZ(8, O_KR, O_KR + (size_t)MP * 64) DZ(9, O_KR + (size_t)MP * 64, O_CONV_P)
        DZ(10, O_CONV_P, O_CONV_S) DZ(11, O_CONV_S, O_CONV_S + 2 * 32 * 2 * DFF)
        }
#endif
    }
}

extern "C" void kernel_launch(void* const* d_in, const int* in_sizes, int n_in, void* d_out, int out_size, void* d_ws, size_t ws_size, hipStream_t stream) {
    static int grid = 0;
    if (grid == 0) {
        int dev = 0, cus = 0, per_cu = 0;
        (void)hipGetDevice(&dev);
        (void)hipDeviceGetAttribute(&cus, hipDeviceAttributeMultiprocessorCount, dev);
        (void)hipFuncSetAttribute((const void*)mega_fwd, hipFuncAttributeMaxDynamicSharedMemorySize, LDS_BYTES);
        (void)hipOccupancyMaxActiveBlocksPerMultiprocessor(&per_cu, (const void*)mega_fwd, 512, LDS_BYTES);
        if (per_cu < 1) per_cu = 1;
        grid = cus * per_cu;
        (void)hipGetLastError();
        if (n_in != 27 || ws_size < WS_END) { fprintf(stderr, "kernel_launch: unexpected n_in %d / ws_size %zu\n", n_in, ws_size); }
    }
    Params p{};
    for (int i = 0; i < 27; ++i) p.in[i] = (const float*)d_in[i];
    p.out = (float*)d_out; p.ws = (unsigned char*)d_ws;
#if ONE_LAUNCH
    (void)hipMemsetAsync(d_ws, 0, 16384, stream);
    p.ph_lo = 0; p.ph_hi = NPHASE;
    void* args[] = {&p};
    hipError_t e = hipLaunchCooperativeKernel((const void*)mega_fwd, dim3(grid), dim3(512), args, LDS_BYTES, stream);
    if (e != hipSuccess) fprintf(stderr, "cooperative launch failed: %s (grid %d)\n", hipGetErrorString(e), grid);
#else
    for (int ph = 0; ph < NPHASE; ++ph) {
        p.ph_lo = ph; p.ph_hi = ph + 1;
        hipLaunchKernelGGL(mega_fwd, dim3(grid), dim3(512), LDS_BYTES, stream, p);
    }
#endif
}
```

```cpp
#include <hip/hip_runtime.h>
#include <hip/hip_cooperative_groups.h>
#include <cstdio>
#include <cstdint>
namespace cg = cooperative_groups;

#ifndef ONE_LAUNCH
#define ONE_LAUNCH 1


#endif

#define LAS __attribute__((address_space(3)))
typedef unsigned short bf16_t;
typedef short bf16x8 __attribute__((ext_vector_type(8)));
typedef float f32x4 __attribute__((ext_vector_type(4)));
typedef float f32x2 __attribute__((ext_vector_type(2)));
typedef unsigned u32x4 __attribute__((ext_vector_type(4)));
typedef unsigned u32x2 __attribute__((ext_vector_type(2)));
typedef __bf16 bf16x2_t __attribute__((ext_vector_type(2)));

__device__ __forceinline__ unsigned cvtpk(float lo, float hi) { f32x2 v = {lo, hi}; bf16x2_t b = __builtin_convertvector(v, bf16x2_t); return __builtin_bit_cast(unsigned, b); }
__device__ __forceinline__ float bf2f(unsigned short h) { return __uint_as_float(((unsigned)h) << 16); }
__device__ __forceinline__ float bflo(unsigned w) { return __uint_as_float(w << 16); }
__device__ __forceinline__ float bfhi(unsigned w) { return __uint_as_float(w & 0xffff0000u); }

constexpr int D = 1024, MP = 32768, MS = 512, M = MP + MS, SEQ = 2048, DSEQ = 16, PAST = 4096;
constexpr int KVS = PAST + DSEQ;
constexpr int NKV = MP + 32 * KVS;
constexpr int NAB = 3328;
constexpr int DFF = 2816;
constexpr float EPS = 1e-6f;
constexpr int NPOS = SEQ + DSEQ;

constexpr size_t O_Y = 0;
constexpr size_t O_GLA_P = (size_t)M * D;
constexpr size_t O_GLA_S = O_GLA_P + 16 * 4 * 64 * 128;
constexpr size_t O_RET_P = O_GLA_S + 32 * 4 * 64 * 128;
constexpr size_t O_RET_S = O_RET_P + 16 * 4 * 64 * 128;
constexpr size_t O_CKV = O_RET_S + 32 * 4 * 64 * 128;
constexpr size_t O_KR = O_CKV + (size_t)M * 512;
constexpr size_t O_CONV_P = O_KR + (size_t)M * 64;
constexpr size_t O_CONV_S = O_CONV_P + 2 * 16 * 2 * DFF;

constexpr size_t MiB = 1u << 20;
constexpr size_t WS_W_INAB = 1 * MiB;
constexpr size_t WS_W_OUTAB = 8 * MiB;
constexpr size_t WS_W_FFNIN = 10 * MiB;
constexpr size_t WS_W_FFNOUT = 32 * MiB;
constexpr size_t WS_W_INC = 43 * MiB;
constexpr size_t WS_W_UQ = 45 * MiB;
constexpr size_t WS_W_UK = 47 * MiB;
constexpr size_t WS_W_UV = 48 * MiB;
constexpr size_t WS_W_OUTC = 49 * MiB;
constexpr size_t WS_ROT = 51 * MiB;
constexpr size_t WS_SSP = 52 * MiB;
constexpr size_t WS_SSQ = 55 * MiB;
constexpr size_t WS_RS = 60 * MiB;
constexpr size_t WS_W_QL = 61 * MiB;
constexpr size_t WS_R = 64 * MiB;
constexpr size_t WS_P = WS_R;
constexpr size_t WS_MIX = WS_R + 212 * MiB;
constexpr int NBLK = MP / 64 + 32;
constexpr size_t WS_SIDEA = WS_R;
constexpr size_t WS_SIDEB = WS_R + 8 * MiB;
constexpr size_t WS_SIDEU = WS_R + 16 * MiB;
constexpr size_t WS_ACT = WS_R + 358 * MiB;
constexpr size_t WS_XB = WS_R + 540 * MiB;
constexpr size_t WS_CKVALL = WS_R;
constexpr size_t WS_AO = WS_R + 430 * MiB;
constexpr size_t WS_CQ = WS_R + 161 * MiB;
constexpr size_t WS_KRALL = WS_R + 186 * MiB;
constexpr size_t WS_Q = WS_R + 207 * MiB;
constexpr size_t WS_KN = WS_R + 305 * MiB;
constexpr size_t WS_VT = WS_R + 626 * MiB;
constexpr size_t WS_QL = WS_R + 370 * MiB;
constexpr size_t WS_PO = WS_R + 380 * MiB;
constexpr size_t WS_PM = WS_R + 420 * MiB;
constexpr size_t WS_PL = WS_R + 421 * MiB;
constexpr size_t WS_END = WS_R + 948 * MiB;
static_assert(WS_END <= 1024 * MiB, "ws map");

constexpr int LDS_BYTES = 147456;

__device__ __forceinline__ int kvtok(int row) { return row < MP ? row : MP + ((row - MP) >> 4) * KVS + PAST + ((row - MP) & 15); }
__device__ __forceinline__ int posidx(int row) { return row < MP ? (row & (SEQ - 1)) : SEQ + ((row - MP) & 15); }

namespace pg8 {
constexpr int BM = 256, BK = 64, HALF = 128, HTB = HALF * BK * 2, STAGE_BYTES = 8 * HTB, NXCD = 8, WGM = 4;
__host__ __device__ __forceinline__ int lds_byte(int r, int c) { const int st = (r >> 4) * 2 + (c >> 5), rr = r & 15, cc = c & 31, ob = rr * 64 + cc * 2; return st * 1024 + (ob ^ (((ob >> 9) & 1) << 5)); }
__host__ __device__ __forceinline__ void stage_rc(int b, int& R, int& C) { const int st = b / 1024, sb = b % 1024, swz = sb ^ (((sb >> 9) & 1) << 5); R = (st >> 1) * 16 + swz / 64; C = (st & 1) * 32 + (swz % 64) / 2; }
__host__ __device__ __forceinline__ int perm32(int rho) { const int n = rho >> 4, i = rho & 15; return 8 * (i >> 2) + 4 * n + (i & 3); }
struct Unit { int pm, pn; };
struct Gemm { const bf16_t* A; const bf16_t* Bt; int M, N, K; };
struct StaticOrder {
    int nM, nN, nwg, G, c, wgm;
    __host__ __device__ void init(int M_, int N_, int G_, int c_, int wgm_ = WGM) { nM = M_ / BM; nN = N_ / BM; nwg = nM * nN; G = G_; c = c_; wgm = wgm_; }
    __host__ __device__ bool next(int i, Unit& u) const {
        const long L = (long)i * G + c; if (L >= nwg) return false;
        int wgid = (int)L; { const int q = nwg / NXCD, r = nwg % NXCD, xcd = wgid % NXCD, off = wgid / NXCD; wgid = (xcd < r ? xcd * (q + 1) : r * (q + 1) + (xcd - r) * q) + off; }
        const int nig = wgm * nN, gid = wgid / nig, fm = gid * wgm, gsz = (nM - fm) < wgm ? (nM - fm) : wgm;
        u.pm = fm + ((wgid % nig) % gsz); u.pn = (wgid % nig) / gsz; return true;
    }
};
template <class Epi>
__device__ __forceinline__ void gemm_phase(LAS unsigned char* lds, const Gemm g, const StaticOrder& S, const Epi& E) {
    int tid_ = threadIdx.x; asm volatile("" : "+v"(tid_));
    const int tid = tid_, wid = __builtin_amdgcn_readfirstlane(tid >> 6), lane = tid & 63, wr = wid >> 2, wc = wid & 3, fr = lane & 15, fq = lane >> 4;
    const int K = g.K, nt = K / BK;
    unsigned voffA[2], voffB[2];
#pragma unroll
    for (int i = 0; i < 2; ++i) { int R, C; stage_rc(tid * 16 + i * 8192, R, C); const int Rb = Epi::PERM ? ((R & ~31) + perm32(R & 31)) : R;
        voffA[i] = (unsigned)(R * K + C) * 2u; voffB[i] = (unsigned)(Rb * K + C) * 2u; }
    const size_t kstep = (size_t)(BK * 2);
    const size_t hstep = (size_t)HALF * K * 2;
    const size_t tstep = 2 * hstep;
    const unsigned ldsw = (unsigned)wid * 1024u;
    const int aoff = lds_byte(wr * 64 + fr, fq * 8), boff = lds_byte(wc * 32 + fr, fq * 8);
#define PG8_SA(b, h) (((b) * 2 + (h)) * HTB)
#define PG8_SB(b, h) ((4 + (b) * 2 + (h)) * HTB)
#define PG8_STAGE(bufoff, gbase, voff) do { _Pragma("unroll") for (int _i = 0; _i < 2; ++_i) \
        __builtin_amdgcn_global_load_lds((const unsigned*)((const char*)(gbase) + (voff)[_i]), (LAS unsigned*)(lds + (bufoff) + ldsw + _i * 8192), 16, 0, 0); } while (0)
#define PG8_LDA(dst, b, h) do { _Pragma("unroll") for (int m = 0; m < 4; ++m) _Pragma("unroll") for (int k = 0; k < 2; ++k) dst[m][k] = *(const LAS bf16x8*)(lds + PG8_SA(b, h) + aoff + m * 2048 + k * 1024); } while (0)
#define PG8_LDB(dst, b, h) do { _Pragma("unroll") for (int n = 0; n < 2; ++n) _Pragma("unroll") for (int k = 0; k < 2; ++k) dst[n][k] = *(const LAS bf16x8*)(lds + PG8_SB(b, h) + boff + n * 2048 + k * 1024); } while (0)
#define PG8_MMA(ai, bj, At, Bt) do { __builtin_amdgcn_s_setprio(1); _Pragma("unroll") for (int m = 0; m < 4; ++m) _Pragma("unroll") for (int n = 0; n < 2; ++n) _Pragma("unroll") for (int k = 0; k < 2; ++k) \
        acc[ai][bj][m][n] = __builtin_amdgcn_mfma_f32_16x16x32_bf16(Bt[n][k], At[m][k], acc[ai][bj][m][n], 0, 0, 0); __builtin_amdgcn_s_setprio(0); } while (0)
#define PG8_WAIT_V(n) asm volatile("s_waitcnt vmcnt(" #n ")" ::: "memory")
#define PG8_WAIT_L(n) asm volatile("s_waitcnt lgkmcnt(" #n ")" ::: "memory")
#define PG8_BAR __builtin_amdgcn_s_barrier()
#define PG8_SCHED __builtin_amdgcn_sched_barrier(0)
    Unit cur, nxt; int ui = 0;
    if (!S.next(0, cur)) return;
    f32x4 acc[2][2][4][2];
#pragma unroll
    for (int a = 0; a < 2; ++a)
#pragma unroll
        for (int b = 0; b < 2; ++b)
#pragma unroll
            for (int m = 0; m < 4; ++m)
#pragma unroll
                for (int n = 0; n < 2; ++n) acc[a][b][m][n] = (f32x4){0.f, 0.f, 0.f, 0.f};
    bf16x8 At[4][2], B0[2][2], B1[2][2];
    const char* cA = (const char*)g.A + (size_t)cur.pm * tstep; const char* cB = (const char*)g.Bt + (size_t)cur.pn * tstep;
    PG8_STAGE(PG8_SB(0, 0), cB, voffB); PG8_STAGE(PG8_SB(0, 1), cB + hstep, voffB); PG8_STAGE(PG8_SA(0, 0), cA, voffA); PG8_STAGE(PG8_SA(0, 1), cA + hstep, voffA);
    if (wr == 1) PG8_BAR;
    PG8_WAIT_V(2); PG8_BAR;
    PG8_STAGE(PG8_SB(1, 0), cB + kstep, voffB); PG8_STAGE(PG8_SA(1, 0), cA + kstep, voffA); PG8_STAGE(PG8_SB(1, 1), cB + hstep + kstep, voffB);
    PG8_WAIT_V(6); PG8_BAR;
    for (;;) {
        const bool has_next = S.next(ui + 1, nxt);
        const char* nA = has_next ? (const char*)g.A + (size_t)nxt.pm * tstep : cA; const char* nB = has_next ? (const char*)g.Bt + (size_t)nxt.pn * tstep : cB;
        for (int t = 0; t < nt; t += 2) {
            const bool last = (t == nt - 2);
            const char* a1 = cA + (size_t)(t + 1) * kstep;
            const char* a2 = last ? nA : cA + (size_t)(t + 2) * kstep; const char* b2 = last ? nB : cB + (size_t)(t + 2) * kstep;
            const char* a3 = a2 + kstep; const char* b3 = b2 + kstep;
            PG8_LDB(B0, 0, 0); PG8_LDB(B1, 0, 1); PG8_SCHED; PG8_LDA(At, 0, 0); PG8_STAGE(PG8_SA(1, 1), a1 + hstep, voffA);
            PG8_WAIT_V(8); PG8_WAIT_L(0); PG8_BAR; PG8_MMA(0, 0, At, B0); PG8_MMA(0, 1, At, B1); PG8_BAR; PG8_SCHED;
            PG8_LDA(At, 0, 1); PG8_STAGE(PG8_SB(0, 0), b2, voffB); PG8_STAGE(PG8_SB(0, 1), b2 + hstep, voffB); PG8_STAGE(PG8_SA(0, 0), a2, voffA);
            PG8_WAIT_V(8); PG8_WAIT_L(0); PG8_BAR; PG8_MMA(1, 0, At, B0); PG8_MMA(1, 1, At, B1); PG8_BAR; PG8_SCHED;
            PG8_LDB(B0, 1, 0); PG8_LDB(B1, 1, 1); PG8_SCHED; PG8_LDA(At, 1, 0); PG8_STAGE(PG8_SA(0, 1), a2 + hstep, voffA);
            PG8_WAIT_V(8); PG8_WAIT_L(0); PG8_BAR; PG8_MMA(0, 0, At, B0); PG8_MMA(0, 1, At, B1); PG8_BAR; PG8_SCHED;
            PG8_LDA(At, 1, 1); PG8_STAGE(PG8_SB(1, 0), b3, voffB); PG8_STAGE(PG8_SB(1, 1), b3 + hstep, voffB); PG8_STAGE(PG8_SA(1, 0), a3, voffA);
            PG8_WAIT_V(8); PG8_WAIT_L(0); PG8_BAR; PG8_MMA(1, 0, At, B0); PG8_MMA(1, 1, At, B1); PG8_BAR; PG8_SCHED;
        }
        if (wr == 0) PG8_BAR;
        E(acc, cur, wr, wc, fr, fq);
        if (!has_next) break;
#pragma unroll
        for (int a = 0; a < 2; ++a)
#pragma unroll
            for (int b = 0; b < 2; ++b)
#pragma unroll
                for (int m = 0; m < 4; ++m)
#pragma unroll
                    for (int n = 0; n < 2; ++n) acc[a][b][m][n] = (f32x4){0.f, 0.f, 0.f, 0.f};
        cur = nxt; cA = nA; cB = nB; ++ui;
        if (wr == 1) PG8_BAR;
    }
    PG8_WAIT_V(0);
    PG8_BAR;
#undef PG8_SA
#undef PG8_SB
#undef PG8_STAGE
#undef PG8_LDA
#undef PG8_LDB
#undef PG8_MMA
#undef PG8_WAIT_V
#undef PG8_WAIT_L
#undef PG8_BAR
#undef PG8_SCHED
}
}

struct Params { const float* in[27]; float* out; unsigned char* ws; int ph_lo, ph_hi; };
enum { I_XP = 0, I_XS, I_SGLA, I_SRET, I_CCKV, I_CKR, I_SCONV, I_NMIX, I_NFFN, I_NFIN, I_WINAB, I_WGU, I_BG, I_GGLA, I_GRET, I_WOUTAB, I_WINC, I_GQ, I_GKV, I_WUQ, I_WUK, I_WUV, I_WOUTC, I_WFFNIN, I_WDW, I_BDW, I_WFFNOUT };

__device__ __forceinline__ float sum4(f32x4 a) { return (a.x + a.y) + (a.z + a.w); }
__device__ __forceinline__ float rstd_from16(const float* ssp, int row) {
    const f32x4* p = (const f32x4*)(ssp + (size_t)row * 16);
    const f32x4 a = p[0], b = p[1], c = p[2], d = p[3];
    const float s = (sum4(a) + sum4(b)) + (sum4(c) + sum4(d));
    return rsqrtf(s * (1.0f / 1024.0f) + EPS);
}
__device__ __forceinline__ f32x4 rope4(f32x4 v, f32x4 cs) { f32x4 r; r.x = v.x * cs.x - v.y * cs.y; r.y = v.x * cs.y + v.y * cs.x; r.z = v.z * cs.z - v.w * cs.w; r.w = v.z * cs.w + v.w * cs.z; return r; }
__device__ __forceinline__ float logsig(float x) { return fminf(x, 0.f) - log1pf(__expf(-fabsf(x))); }

struct EpiBf {
    static constexpr bool PERM = true;
    const Params* pp; int job;
    __device__ __forceinline__ void operator()(const f32x4 (&acc)[2][2][4][2], const pg8::Unit& u, int wr, int wc, int fr, int fq) const {
        const Params* q_ = pp; asm volatile("" : "+s"(q_));
        unsigned char* ws = q_->ws;
        const int MODE = job == 1 ? 2 : (job == 90 || job == 93 || job == 94) ? 3 : 0;
        bf16_t* O = (bf16_t*)(ws + (job == 1 ? WS_P : (job == 90 || job == 94) ? WS_Q : job == 91 ? WS_KN : job == 93 ? WS_QL : WS_VT)) + (job == 94 ? (size_t)MP * 1536 : 0);
        const int ldc = job == 1 ? NAB : (job == 90 || job == 94) ? 1536 : job == 91 ? 1024 : job == 93 ? 4096 : NKV;
        const int rowoff = (job == 93 || job == 94) ? MP : 0;
        const float* ssp = (const float*)(ws + ((job == 90 || job == 93 || job == 94) ? WS_SSQ : WS_SSP));
        const float* rot = (const float*)(ws + WS_ROT);
        const float* bgate = q_->in[I_BG];
        const int row0 = u.pm * 256 + wr * 64 + fr, col0 = u.pn * 256 + wc * 32 + 8 * fq;
        float rsv[2][4];
#pragma unroll
        for (int ai = 0; ai < 2; ++ai) {
#pragma unroll
            for (int m = 0; m < 4; ++m) {
                const int row = row0 + ai * 128 + m * 16;
                float r_ = 1.f;
                if (MODE == 1 || MODE == 2) r_ = rstd_from16(ssp, row);
                if (MODE == 3) { const f32x4* p = (const f32x4*)(ssp + (size_t)(row + rowoff) * 32); const float s = sum4(p[0]) + sum4(p[1]) + sum4(p[2]); r_ = rsqrtf(s * (1.0f / 384.0f) + EPS); }
                rsv[ai][m] = r_;
                if (m & 1) asm volatile("" ::: "memory");
            }
        }
#pragma unroll
        for (int ai = 0; ai < 2; ++ai)
#pragma unroll
            for (int m = 0; m < 4; ++m) {
                const int row = row0 + ai * 128 + m * 16;
                const float rs = rsv[ai][m];
#pragma unroll
                for (int bj = 0; bj < 2; ++bj) {
                    const int col = col0 + bj * 128;
                    f32x4 v0 = acc[ai][bj][m][0] * rs, v1 = acc[ai][bj][m][1] * rs;
                    bool dorope = false; int i0 = 0;
                    if (MODE == 2) { if (u.pn == 6 || u.pn == 7) { dorope = true; i0 = (col & 63) >> 1; } }
                    if (MODE == 3 && job != 93) { const int within = col % 192; if (within >= 128) { dorope = true; i0 = (within - 128) >> 1; } }
                    if (dorope) {
                        const f32x4* cs = (const f32x4*)(rot + ((size_t)posidx(row + rowoff) * 32 + i0) * 2);
                        const f32x4 c0 = cs[0], c1 = cs[1];
                        v0 = rope4(v0, c0);
                        v1 = rope4(v1, c1);
                    }
                    if (MODE == 2) { if (u.pn == 12) {
                        const f32x4 b0 = *(const f32x4*)(bgate + (col - 3072)), b1 = *(const f32x4*)(bgate + (col - 3072) + 4);
                        v0.x = logsig(v0.x + b0.x) * 0.0625f; v0.y = logsig(v0.y + b0.y) * 0.0625f; v0.z = logsig(v0.z + b0.z) * 0.0625f; v0.w = logsig(v0.w + b0.w) * 0.0625f;
                        v1.x = logsig(v1.x + b1.x) * 0.0625f; v1.y = logsig(v1.y + b1.y) * 0.0625f; v1.z = logsig(v1.z + b1.z) * 0.0625f; v1.w = logsig(v1.w + b1.w) * 0.0625f;
                    } }
                    u32x4 w; w.x = cvtpk(v0.x, v0.y); w.y = cvtpk(v0.z, v0.w); w.z = cvtpk(v1.x, v1.y); w.w = cvtpk(v1.z, v1.w);
                    *(u32x4*)(O + (size_t)row * ldc + col) = w;
                }
            }
    }
};

struct EpiRes {
    static constexpr bool PERM = false;
    const Params* pp; int job;
    __device__ __forceinline__ void operator()(const f32x4 (&acc)[2][2][4][2], const pg8::Unit& u, int wr, int wc, int fr, int fq) const {
        const Params* q_ = pp; asm volatile("" : "+s"(q_));
        bf16_t* XB = (bf16_t*)(q_->ws + WS_XB); float* ssp = (float*)(q_->ws + WS_SSP);
        const int row0 = u.pm * 256 + wr * 64 + fr, col0 = u.pn * 256 + wc * 32 + 4 * fq;
#pragma unroll
        for (int ai = 0; ai < 2; ++ai)
#pragma unroll
            for (int m = 0; m < 4; ++m) {
                const int row = row0 + ai * 128 + m * 16;
                float ss = 0.f;
#pragma unroll
                for (int bj = 0; bj < 2; ++bj)
#pragma unroll
                    for (int n = 0; n < 2; ++n) {
                        const int col = col0 + bj * 128 + n * 16;
                        const u32x2 rb = *(const u32x2*)(XB + (size_t)row * D + col);
                        const f32x4 r = (f32x4){bflo(rb.x), bfhi(rb.x), bflo(rb.y), bfhi(rb.y)};
                        const f32x4 x = r + acc[ai][bj][m][n];
                        { u32x2 w; w.x = cvtpk(x.x, x.y); w.y = cvtpk(x.z, x.w); *(u32x2*)(XB + (size_t)row * D + col) = w; }
                        ss += (x.x * x.x + x.y * x.y) + (x.z * x.z + x.w * x.w);
                    }
                ss += __shfl_xor(ss, 16); ss += __shfl_xor(ss, 32);
                if (fq == 0) ssp[(size_t)row * 16 + u.pn * 4 + wc] = ss;
                if (m & 1) asm volatile("" ::: "memory");
            }
    }
};

struct EpiInC {
    static constexpr bool PERM = false;
    const Params* pp;
    __device__ __forceinline__ void operator()(const f32x4 (&acc)[2][2][4][2], const pg8::Unit& u, int wr, int wc, int fr, int fq) const {
        const Params* q_ = pp; asm volatile("" : "+s"(q_));
        unsigned char* ws = q_->ws;
        const float* ssp = (const float*)(ws + WS_SSP); const float* rot = (const float*)(ws + WS_ROT); bf16_t* CQ = (bf16_t*)(ws + WS_CQ);
        bf16_t* CKVALL = (bf16_t*)(ws + WS_CKVALL); float* krout = q_->out + O_KR; bf16_t* KRALL = (bf16_t*)(ws + WS_KRALL); float* ssq = (float*)(ws + WS_SSQ);
        const int row0 = u.pm * 256 + wr * 64 + fr, col0 = u.pn * 256 + wc * 32 + 4 * fq;

#pragma unroll
        for (int ai = 0; ai < 2; ++ai)
#pragma unroll
            for (int m = 0; m < 4; ++m) {
                const int row = row0 + ai * 128 + m * 16;
                const float rs = rstd_from16(ssp, row);
#pragma unroll
                for (int bj = 0; bj < 2; ++bj) {
                    const int blk = u.pn * 2 + bj;
                    float ss = 0.f;
#pragma unroll
                    for (int n = 0; n < 2; ++n) {
                        const int col = col0 + bj * 128 + n * 16;
                        f32x4 v = acc[ai][bj][m][n] * rs;
                        if (blk < 3) {
                            u32x2 w; w.x = cvtpk(v.x, v.y); w.y = cvtpk(v.z, v.w);
                            *(u32x2*)(CQ + (size_t)row * 384 + col) = w;
                        } else if (blk < 7) {
                            u32x2 w; w.x = cvtpk(v.x, v.y); w.y = cvtpk(v.z, v.w);
                            *(u32x2*)(CKVALL + (size_t)kvtok(row) * 512 + (col - 384)) = w;
                        } else if (col < 960) {
                            const int j = col - 896, i0 = j >> 1;
                            const f32x4 cs = *(const f32x4*)(rot + ((size_t)posidx(row) * 32 + i0) * 2);
                            v = rope4(v, cs);
                            float* ko = krout + (size_t)row * 64;
                            ko[i0] = v.x; ko[32 + i0] = v.y; ko[i0 + 1] = v.z; ko[33 + i0] = v.w;
                            u32x2 w; w.x = cvtpk(v.x, v.y); w.y = cvtpk(v.z, v.w);
                            *(u32x2*)(KRALL + (size_t)kvtok(row) * 64 + j) = w;
                        }
                        ss += (v.x * v.x + v.y * v.y) + (v.z * v.z + v.w * v.w);
                    }
                    ss += __shfl_xor(ss, 16); ss += __shfl_xor(ss, 32);
                    if (fq == 0) ssq[(size_t)row * 32 + blk * 4 + wc] = ss;
                }
                asm volatile("" ::: "memory");
            }
    }
};

__device__ __forceinline__ f32x2 gelu_pk(f32x2 v) {
    const f32x2 av = __builtin_elementwise_abs(v), d = av * 0.2316418882f + 1.0f;
    f32x2 t; t.x = __builtin_amdgcn_rcpf(d.x); t.y = __builtin_amdgcn_rcpf(d.y);
    f32x2 q = t * 0.5307027145f + (-0.7265760135f); q = q * t + 0.7107068705f; q = q * t + (-0.142248368f); q = q * t + 0.127414796f; q = q * t;
    const f32x2 sx = (v * v) * (-0.72134752044f);
    f32x2 e; e.x = __builtin_amdgcn_exp2f(sx.x); e.y = __builtin_amdgcn_exp2f(sx.y);
    const f32x2 m = v * (q * e), r = v - m;
    f32x2 o; o.x = v.x < 0.f ? m.x : r.x; o.y = v.y < 0.f ? m.y : r.y; return o;
}
__device__ __forceinline__ void attn_sample_unit(const Params& p, LAS unsigned char* lds, int b, int h) {
    int tid_ = threadIdx.x; asm volatile("" : "+v"(tid_));
    const int tid = tid_, lane = tid & 63, w = tid >> 6, fr = lane & 15, fq = lane >> 4;
    const bf16_t* Q = (const bf16_t*)(p.ws + WS_Q); const bf16_t* KN = (const bf16_t*)(p.ws + WS_KN);
    const bf16_t* KRA = (const bf16_t*)(p.ws + WS_KRALL); const bf16_t* VT = (const bf16_t*)(p.ws + WS_VT);
    bf16_t* AO = (bf16_t*)(p.ws + WS_AO);
    const int qrow0 = MP + b * DSEQ, kv0 = MP + b * KVS;
    bf16x8 qf[6];
#pragma unroll
    for (int ks = 0; ks < 6; ++ks) qf[ks] = *(const bf16x8*)(Q + (size_t)(qrow0 + fr) * 1536 + h * 192 + ks * 32 + fq * 8);
    f32x4 oacc[8];
#pragma unroll
    for (int dt = 0; dt < 8; ++dt) oacc[dt] = (f32x4){0.f, 0.f, 0.f, 0.f};
    float mrun = -1e30f, lrun = 0.f;
    constexpr int NSTEP = (KVS + 31) / 32;
    bf16x8 kf[2][6];
#define SMP_KLOAD(ss) do { const int kb_ = (ss) * 32; \
        _Pragma("unroll") for (int e = 0; e < 2; ++e) { const size_t tok = (size_t)(kv0 + kb_ + e * 16 + fr); \
            _Pragma("unroll") for (int ks = 0; ks < 4; ++ks) kf[e][ks] = *(const bf16x8*)(KN + tok * 1024 + h * 128 + ks * 32 + fq * 8); \
            _Pragma("unroll") for (int ks = 4; ks < 6; ++ks) kf[e][ks] = *(const bf16x8*)(KRA + tok * 64 + (ks - 4) * 32 + fq * 8); } } while (0)
    if (w < NSTEP) SMP_KLOAD(w);
    for (int st = w; st < NSTEP; st += 8) {
        const int kb = st * 32;
        u32x2 va0[8], va1[8];
#pragma unroll
        for (int dt = 0; dt < 8; ++dt) { const bf16_t* vp = VT + (size_t)(h * 128 + dt * 16 + fr) * NKV + kv0 + kb + fq * 4;
            va0[dt] = *(const u32x2*)vp; va1[dt] = *(const u32x2*)(vp + 16); }
        f32x4 s0 = (f32x4){0.f, 0.f, 0.f, 0.f}, s1 = (f32x4){0.f, 0.f, 0.f, 0.f};
#pragma unroll
        for (int ks = 0; ks < 6; ++ks) { s0 = __builtin_amdgcn_mfma_f32_16x16x32_bf16(kf[0][ks], qf[ks], s0, 0, 0, 0); s1 = __builtin_amdgcn_mfma_f32_16x16x32_bf16(kf[1][ks], qf[ks], s1, 0, 0, 0); }
        if (st + 8 < NSTEP) SMP_KLOAD(st + 8);
        if (kb + 32 > KVS) {
#pragma unroll
            for (int j = 0; j < 4; ++j) { if (kb + fq * 4 + j >= KVS) s0[j] = -1e30f; if (kb + 16 + fq * 4 + j >= KVS) s1[j] = -1e30f; }
        }
        float mx = fmaxf(fmaxf(fmaxf(s0[0], s0[1]), fmaxf(s0[2], s0[3])), fmaxf(fmaxf(s1[0], s1[1]), fmaxf(s1[2], s1[3])));
        mx = fmaxf(mx, __shfl_xor(mx, 16)); mx = fmaxf(mx, __shfl_xor(mx, 32));
        const float mnew = fmaxf(mrun, mx), alpha = __builtin_amdgcn_exp2f(mrun - mnew);
        mrun = mnew;
        float ps = 0.f;
#pragma unroll
        for (int j = 0; j < 4; ++j) { s0[j] = __builtin_amdgcn_exp2f(s0[j] - mnew); s1[j] = __builtin_amdgcn_exp2f(s1[j] - mnew); ps += s0[j] + s1[j]; }
        lrun = lrun * alpha + ps;
        u32x4 wv; wv.x = cvtpk(s0[0], s0[1]); wv.y = cvtpk(s0[2], s0[3]); wv.z = cvtpk(s1[0], s1[1]); wv.w = cvtpk(s1[2], s1[3]);
        const bf16x8 pf = __builtin_bit_cast(bf16x8, wv);
#pragma unroll
        for (int dt = 0; dt < 8; ++dt) {
            const bf16x8 vf = __builtin_bit_cast(bf16x8, (u32x4){va0[dt].x, va0[dt].y, va1[dt].x, va1[dt].y});
            oacc[dt] = __builtin_amdgcn_mfma_f32_16x16x32_bf16(vf, pf, oacc[dt] * alpha, 0, 0, 0);
        }
    }
#undef SMP_KLOAD
    { float l = lrun; l += __shfl_xor(l, 16); l += __shfl_xor(l, 32);
      LAS float* OW = (LAS float*)(lds + w * 8192); LAS float* ML = (LAS float*)(lds + 65536 + w * 128);
#pragma unroll
      for (int dt = 0; dt < 8; ++dt)
#pragma unroll
          for (int j = 0; j < 4; ++j) OW[(dt * 16 + fq * 4 + j) * 16 + fr] = oacc[dt][j];
      if (fq == 0) { ML[fr] = mrun; ML[16 + fr] = l; } }
    __syncthreads();
    { const int q = tid & 15, dc = tid >> 4;
      float mw[8], M_ = -1e30f;
#pragma unroll
      for (int ww = 0; ww < 8; ++ww) { mw[ww] = ((LAS float*)(lds + 65536 + ww * 128))[q]; M_ = fmaxf(M_, mw[ww]); }
      float L_ = 0.f, o[4] = {0.f, 0.f, 0.f, 0.f};
#pragma unroll
      for (int ww = 0; ww < 8; ++ww) { const float sc = __builtin_amdgcn_exp2f(mw[ww] - M_); L_ += sc * ((LAS float*)(lds + 65536 + ww * 128))[16 + q];
          const LAS float* OW = (LAS float*)(lds + ww * 8192);
#pragma unroll
          for (int i = 0; i < 4; ++i) o[i] += sc * OW[(dc * 4 + i) * 16 + q]; }
      const float inv = 1.f / L_;
      u32x2 wv; wv.x = cvtpk(o[0] * inv, o[1] * inv); wv.y = cvtpk(o[2] * inv, o[3] * inv);
      *(u32x2*)(AO + (size_t)(qrow0 + q) * D + h * 128 + dc * 4) = wv; }
    __syncthreads();
}

struct EpiFfn {
    static constexpr bool PERM = true;
    const Params* pp; int layer;
    __device__ __forceinline__ void operator()(f32x4 (&acc)[2][2][4][2], const pg8::Unit& u, int wr_, int wc_, int fr_, int fq_) const {
        const Params* q_ = pp; asm volatile("" : "+s"(q_));
        int wr = wr_, wc = wc_, fr = fr_, fq = fq_;
        asm volatile("" : "+s"(wr), "+s"(wc), "+v"(fr), "+v"(fq));
        unsigned char* ws = q_->ws;
        const float* rsp = (const float*)(ws + WS_RS);
        const int row0 = u.pm * 256 + wr * 64 + fr;
#pragma unroll
        for (int ai = 0; ai < 2; ++ai)
#pragma unroll
            for (int m = 0; m < 4; ++m) {
                const float rs = rsp[row0 + ai * 128 + m * 16];
#pragma unroll
                for (int bj = 0; bj < 2; ++bj)
#pragma unroll
                    for (int n = 0; n < 2; ++n) acc[ai][bj][m][n] *= rs;
                if (m & 1) asm volatile("" ::: "memory");
            }
        bf16_t* ACT = (bf16_t*)(ws + WS_ACT); bf16_t* SA = (bf16_t*)(ws + WS_SIDEA); bf16_t* SB = (bf16_t*)(ws + WS_SIDEB); bf16_t* SU = (bf16_t*)(ws + WS_SIDEU);
        const float* wd = q_->in[I_WDW] + (size_t)layer * 3 * DFF; const float* bd = q_->in[I_BDW] + (size_t)layer * DFF;
        const int lane = fq * 16 + fr, src1 = (lane & 48) | ((fr + 15) & 15), src2 = (lane & 48) | ((fr + 14) & 15);
        const bool smp = u.pm * 256 >= MP;
#pragma unroll
        for (int n = 0; n < 2; ++n) {
            asm volatile("" ::: "memory");
            int col = u.pn * 128 + wc * 32 + 8 * fq + 4 * n;
            asm volatile("" : "+v"(col));
            const f32x4 w0 = *(const f32x4*)(wd + col), w1 = *(const f32x4*)(wd + DFF + col), w2 = *(const f32x4*)(wd + 2 * DFF + col), bi = *(const f32x4*)(bd + col);
#pragma unroll
            for (int ai = 0; ai < 2; ++ai) {
                f32x4 pr1 = (f32x4){0.f, 0.f, 0.f, 0.f}, pr2 = pr1;
#pragma unroll
                for (int m = 0; m < 4; ++m) {
                    int row = row0 + ai * 128 + m * 16;
                    asm volatile("" : "+v"(row));
                    const f32x4 a = acc[ai][0][m][n], uu = acc[ai][1][m][n];
                    f32x4 r1, r2;
#pragma unroll
                    for (int e = 0; e < 4; ++e) { r1[e] = __shfl(a[e], src1); r2[e] = __shfl(a[e], src2); }
                    const f32x4 p1 = fr >= 1 ? r1 : pr1, p2 = fr >= 2 ? r2 : pr2;
                    const bool deferred = smp ? (fr < 2) : (m == 0 && fr < 2);
                    const int blk = smp ? (MP / 64 + ((row - MP) >> 4)) : (row >> 6);
                    if (!deferred) {
                        const f32x4 cv = bi + p2 * w0 + p1 * w1 + a * w2;
                        const f32x2 g0 = gelu_pk((f32x2){cv.x, cv.y}), g1 = gelu_pk((f32x2){cv.z, cv.w});
                        u32x2 o; o.x = cvtpk(g0.x * uu.x, g0.y * uu.y); o.y = cvtpk(g1.x * uu.z, g1.y * uu.w);
                        *(u32x2*)(ACT + (size_t)row * DFF + col) = o;
                    } else {
                        u32x2 oa, ou; oa.x = cvtpk(a.x, a.y); oa.y = cvtpk(a.z, a.w); ou.x = cvtpk(uu.x, uu.y); ou.y = cvtpk(uu.z, uu.w);
                        *(u32x2*)(SB + ((size_t)blk * 2 + fr) * DFF + col) = oa; *(u32x2*)(SU + ((size_t)blk * 2 + fr) * DFF + col) = ou;
                    }
                    if (fr >= 14 && (smp || m == 3)) { u32x2 oa; oa.x = cvtpk(a.x, a.y); oa.y = cvtpk(a.z, a.w); *(u32x2*)(SA + ((size_t)blk * 2 + (fr - 14)) * DFF + col) = oa; }
                    pr1 = r1; pr2 = r2;
                    __builtin_amdgcn_sched_barrier(0);
                }
            }
        }
    }
};

template <class F> __device__ __forceinline__ void tr_item(const F& f, int K, bf16_t* WT, int item, int nblk, LAS float* scr, int lane) {
    const int kb = item / nblk, nb = item % nblk, k0 = 64 * kb, n0 = 32 * nb;
#pragma unroll 4
    for (int i = 0; i < 32; ++i) { const int kk = 2 * i + (lane >> 5); scr[kk * 33 + (lane & 31)] = f(k0 + kk, n0 + (lane & 31)); }
    asm volatile("s_waitcnt lgkmcnt(0)" ::: "memory");
    const int c = lane & 7;
#pragma unroll
    for (int j = 0; j < 4; ++j) { const int n = (lane >> 3) + 8 * j; const LAS float* s = scr + (8 * c) * 33 + n;
        u32x4 o; o.x = cvtpk(s[0 * 33], s[1 * 33]); o.y = cvtpk(s[2 * 33], s[3 * 33]); o.z = cvtpk(s[4 * 33], s[5 * 33]); o.w = cvtpk(s[6 * 33], s[7 * 33]);
        *(u32x4*)(WT + (size_t)(n0 + n) * K + k0 + 8 * c) = o; }
    asm volatile("s_waitcnt lgkmcnt(0)" ::: "memory");
}
template <bool FFNPERM = false>
__device__ __forceinline__ void tr_item_plain(const float* W, int ldw, const float* g, int K, bf16_t* WT, int item, int nblk, LAS float* scr, int lane) {
    const int kb = item / nblk, nb = item % nblk, k0 = 64 * kb, n0 = 32 * nb;
    const int c4 = (lane & 7) * 4, kr = lane >> 3;
    const int ns = FFNPERM ? (((n0 & 255) >> 7) * DFF + (n0 >> 8) * 128 + (n0 & 127)) : n0;
#pragma unroll
    for (int i = 0; i < 8; ++i) { const int kk = i * 8 + kr; f32x4 v = *(const f32x4*)(W + (size_t)(k0 + kk) * ldw + ns + c4);
        if (g) v = v * g[k0 + kk];
        scr[kk * 33 + c4] = v.x; scr[kk * 33 + c4 + 1] = v.y; scr[kk * 33 + c4 + 2] = v.z; scr[kk * 33 + c4 + 3] = v.w; }
    asm volatile("s_waitcnt lgkmcnt(0)" ::: "memory");
    const int c = lane & 7;
#pragma unroll
    for (int j = 0; j < 4; ++j) { const int n = (lane >> 3) + 8 * j; const LAS float* s = scr + (8 * c) * 33 + n;
        u32x4 o; o.x = cvtpk(s[0 * 33], s[1 * 33]); o.y = cvtpk(s[2 * 33], s[3 * 33]); o.z = cvtpk(s[4 * 33], s[5 * 33]); o.w = cvtpk(s[6 * 33], s[7 * 33]);
        *(u32x4*)(WT + (size_t)(n0 + n) * K + k0 + 8 * c) = o; }
    asm volatile("s_waitcnt lgkmcnt(0)" ::: "memory");
}
struct FPlain { const float* W; int ldw; const float* g; float sc;
    __device__ __forceinline__ float operator()(int k, int n) const { float v = W[(size_t)k * ldw + n] * sc; if (g) v *= g[k]; return v; } };
struct FInAB { const float* W; const float* g; const float* wgu;
    __device__ __forceinline__ float operator()(int k, int n) const {
        const float* wr = W + (size_t)k * 3088; float v;
        if (n < 1536) { v = wr[n]; if (n < 256) v *= 0.125f; }
        else if (n < 2048) { const int q = n - 1536, isk = q >> 8, r = q & 255, h = r >> 6, j = r & 63, i = j >> 1, hf = j & 1;
            v = wr[(isk ? 1808 : 1552) + h * 64 + hf * 32 + i]; if (isk) v *= 0.125f; }
        else if (n < 3072) { v = wr[n + 16]; }
        else { const int c = n - 3072; float s = 0.f;
#pragma unroll
            for (int r = 0; r < 16; ++r) s += wr[1536 + r] * wgu[r * 256 + c];
            v = s; }
        return v * g[k];
    } };
struct FInC { const float* W; const float* g;
    __device__ __forceinline__ float operator()(int k, int n) const {
        const float* wr = W + (size_t)k * 960; float v;
        if (n < 896) v = wr[n];
        else if (n < 960) { const int j = n - 896; v = wr[896 + (j & 1) * 32 + (j >> 1)]; }
        else v = 0.f;
        return v * g[k];
    } };
struct FUq { const float* W; const float* g; float sc;
    __device__ __forceinline__ float operator()(int k, int n) const {
        const int h = n / 192, j = n % 192; int src = n;
        if (j >= 128) { const int jj = j - 128; src = h * 192 + 128 + (jj & 1) * 32 + (jj >> 1); }
        return W[(size_t)k * 1536 + src] * g[k] * sc;
    } };

struct FQl { const float* wuq; const float* wuk; const float* g; float sc;
    __device__ __forceinline__ float operator()(int k, int n) const {
        const int h = n >> 9, l = n & 511; const float* a = wuq + (size_t)k * 1536 + h * 192; const float* b = wuk + ((size_t)l * 8 + h) * 128;
        float s0 = 0.f, s1 = 0.f;
#pragma unroll 8
        for (int q = 0; q < 128; q += 2) { s0 += a[q] * b[q]; s1 += a[q + 1] * b[q + 1]; }
        return (s0 + s1) * g[k] * sc;
    } };

__device__ __forceinline__ bf16x8 cvt8(const float* p) { const f32x4 a = *(const f32x4*)p, b = *(const f32x4*)(p + 4); u32x4 w; w.x = cvtpk(a.x, a.y); w.y = cvtpk(a.z, a.w); w.z = cvtpk(b.x, b.y); w.w = cvtpk(b.z, b.w); return __builtin_bit_cast(bf16x8, w); }
__device__ __forceinline__ void fold_wql(const Params& p, int vb, int nvb) {
    int tid_ = threadIdx.x; asm volatile("" : "+v"(tid_));
    const int lane = tid_ & 63, wave = tid_ >> 6, fr = lane & 15, fq = lane >> 4;
    const float* wuq = p.in[I_WUQ]; const float* wuk = p.in[I_WUK]; const float* g = p.in[I_GQ];
    bf16_t* WQL = (bf16_t*)(p.ws + WS_W_QL);
    const float sc = 0.07216878364870322f * 1.4426950408889634f;
    for (int it = vb * 8 + wave; it < 8 * 32 * 24; it += nvb * 8) {
        const int h = it / (32 * 24), lt = (it / 24) % 32, kt = it % 24;
        const float* ap = wuk + ((size_t)(lt * 16 + fr) * 8 + h) * 128 + fq * 8;
        const float* bp = wuq + (size_t)(kt * 16 + fr) * 1536 + h * 192 + fq * 8;
        f32x4 acc = (f32x4){0.f, 0.f, 0.f, 0.f};
#pragma unroll
        for (int ks = 0; ks < 4; ++ks) acc = __builtin_amdgcn_mfma_f32_16x16x32_bf16(cvt8(ap + ks * 32), cvt8(bp + ks * 32), acc, 0, 0, 0);
        const int kk = kt * 16 + fr; const float gs = g[kk] * sc;
#pragma unroll
        for (int j = 0; j < 4; ++j) WQL[(size_t)(h * 512 + lt * 16 + fq * 4 + j) * 384 + kk] = (bf16_t)(cvtpk(acc[j] * gs, 0.f) & 0xffff);
    }
}

__device__ __forceinline__ float wave_sum(float v) {
#pragma unroll
    for (int o = 1; o < 64; o <<= 1) v += __shfl_xor(v, o);
    return v;
}

__device__ __forceinline__ void phase_prologue(const Params& p, LAS unsigned char* lds, int which, int vb, int nvb) {
    int tid_ = threadIdx.x; asm volatile("" : "+v"(tid_));
    const int tid = tid_, lane = tid & 63, wave = tid >> 6;
    const int gw = vb * 8 + wave, NGW = nvb * 8;
    LAS float* scr = (LAS float*)(lds + wave * 16384);
    unsigned char* ws = p.ws;
    constexpr int I1 = 16 * (NAB / 32), I2 = 16 * 32, I3 = 16 * (5632 / 32), I4 = 44 * 32, I5 = 16 * 32, I6 = 6 * 48, I7 = 8 * 32, I8 = 8 * 32, I9 = 16 * 32;
    constexpr int NIT = I1 + I2 + 2 * I3 + 2 * I4 + I5 + I6 + I7 + I8 + I9;
    for (int it = gw; it < NIT; it += NGW) {
        int r = it;
        { int cls = it < I1 ? 0 : 1;
          const int r3 = it - (I1 + I2); if (r3 >= I3 && r3 < 2 * I3) cls = 2;
          const int r4 = r3 - 2 * I3; if (r4 >= I4 && r4 < 2 * I4) cls = 2;
          if (!((which >> cls) & 1)) continue; }
        if (r < I1) { FInAB f{p.in[I_WINAB], p.in[I_NMIX], p.in[I_WGU]}; tr_item(f, 1024, (bf16_t*)(ws + WS_W_INAB), r, NAB / 32, scr, lane); continue; } r -= I1;
        if (r < I2) { tr_item_plain(p.in[I_WOUTAB], 1024, nullptr, 1024, (bf16_t*)(ws + WS_W_OUTAB), r, 32, scr, lane); continue; } r -= I2;
        if (r < 2 * I3) { const int l = r / I3; r -= l * I3; tr_item_plain<true>(p.in[I_WFFNIN] + (size_t)l * 1024 * 5632, 5632, p.in[I_NFFN] + l * 1024, 1024, (bf16_t*)(ws + WS_W_FFNIN) + (size_t)l * 5632 * 1024, r, 176, scr, lane); continue; } r -= 2 * I3;
        if (r < 2 * I4) { const int l = r / I4; r -= l * I4; tr_item_plain(p.in[I_WFFNOUT] + (size_t)l * 2816 * 1024, 1024, nullptr, 2816, (bf16_t*)(ws + WS_W_FFNOUT) + (size_t)l * 1024 * 2816, r, 32, scr, lane); continue; } r -= 2 * I4;
        if (r < I5) { FInC f{p.in[I_WINC], p.in[I_NMIX] + 1024}; tr_item(f, 1024, (bf16_t*)(ws + WS_W_INC), r, 32, scr, lane); continue; } r -= I5;
        if (r < I6) { FUq f{p.in[I_WUQ], p.in[I_GQ], 0.07216878364870322f * 1.4426950408889634f}; tr_item(f, 384, (bf16_t*)(ws + WS_W_UQ), r, 48, scr, lane); continue; } r -= I6;
        if (r < I7) { tr_item_plain(p.in[I_WUK], 1024, nullptr, 512, (bf16_t*)(ws + WS_W_UK), r, 32, scr, lane); continue; } r -= I7;
        if (r < I8) { tr_item_plain(p.in[I_WUV], 1024, nullptr, 512, (bf16_t*)(ws + WS_W_UV), r, 32, scr, lane); continue; } r -= I8;
        { tr_item_plain(p.in[I_WOUTC], 1024, nullptr, 1024, (bf16_t*)(ws + WS_W_OUTC), r, 32, scr, lane); }
    }
    if (!(which & 1)) return;
    bf16_t* XB = (bf16_t*)(ws + WS_XB); float* ssp = (float*)(ws + WS_SSP);
    for (int row = gw; row < M; row += NGW) {
        const float* x = row < MP ? p.in[I_XP] + (size_t)row * D : p.in[I_XS] + (size_t)(row - MP) * D;
        float ss = 0.f;
#pragma unroll
        for (int j = 0; j < 4; ++j) { const f32x4 v = *(const f32x4*)(x + j * 256 + lane * 4); ss += (v.x * v.x + v.y * v.y) + (v.z * v.z + v.w * v.w);
            u32x2 w; w.x = cvtpk(v.x, v.y); w.y = cvtpk(v.z, v.w); *(u32x2*)(XB + (size_t)row * D + j * 256 + lane * 4) = w; }
        ss = wave_sum(ss);
        if (lane < 16) ssp[(size_t)row * 16 + lane] = lane == 0 ? ss : 0.f;
    }
    float* rot = (float*)(ws + WS_ROT);
    for (int idx = vb * 512 + tid; idx < NPOS * 32; idx += nvb * 512) {
        const int pi = idx >> 5, i = idx & 31; const double pos = (double)(pi < SEQ ? pi : PAST + (pi - SEQ));
        double fr = 1.0; for (int q = 0; q < i; ++q) fr *= 0.7498942093324559;
        const double ang = pos * fr; const double TWO_PI = 6.283185307179586476925287;
        const double kq = __builtin_rint(ang / TWO_PI); const double r = ang - kq * TWO_PI; const double r2 = r * r;
        double sn = 0.0, cn = 0.0, ts = r, tc = 1.0;
        for (int q = 0; q < 15; ++q) { sn += ts; cn += tc; tc = -tc * r2 / (double)((2 * q + 1) * (2 * q + 2)); ts = -ts * r2 / (double)((2 * q + 2) * (2 * q + 3)); }
        rot[(size_t)idx * 2] = (float)cn; rot[(size_t)idx * 2 + 1] = (float)sn;
    }
}

constexpr int SK = 72;
constexpr int L_QR = 0, L_KR = 9216, L_QD = 18432, L_KD = 27648, L_SC = 36864, L_VT = 46080, L_ST = 64512, L_O = 82944, L_SEG = 116736, L_BREF = 118784, L_BLAST = 119040;
constexpr int OS = 132;

__device__ __forceinline__ bf16x8 ldfrag(const LAS unsigned char* base, int row, int col) { return *(const LAS bf16x8*)(base + (row * SK + col) * 2); }

__device__ __forceinline__ void dla_unit(const Params& p, LAS unsigned char* lds, int u) {
    int tid_ = threadIdx.x; asm volatile("" : "+v"(tid_));
    const int tid = tid_, lane = tid & 63, w = tid >> 6, fr = lane & 15, fq = lane >> 4;
    int mixer, b, h, row0, T, c; const float* s_in; float* s_out;
    if (u < 128) { mixer = u >> 6; b = (u & 63) >> 2; h = u & 3; row0 = b * SEQ; T = SEQ; c = 64; s_in = nullptr;
        s_out = p.out + (mixer ? O_RET_P : O_GLA_P) + (size_t)(b * 4 + h) * 64 * 128; }
    else { const int v = u - 128; mixer = v >> 7; b = (v & 127) >> 2; h = v & 3; row0 = MP + b * DSEQ; T = DSEQ; c = 16;
        s_in = p.in[mixer ? I_SRET : I_SGLA] + (size_t)(b * 4 + h) * 64 * 128;
        s_out = p.out + (mixer ? O_RET_S : O_GLA_S) + (size_t)(b * 4 + h) * 64 * 128; }
    const bf16_t* P = (const bf16_t*)(p.ws + WS_P);
    bf16_t* MIX = (bf16_t*)(p.ws + WS_MIX);
    const int qc = (mixer ? 1536 : 0) + h * 64, kc = (mixer ? 1792 : 256) + h * 64, vc0 = (mixer ? 2048 : 512) + h * 128, gc0 = (mixer ? 2560 : 1024) + h * 128, lac = 3072 + h * 64;
    const float* gn = p.in[mixer ? I_GRET : I_GGLA] + h * 128;
    const float lgam = log1pf(-exp2f(-5.0f - (float)h));
    const int tref = (c - 1) >> 1;
    LAS float* SEG = (LAS float*)(lds + L_SEG); LAS float* BREF = (LAS float*)(lds + L_BREF); LAS float* BLAST = (LAS float*)(lds + L_BLAST);
    LAS float* OL = (LAS float*)(lds + L_O);
    const int kr = w & 3, vt0 = (w >> 2) * 4;
    f32x4 Sacc[4];
#pragma unroll
    for (int i = 0; i < 4; ++i) {
        if (s_in) { for (int j = 0; j < 4; ++j) { const int km = kr * 16 + fq * 4 + j, ko = mixer ? ((km & 1) * 32 + (km >> 1)) : km;
            Sacc[i][j] = s_in[(size_t)ko * 128 + (vt0 + i) * 16 + fr]; } }
        else Sacc[i] = (f32x4){0.f, 0.f, 0.f, 0.f};
    }
    __syncthreads();
#pragma unroll
    for (int i = 0; i < 4; ++i) { u32x2 wv; wv.x = cvtpk(Sacc[i][0], Sacc[i][1]); wv.y = cvtpk(Sacc[i][2], Sacc[i][3]);
        *(LAS u32x2*)(lds + L_ST + (((vt0 + i) * 16 + fr) * SK + kr * 16 + fq * 4) * 2) = wv; }
    const int kcol = lane, seg = w;
    const int nch = T / c;
    unsigned short la_r[8], q_r[8], k_r[8], v_r[16];
    const int vv_ = tid & 127, sg_ = tid >> 7;
#define DLA_LOAD(rr) do { \
        _Pragma("unroll") for (int i = 0; i < 8; ++i) { const int t = seg * 8 + i; const bool ok = t < c; const size_t ro = (size_t)((rr) + (ok ? t : 0)) * NAB; \
            la_r[i] = (ok && !mixer) ? P[ro + lac + kcol] : (unsigned short)0; q_r[i] = ok ? P[ro + qc + kcol] : (unsigned short)0; k_r[i] = ok ? P[ro + kc + kcol] : (unsigned short)0; } \
        _Pragma("unroll") for (int i = 0; i < 16; ++i) { const int s_ = sg_ * 16 + i; v_r[i] = (s_ < c) ? P[(size_t)((rr) + s_) * NAB + vc0 + vv_] : (unsigned short)0; } } while (0)
    DLA_LOAD(row0);
    float gnv[16];
#pragma unroll
    for (int i = 0; i < 16; ++i) gnv[i] = gn[(tid & 7) * 16 + i];
    for (int n = 0; n < nch; ++n) {
        const int r0 = row0 + n * c;
        float bb[8];
        {
            float run = 0.f;
#pragma unroll
            for (int i = 0; i < 8; ++i) { const int t = seg * 8 + i; float la = 0.f;
                if (t < c) la = mixer ? lgam : bf2f(la_r[i]);
                run += la; bb[i] = run; }
            SEG[seg * 64 + kcol] = run;
        }
        __syncthreads();
        {
            float off = 0.f;
            for (int s = 0; s < seg; ++s) off += SEG[s * 64 + kcol];
#pragma unroll
            for (int i = 0; i < 8; ++i) { bb[i] += off; if (seg * 8 + i == tref) BREF[kcol] = bb[i]; if (seg * 8 + i == 63) BLAST[kcol] = bb[i]; }
        }
        __syncthreads();
        {
            const float bref = BREF[kcol], blast = BLAST[kcol];
            float kd[8];
#pragma unroll
            for (int i = 0; i < 8; ++i) { const int t = seg * 8 + i; const float q = bf2f(q_r[i]), k = bf2f(k_r[i]);
                const float e1 = __expf(bb[i] - bref), e2 = __expf(bref - bb[i]), e3 = __expf(bb[i]), e4 = __expf(blast - bb[i]);
                *(LAS bf16_t*)(lds + L_QR + (t * SK + kcol) * 2) = (bf16_t)(cvtpk(q * e1, 0.f) & 0xffff);
                *(LAS bf16_t*)(lds + L_KR + (t * SK + kcol) * 2) = (bf16_t)(cvtpk(k * e2, 0.f) & 0xffff);
                *(LAS bf16_t*)(lds + L_QD + (t * SK + kcol) * 2) = (bf16_t)(cvtpk(q * e3, 0.f) & 0xffff);
                kd[i] = k * e4; }
            u32x4 wv; wv.x = cvtpk(kd[0], kd[1]); wv.y = cvtpk(kd[2], kd[3]); wv.z = cvtpk(kd[4], kd[5]); wv.w = cvtpk(kd[6], kd[7]);
            *(LAS u32x4*)(lds + L_KD + (kcol * SK + seg * 8) * 2) = wv;
            const int v = tid & 127, sg = tid >> 7;
            float vv[16];
#pragma unroll
            for (int i = 0; i < 16; ++i) vv[i] = bf2f(v_r[i]);
            u32x4 w0, w1; w0.x = cvtpk(vv[0], vv[1]); w0.y = cvtpk(vv[2], vv[3]); w0.z = cvtpk(vv[4], vv[5]); w0.w = cvtpk(vv[6], vv[7]);
            w1.x = cvtpk(vv[8], vv[9]); w1.y = cvtpk(vv[10], vv[11]); w1.z = cvtpk(vv[12], vv[13]); w1.w = cvtpk(vv[14], vv[15]);
            *(LAS u32x4*)(lds + L_VT + (v * SK + sg * 16) * 2) = w0; *(LAS u32x4*)(lds + L_VT + (v * SK + sg * 16 + 8) * 2) = w1;
        }
        if (n + 1 < nch) DLA_LOAD(r0 + c);
        u32x4 gate0, gate1;
        { const int tj = tid >> 3, vsj = (tid & 7) * 16; const size_t rowg = (size_t)(r0 + (tj < c ? tj : 0));
          gate0 = *(const u32x4*)(P + rowg * NAB + gc0 + vsj); gate1 = *(const u32x4*)(P + rowg * NAB + gc0 + vsj + 8); }
        __syncthreads();
        {
            const int tr = w & 3;
#pragma unroll
            for (int e = 0; e < 2; ++e) { const int sc = (w >> 2) * 2 + e; f32x4 a = (f32x4){0.f, 0.f, 0.f, 0.f};
#pragma unroll
                for (int ks = 0; ks < 2; ++ks) a = __builtin_amdgcn_mfma_f32_16x16x32_bf16(ldfrag(lds + L_QR, tr * 16 + fr, ks * 32 + fq * 8), ldfrag(lds + L_KR, sc * 16 + fr, ks * 32 + fq * 8), a, 0, 0, 0);
#pragma unroll
                for (int j = 0; j < 4; ++j) { const int t = tr * 16 + fq * 4 + j, s = sc * 16 + fr; const float val = (s <= t) ? a[j] : 0.f;
                    *(LAS bf16_t*)(lds + L_SC + (t * SK + s) * 2) = (bf16_t)(cvtpk(val, 0.f) & 0xffff); } }
        }
        __syncthreads();
        {
            const int tr = w & 3;
#pragma unroll
            for (int i = 0; i < 4; ++i) { const int vt = vt0 + i; f32x4 a = (f32x4){0.f, 0.f, 0.f, 0.f};
#pragma unroll
                for (int ks = 0; ks < 2; ++ks) {
                    a = __builtin_amdgcn_mfma_f32_16x16x32_bf16(ldfrag(lds + L_SC, tr * 16 + fr, ks * 32 + fq * 8), ldfrag(lds + L_VT, vt * 16 + fr, ks * 32 + fq * 8), a, 0, 0, 0);
                    a = __builtin_amdgcn_mfma_f32_16x16x32_bf16(ldfrag(lds + L_QD, tr * 16 + fr, ks * 32 + fq * 8), ldfrag(lds + L_ST, vt * 16 + fr, ks * 32 + fq * 8), a, 0, 0, 0); }
#pragma unroll
                for (int j = 0; j < 4; ++j) OL[(tr * 16 + fq * 4 + j) * OS + vt * 16 + fr] = a[j]; }
            float dec[4];
#pragma unroll
            for (int j = 0; j < 4; ++j) dec[j] = __expf(BLAST[kr * 16 + fq * 4 + j]);
#pragma unroll
            for (int i = 0; i < 4; ++i) { const int vt = vt0 + i; f32x4 a = Sacc[i];
#pragma unroll
                for (int j = 0; j < 4; ++j) a[j] *= dec[j];
#pragma unroll
                for (int ks = 0; ks < 2; ++ks) a = __builtin_amdgcn_mfma_f32_16x16x32_bf16(ldfrag(lds + L_KD, kr * 16 + fr, ks * 32 + fq * 8), ldfrag(lds + L_VT, vt * 16 + fr, ks * 32 + fq * 8), a, 0, 0, 0);
                Sacc[i] = a; }
        }
        __syncthreads();
#pragma unroll
        for (int i = 0; i < 4; ++i) { u32x2 wv; wv.x = cvtpk(Sacc[i][0], Sacc[i][1]); wv.y = cvtpk(Sacc[i][2], Sacc[i][3]);
            *(LAS u32x2*)(lds + L_ST + (((vt0 + i) * 16 + fr) * SK + kr * 16 + fq * 4) * 2) = wv; }
        {
            const int t = tid >> 3, vs = (tid & 7) * 16;
            float o[16]; float s1 = 0.f, s2 = 0.f;
#pragma unroll
            for (int i = 0; i < 16; ++i) { o[i] = OL[t * OS + vs + i]; s1 += o[i]; s2 += o[i] * o[i]; }
            s1 += __shfl_xor(s1, 1); s1 += __shfl_xor(s1, 2); s1 += __shfl_xor(s1, 4);
            s2 += __shfl_xor(s2, 1); s2 += __shfl_xor(s2, 2); s2 += __shfl_xor(s2, 4);
            float mu = 0.f, rs;
            if (mixer) { mu = s1 * (1.f / 128.f); const float var = fmaxf(s2 * (1.f / 128.f) - mu * mu, 0.f); rs = rsqrtf(var + EPS); }
            else rs = rsqrtf(s2 * (1.f / 128.f) + EPS);
            if (t < c) {
                const size_t rowg = (size_t)(r0 + t);
                const unsigned gw[8] = {gate0.x, gate0.y, gate0.z, gate0.w, gate1.x, gate1.y, gate1.z, gate1.w};
                unsigned ow[8];
#pragma unroll
                for (int i = 0; i < 8; ++i) {
                    const float ga = bflo(gw[i]), gb = bfhi(gw[i]);
                    const float ya = (o[2 * i] - mu) * rs * gnv[2 * i] * (ga / (1.f + __expf(-ga)));
                    const float yb = (o[2 * i + 1] - mu) * rs * gnv[2 * i + 1] * (gb / (1.f + __expf(-gb)));
                    ow[i] = cvtpk(ya, yb); }
                bf16_t* mo = MIX + rowg * D + mixer * 512 + h * 128 + vs;
                *(u32x4*)mo = (u32x4){ow[0], ow[1], ow[2], ow[3]}; *(u32x4*)(mo + 8) = (u32x4){ow[4], ow[5], ow[6], ow[7]};
            }
        }
    }
#pragma unroll
    for (int i = 0; i < 4; ++i)
#pragma unroll
        for (int j = 0; j < 4; ++j) { const int km = kr * 16 + fq * 4 + j, ko = mixer ? ((km & 1) * 32 + (km >> 1)) : km;
            s_out[(size_t)ko * 128 + (vt0 + i) * 16 + fr] = Sacc[i][j]; }
    __syncthreads();
}

constexpr int KST = 200;
constexpr int L_AK = 0, L_AV = 64 * KST * 2;

__device__ __forceinline__ void attn_tile(const LAS unsigned char* lds, int kb, int klim, int fr, int fq, const bf16x8 (&qf)[2][6], f32x4 (&oacc)[8][2], float (&mrun)[2], float (&lrun)[2]) {
#pragma unroll 1
        for (int half = 0; half < 2; ++half) {
            const int kb2 = kb + half * 32;
            if (kb2 >= klim) break;
            const bool first0 = mrun[0] < -1e29f, first1 = mrun[1] < -1e29f;
            const float mref0 = first0 ? 0.f : mrun[0], mref1 = first1 ? 0.f : mrun[1];
            f32x4 s[2][2];
#pragma unroll
            for (int e = 0; e < 2; ++e) {
                s[e][0] = (f32x4){-mref0, -mref0, -mref0, -mref0}; s[e][1] = (f32x4){-mref1, -mref1, -mref1, -mref1};
#pragma unroll
                for (int kg = 0; kg < 2; ++kg) {
                    bf16x8 kfr[3];
#pragma unroll
                    for (int k3 = 0; k3 < 3; ++k3) kfr[k3] = *(const LAS bf16x8*)(lds + L_AK + (((half * 2 + e) * 16 + fr) * KST + (kg * 3 + k3) * 32 + fq * 8) * 2);
                    __builtin_amdgcn_sched_barrier(0);
#pragma unroll
                    for (int k3 = 0; k3 < 3; ++k3) {
                        s[e][0] = __builtin_amdgcn_mfma_f32_16x16x32_bf16(kfr[k3], qf[0][kg * 3 + k3], s[e][0], 0, 0, 0);
                        s[e][1] = __builtin_amdgcn_mfma_f32_16x16x32_bf16(kfr[k3], qf[1][kg * 3 + k3], s[e][1], 0, 0, 0); }
                    __builtin_amdgcn_sched_barrier(0);
                }
            }
            if (kb2 + 32 > klim) {
#pragma unroll
                for (int e = 0; e < 2; ++e)
#pragma unroll
                    for (int j = 0; j < 4; ++j) if (kb2 + e * 16 + fq * 4 + j >= klim) { s[e][0][j] = -1e30f; s[e][1][j] = -1e30f; }
            }
            float dl[2];
#pragma unroll
            for (int qt = 0; qt < 2; ++qt) {
                float mx = fmaxf(fmaxf(fmaxf(s[0][qt][0], s[0][qt][1]), fmaxf(s[0][qt][2], s[0][qt][3])), fmaxf(fmaxf(s[1][qt][0], s[1][qt][1]), fmaxf(s[1][qt][2], s[1][qt][3])));
                mx = fmaxf(mx, __shfl_xor(mx, 16)); mx = fmaxf(mx, __shfl_xor(mx, 32));
                dl[qt] = (qt ? first1 : first0) ? mx : fmaxf(mx, 0.f);
            }
            if (__any(dl[0] != 0.f || dl[1] != 0.f)) {
#pragma unroll
                for (int qt = 0; qt < 2; ++qt) {
                    const float alpha = __builtin_amdgcn_exp2f(-dl[qt]);
                    const float al = (qt ? first1 : first0) ? 0.f : alpha;
                    mrun[qt] = (qt ? mref1 : mref0) + dl[qt];
                    lrun[qt] *= al;
#pragma unroll
                    for (int dt = 0; dt < 8; ++dt) oacc[dt][qt] *= al;
#pragma unroll
                    for (int e = 0; e < 2; ++e)
#pragma unroll
                        for (int j = 0; j < 4; ++j) s[e][qt][j] -= dl[qt];
                }
            }
            bf16x8 pf[2];
#pragma unroll
            for (int qt = 0; qt < 2; ++qt) {
                float ps = 0.f;
#pragma unroll
                for (int e = 0; e < 2; ++e)
#pragma unroll
                    for (int j = 0; j < 4; ++j) { const float ex = __builtin_amdgcn_exp2f(s[e][qt][j]); s[e][qt][j] = ex; ps += ex; }
                lrun[qt] += ps;
                u32x4 wv;
                wv.x = cvtpk(s[0][qt][0], s[0][qt][1]); wv.y = cvtpk(s[0][qt][2], s[0][qt][3]);
                wv.z = cvtpk(s[1][qt][0], s[1][qt][1]); wv.w = cvtpk(s[1][qt][2], s[1][qt][3]);
                pf[qt] = __builtin_bit_cast(bf16x8, wv);
            }
#pragma unroll
            for (int dg = 0; dg < 2; ++dg) {
                u32x2 va0[4], va1[4];
#pragma unroll
                for (int d4 = 0; d4 < 4; ++d4) { const int dt = dg * 4 + d4;
                    va0[d4] = *(const LAS u32x2*)(lds + L_AV + ((dt * 16 + fr) * SK + half * 32 + fq * 4) * 2);
                    va1[d4] = *(const LAS u32x2*)(lds + L_AV + ((dt * 16 + fr) * SK + half * 32 + 16 + fq * 4) * 2); }
                __builtin_amdgcn_sched_barrier(0);
#pragma unroll
                for (int d4 = 0; d4 < 4; ++d4) { const int dt = dg * 4 + d4;
                    const bf16x8 vf = __builtin_bit_cast(bf16x8, (u32x4){va0[d4].x, va0[d4].y, va1[d4].x, va1[d4].y});
                    oacc[dt][0] = __builtin_amdgcn_mfma_f32_16x16x32_bf16(vf, pf[0], oacc[dt][0], 0, 0, 0);
                    oacc[dt][1] = __builtin_amdgcn_mfma_f32_16x16x32_bf16(vf, pf[1], oacc[dt][1], 0, 0, 0); }
                __builtin_amdgcn_sched_barrier(0);
            }
        }
}

__device__ __forceinline__ void attn_unit(const Params& p, LAS unsigned char* lds, int qrow0, int nqv, int kv0, int nkeys_unit, int h, bool causal) {
    int tid_ = threadIdx.x; asm volatile("" : "+v"(tid_));
    const int tid = tid_, lane = tid & 63, w = tid >> 6, fr = lane & 15, fq = lane >> 4;
    const bf16_t* Q = (const bf16_t*)(p.ws + WS_Q); const bf16_t* KN = (const bf16_t*)(p.ws + WS_KN);
    const bf16_t* KRA = (const bf16_t*)(p.ws + WS_KRALL); const bf16_t* VT = (const bf16_t*)(p.ws + WS_VT);
    bf16_t* AO = (bf16_t*)(p.ws + WS_AO);
    const int klim = causal ? 64 * ((w >> 1) + 1) + (nkeys_unit - 256) : nkeys_unit;
    const bool active = (w * 32) < nqv;
    bf16x8 qf[2][6];
#pragma unroll
    for (int qt = 0; qt < 2; ++qt) { int qi = w * 32 + qt * 16 + fr; if (qi >= nqv) qi = 0;
#pragma unroll
        for (int ks = 0; ks < 6; ++ks) qf[qt][ks] = *(const bf16x8*)(Q + (size_t)(qrow0 + qi) * 1536 + h * 192 + ks * 32 + fq * 8); }
    f32x4 oacc[8][2];
#pragma unroll
    for (int dt = 0; dt < 8; ++dt) { oacc[dt][0] = (f32x4){0.f, 0.f, 0.f, 0.f}; oacc[dt][1] = (f32x4){0.f, 0.f, 0.f, 0.f}; }
    float mrun[2] = {-1e30f, -1e30f}, lrun[2] = {0.f, 0.f};
    const int ntile = (nkeys_unit + 63) >> 6;
    u32x4 kregA[3], vregA[2];
#define ATT_LOAD(KR_, VR_, tt) do { const int kb_ = (tt) * 64; \
        _Pragma("unroll") for (int i = 0; i < 3; ++i) { const int ch = tid + i * 512, r = ch / 24, cc = ch % 24; const size_t tok = (size_t)(kv0 + kb_ + r); \
            KR_[i] = (cc < 16) ? *(const u32x4*)(KN + tok * 1024 + h * 128 + cc * 8) : *(const u32x4*)(KRA + tok * 64 + (cc - 16) * 8); } \
        _Pragma("unroll") for (int i = 0; i < 2; ++i) { const int ch = tid + i * 512, r = ch >> 3, cc = ch & 7; \
            VR_[i] = *(const u32x4*)(VT + (size_t)(h * 128 + r) * NKV + kv0 + kb_ + cc * 8); } } while (0)
#define ATT_STORE(KR_, VR_) do { \
        _Pragma("unroll") for (int i = 0; i < 3; ++i) { const int ch = tid + i * 512, r = ch / 24, cc = ch % 24; *(LAS u32x4*)(lds + L_AK + (r * KST + cc * 8) * 2) = KR_[i]; } \
        _Pragma("unroll") for (int i = 0; i < 2; ++i) { const int ch = tid + i * 512, r = ch >> 3, cc = ch & 7; *(LAS u32x4*)(lds + L_AV + (r * SK + cc * 8) * 2) = VR_[i]; } } while (0)
#define ATT_BAR() asm volatile("s_waitcnt lgkmcnt(0)\n\ts_barrier" ::: "memory")
    u32x4 kregB[3], vregB[2];
    ATT_LOAD(kregA, vregA, 0);
    if (ntile > 1) ATT_LOAD(kregB, vregB, 1);
    for (int t = 0; t < ntile; t += 2) {
        ATT_BAR();
        ATT_STORE(kregA, vregA);
        ATT_BAR();
        if (t + 2 < ntile) ATT_LOAD(kregA, vregA, t + 2);
        if (active && t * 64 < klim) attn_tile(lds, t * 64, klim, fr, fq, qf, oacc, mrun, lrun);
        if (t + 1 < ntile) {
            ATT_BAR();
            ATT_STORE(kregB, vregB);
            ATT_BAR();
            if (t + 3 < ntile) ATT_LOAD(kregB, vregB, t + 3);
            if (active && (t + 1) * 64 < klim) attn_tile(lds, (t + 1) * 64, klim, fr, fq, qf, oacc, mrun, lrun);
        }
    }
    if (active) {
#pragma unroll
        for (int qt = 0; qt < 2; ++qt) {
            float l = lrun[qt]; l += __shfl_xor(l, 16); l += __shfl_xor(l, 32);
            const float inv = 1.f / l; const int qi = w * 32 + qt * 16 + fr;
            if (qi < nqv) {
#pragma unroll
                for (int dt = 0; dt < 8; ++dt) { u32x2 wv; wv.x = cvtpk(oacc[dt][qt][0] * inv, oacc[dt][qt][1] * inv); wv.y = cvtpk(oacc[dt][qt][2] * inv, oacc[dt][qt][3] * inv);
                    *(u32x2*)(AO + (size_t)(qrow0 + qi) * D + h * 128 + dt * 16 + fq * 4) = wv; }
            }
        }
    }
    __syncthreads();
}

constexpr int LKS = 584;
constexpr int LVS = 40;
constexpr int LKT = 5 * 512 * 16;
constexpr int L_LK = 0, L_LV = 3 * LKT;
constexpr int KSPLIT = KVS / 4;
__device__ __forceinline__ void attn_latent_unit(const Params& p, LAS unsigned char* lds, int b, int dh, int ks) {
    int tid_ = threadIdx.x; asm volatile("" : "+v"(tid_));
    const int tid = tid_, lane = tid & 63, fr = lane & 15, fq = lane >> 4;
    const int w = __builtin_amdgcn_readfirstlane(tid >> 6);
    const bf16_t* CK = (const bf16_t*)(p.ws + WS_CKVALL); const bf16_t* KRA = (const bf16_t*)(p.ws + WS_KRALL);
    const bf16_t* QL = (const bf16_t*)(p.ws + WS_QL); const bf16_t* Q = (const bf16_t*)(p.ws + WS_Q);
    float* PO = (float*)(p.ws + WS_PO); float* PM = (float*)(p.ws + WS_PM); float* PL = (float*)(p.ws + WS_PL);
    const int kv0 = MP + b * KVS + ks * KSPLIT;
    bf16x8 qf[18];
#pragma unroll
    for (int kq = 0; kq < 16; ++kq) qf[kq] = *(const bf16x8*)(QL + (size_t)(b * 16 + fr) * 4096 + w * 512 + kq * 32 + fq * 8);
#pragma unroll
    for (int kq = 16; kq < 18; ++kq) qf[kq] = *(const bf16x8*)(Q + (size_t)(MP + b * 16 + fr) * 1536 + w * 192 + 128 + (kq - 16) * 32 + fq * 8);
    f32x4 oacc[16];
#pragma unroll
    for (int dt = 0; dt < 16; ++dt) oacc[dt] = (f32x4){0.f, 0.f, 0.f, 0.f};
    float mrun = -1e30f, lrun = 0.f;
    constexpr int NST = (KSPLIT + 31) / 32;
#define LAT_DMA(ss, bufi) do { _Pragma("unroll") for (int i = 0; i < 5; ++i) { const int slot = i * 512 + tid; int r = slot / 73, cc = slot % 73; if (r > 31) { r = 31; cc = 0; } if (cc > 71) cc = 0; \
            const size_t tok = (size_t)(kv0 + (ss) * 32 + r); const bf16_t* src = (cc < 64) ? CK + tok * 512 + cc * 8 : KRA + tok * 64 + (cc - 64) * 8; \
            __builtin_amdgcn_global_load_lds((const unsigned*)src, (LAS unsigned*)(lds + L_LK + (bufi) * LKT + (i * 512 + w * 64) * 16), 16, 0, 0); } } while (0)
    LAT_DMA(0, 0);
    LAT_DMA(1, 1);
    int bufc = 0, bufn = 2;
    for (int st = 0; st < NST; ++st) {
        if (st + 1 < NST) asm volatile("s_waitcnt vmcnt(5) lgkmcnt(0)\n\ts_barrier" ::: "memory");
        else asm volatile("s_waitcnt vmcnt(0) lgkmcnt(0)\n\ts_barrier" ::: "memory");
        if (st + 2 < NST) LAT_DMA(st + 2, bufn);
        const LAS unsigned char* kt = lds + L_LK + bufc * LKT;
#pragma unroll
        for (int ps_ = 0; ps_ < 2; ++ps_) {
            const int r = tid & 31, c32 = (tid >> 5) + ps_ * 16;
            const u32x4 v = *(const LAS u32x4*)(kt + (r * LKS + dh * 256 + c32 * 8) * 2);
            const unsigned ww[4] = {v.x, v.y, v.z, v.w};
#pragma unroll
            for (int e = 0; e < 4; ++e) { *(LAS bf16_t*)(lds + L_LV + ((c32 * 8 + 2 * e) * LVS + r) * 2) = (bf16_t)(ww[e] & 0xffffu); *(LAS bf16_t*)(lds + L_LV + ((c32 * 8 + 2 * e + 1) * LVS + r) * 2) = (bf16_t)(ww[e] >> 16); }
        }
        asm volatile("s_waitcnt lgkmcnt(0)\n\ts_barrier" ::: "memory");
        const int kb = st * 32;
        f32x4 s0 = (f32x4){0.f, 0.f, 0.f, 0.f}, s1 = (f32x4){0.f, 0.f, 0.f, 0.f};
#pragma unroll
        for (int kg = 0; kg < 9; ++kg) {
            bf16x8 k0[2], k1[2];
#pragma unroll
            for (int k3 = 0; k3 < 2; ++k3) { const int kq = kg * 2 + k3;
                k0[k3] = *(const LAS bf16x8*)(kt + (fr * LKS + kq * 32 + fq * 8) * 2);
                k1[k3] = *(const LAS bf16x8*)(kt + ((16 + fr) * LKS + kq * 32 + fq * 8) * 2); }
            __builtin_amdgcn_sched_barrier(0);
#pragma unroll
            for (int k3 = 0; k3 < 2; ++k3) { const int kq = kg * 2 + k3;
                s0 = __builtin_amdgcn_mfma_f32_16x16x32_bf16(k0[k3], qf[kq], s0, 0, 0, 0); s1 = __builtin_amdgcn_mfma_f32_16x16x32_bf16(k1[k3], qf[kq], s1, 0, 0, 0); }
            __builtin_amdgcn_sched_barrier(0);
        }
        if (kb + 32 > KSPLIT) {
#pragma unroll
            for (int j = 0; j < 4; ++j) { if (kb + fq * 4 + j >= KSPLIT) s0[j] = -1e30f; if (kb + 16 + fq * 4 + j >= KSPLIT) s1[j] = -1e30f; }
        }
        float mx = fmaxf(fmaxf(fmaxf(s0[0], s0[1]), fmaxf(s0[2], s0[3])), fmaxf(fmaxf(s1[0], s1[1]), fmaxf(s1[2], s1[3])));
        mx = fmaxf(mx, __shfl_xor(mx, 16)); mx = fmaxf(mx, __shfl_xor(mx, 32));
        const float mnew = fmaxf(mrun, mx), alpha = __builtin_amdgcn_exp2f(mrun - mnew);
        mrun = mnew;
        float ps = 0.f;
#pragma unroll
        for (int j = 0; j < 4; ++j) { s0[j] = __builtin_amdgcn_exp2f(s0[j] - mnew); s1[j] = __builtin_amdgcn_exp2f(s1[j] - mnew); ps += s0[j] + s1[j]; }
        lrun = lrun * alpha + ps;
        u32x4 wv; wv.x = cvtpk(s0[0], s0[1]); wv.y = cvtpk(s0[2], s0[3]); wv.z = cvtpk(s1[0], s1[1]); wv.w = cvtpk(s1[2], s1[3]);
        const bf16x8 pf = __builtin_bit_cast(bf16x8, wv);
#pragma unroll
        for (int dg = 0; dg < 8; ++dg) {
            u32x2 va0[2], va1[2];
#pragma unroll
            for (int d4 = 0; d4 < 2; ++d4) { const int dt = dg * 2 + d4;
                va0[d4] = *(const LAS u32x2*)(lds + L_LV + ((dt * 16 + fr) * LVS + fq * 4) * 2);
                va1[d4] = *(const LAS u32x2*)(lds + L_LV + ((dt * 16 + fr) * LVS + 16 + fq * 4) * 2); }
            __builtin_amdgcn_sched_barrier(0);
#pragma unroll
            for (int d4 = 0; d4 < 2; ++d4) { const int dt = dg * 2 + d4;
                const bf16x8 vf = __builtin_bit_cast(bf16x8, (u32x4){va0[d4].x, va0[d4].y, va1[d4].x, va1[d4].y});
                oacc[dt] = __builtin_amdgcn_mfma_f32_16x16x32_bf16(vf, pf, oacc[dt] * alpha, 0, 0, 0); }
            __builtin_amdgcn_sched_barrier(0);
        }
        bufc = bufc == 2 ? 0 : bufc + 1; bufn = bufn == 2 ? 0 : bufn + 1;
    }
#undef LAT_DMA
    { float l = lrun; l += __shfl_xor(l, 16); l += __shfl_xor(l, 32);
      const size_t prow = (size_t)((b * 4 + ks) * 8 + w) * 16 + fr;
#pragma unroll
      for (int dt = 0; dt < 16; ++dt) *(f32x4*)(PO + prow * 512 + dh * 256 + dt * 16 + fq * 4) = oacc[dt];
      if (dh == 0 && fq == 0) { PM[prow] = mrun; PL[prow] = l; } }
    asm volatile("s_waitcnt vmcnt(0) lgkmcnt(0)\n\ts_barrier" ::: "memory");
}

constexpr int OLS = 520;
__device__ __forceinline__ void attn_latent_combine(const Params& p, LAS unsigned char* lds, int b, int h) {
    int tid_ = threadIdx.x; asm volatile("" : "+v"(tid_));
    const int tid = tid_, lane = tid & 63, w = tid >> 6, fr = lane & 15, fq = lane >> 4;
    const float* PO = (const float*)(p.ws + WS_PO); const float* PM = (const float*)(p.ws + WS_PM); const float* PL = (const float*)(p.ws + WS_PL);
    const bf16_t* WUV = (const bf16_t*)(p.ws + WS_W_UV); bf16_t* AO = (bf16_t*)(p.ws + WS_AO);
    {
        const int t = tid >> 5, d0 = (tid & 31) * 16;
        float mk[4], M_ = -1e30f;
#pragma unroll
        for (int k = 0; k < 4; ++k) { mk[k] = PM[(size_t)((b * 4 + k) * 8 + h) * 16 + t]; M_ = fmaxf(M_, mk[k]); }
        float L_ = 0.f; f32x4 o[4];
#pragma unroll
        for (int i = 0; i < 4; ++i) o[i] = (f32x4){0.f, 0.f, 0.f, 0.f};
#pragma unroll
        for (int k = 0; k < 4; ++k) { const size_t prow = (size_t)((b * 4 + k) * 8 + h) * 16 + t; const float sc = __builtin_amdgcn_exp2f(mk[k] - M_); L_ += sc * PL[prow];
#pragma unroll
            for (int i = 0; i < 4; ++i) o[i] += *(const f32x4*)(PO + prow * 512 + d0 + i * 4) * sc; }
        const float inv = 1.f / L_;
        u32x4 w0, w1; w0.x = cvtpk(o[0].x * inv, o[0].y * inv); w0.y = cvtpk(o[0].z * inv, o[0].w * inv); w0.z = cvtpk(o[1].x * inv, o[1].y * inv); w0.w = cvtpk(o[1].z * inv, o[1].w * inv);
        w1.x = cvtpk(o[2].x * inv, o[2].y * inv); w1.y = cvtpk(o[2].z * inv, o[2].w * inv); w1.z = cvtpk(o[3].x * inv, o[3].y * inv); w1.w = cvtpk(o[3].z * inv, o[3].w * inv);
        *(LAS u32x4*)(lds + (t * OLS + d0) * 2) = w0; *(LAS u32x4*)(lds + (t * OLS + d0 + 8) * 2) = w1;
    }
    __syncthreads();
    {
        f32x4 acc = (f32x4){0.f, 0.f, 0.f, 0.f};
#pragma unroll 4
        for (int kq = 0; kq < 16; ++kq) {
            const bf16x8 a = *(const LAS bf16x8*)(lds + (fr * OLS + kq * 32 + fq * 8) * 2);
            const bf16x8 bb = *(const bf16x8*)(WUV + (size_t)(h * 128 + w * 16 + fr) * 512 + kq * 32 + fq * 8);
            acc = __builtin_amdgcn_mfma_f32_16x16x32_bf16(a, bb, acc, 0, 0, 0);
        }
#pragma unroll
        for (int j = 0; j < 4; ++j) AO[(size_t)(MP + b * 16 + fq * 4 + j) * D + h * 128 + w * 16 + fr] = (bf16_t)(cvtpk(acc[j], 0.f) & 0xffff);
    }
    __syncthreads();
}

__device__ __forceinline__ void unpack8(const u32x4 w, float (&f)[8]) { f[0] = bflo(w.x); f[1] = bfhi(w.x); f[2] = bflo(w.y); f[3] = bfhi(w.y); f[4] = bflo(w.z); f[5] = bfhi(w.z); f[6] = bflo(w.w); f[7] = bfhi(w.w); }
__device__ __forceinline__ void phase_ffn_fix(const Params& p, int layer) {
    const bf16_t* SA = (const bf16_t*)(p.ws + WS_SIDEA); const bf16_t* SB = (const bf16_t*)(p.ws + WS_SIDEB); const bf16_t* SU = (const bf16_t*)(p.ws + WS_SIDEU);
    bf16_t* ACT = (bf16_t*)(p.ws + WS_ACT);
    const float* wd = p.in[I_WDW] + (size_t)layer * 3 * DFF; const float* bd = p.in[I_BDW] + (size_t)layer * DFF;
    constexpr int NCC = DFF / 8;
    int tid_ = threadIdx.x; asm volatile("" : "+v"(tid_));
    for (int item = blockIdx.x * 512 + tid_; item < NBLK * NCC; item += gridDim.x * 512) {
        const int blk = item / NCC, cc = item % NCC, c0 = cc * 8;
        const bool smp = blk >= MP / 64;
        const int row0 = smp ? MP + (blk - MP / 64) * 16 : blk * 64;
        float w0[8], w1[8], w2[8], bi[8], am2[8], am1[8], a0[8], a1[8], u0[8], u1[8];
#pragma unroll
        for (int i = 0; i < 8; ++i) { w0[i] = wd[c0 + i]; w1[i] = wd[DFF + c0 + i]; w2[i] = wd[2 * DFF + c0 + i]; bi[i] = bd[c0 + i]; }
        if (smp) { const float* sc = p.in[I_SCONV] + ((size_t)(layer * 32 + (blk - MP / 64)) * 2) * DFF + c0;
#pragma unroll
            for (int i = 0; i < 8; ++i) { am2[i] = sc[i]; am1[i] = sc[DFF + i]; } }
        else if ((blk & 31) == 0) {
#pragma unroll
            for (int i = 0; i < 8; ++i) { am2[i] = 0.f; am1[i] = 0.f; } }
        else { unpack8(*(const u32x4*)(SA + ((size_t)(blk - 1) * 2) * DFF + c0), am2); unpack8(*(const u32x4*)(SA + ((size_t)(blk - 1) * 2 + 1) * DFF + c0), am1); }
        unpack8(*(const u32x4*)(SB + ((size_t)blk * 2) * DFF + c0), a0); unpack8(*(const u32x4*)(SB + ((size_t)blk * 2 + 1) * DFF + c0), a1);
        unpack8(*(const u32x4*)(SU + ((size_t)blk * 2) * DFF + c0), u0); unpack8(*(const u32x4*)(SU + ((size_t)blk * 2 + 1) * DFF + c0), u1);
        float y0[8], y1[8];
#pragma unroll
        for (int i = 0; i < 8; i += 2) {
            f32x2 c0v, c1v;
            c0v.x = bi[i] + am2[i] * w0[i] + am1[i] * w1[i] + a0[i] * w2[i]; c0v.y = bi[i + 1] + am2[i + 1] * w0[i + 1] + am1[i + 1] * w1[i + 1] + a0[i + 1] * w2[i + 1];
            c1v.x = bi[i] + am1[i] * w0[i] + a0[i] * w1[i] + a1[i] * w2[i]; c1v.y = bi[i + 1] + am1[i + 1] * w0[i + 1] + a0[i + 1] * w1[i + 1] + a1[i + 1] * w2[i + 1];
            const f32x2 g0 = gelu_pk(c0v), g1 = gelu_pk(c1v);
            y0[i] = g0.x * u0[i]; y0[i + 1] = g0.y * u0[i + 1]; y1[i] = g1.x * u1[i]; y1[i + 1] = g1.y * u1[i + 1]; }
        u32x4 o; o.x = cvtpk(y0[0], y0[1]); o.y = cvtpk(y0[2], y0[3]); o.z = cvtpk(y0[4], y0[5]); o.w = cvtpk(y0[6], y0[7]);
        *(u32x4*)(ACT + (size_t)row0 * DFF + c0) = o;
        o.x = cvtpk(y1[0], y1[1]); o.y = cvtpk(y1[2], y1[3]); o.z = cvtpk(y1[4], y1[5]); o.w = cvtpk(y1[6], y1[7]);
        *(u32x4*)(ACT + (size_t)(row0 + 1) * DFF + c0) = o;
        if (smp || (blk & 31) == 31) {
            float l0[8], l1[8];
            unpack8(*(const u32x4*)(SA + ((size_t)blk * 2) * DFF + c0), l0); unpack8(*(const u32x4*)(SA + ((size_t)blk * 2 + 1) * DFF + c0), l1);
            float* co = smp ? p.out + O_CONV_S + ((size_t)(layer * 32 + (blk - MP / 64)) * 2) * DFF + c0
                            : p.out + O_CONV_P + ((size_t)(layer * 16 + (blk >> 5)) * 2) * DFF + c0;
#pragma unroll
            for (int i = 0; i < 8; ++i) { co[i] = l0[i]; co[DFF + i] = l1[i]; }
        }
    }
}

__device__ __forceinline__ void phase_fix(const Params& p, int which, int vb, int nvb) {
    int tid_ = threadIdx.x; asm volatile("" : "+v"(tid_));
    const int tid = tid_, lane = tid & 63, wave = tid >> 6;
    const int gw = vb * 8 + wave, NGW = nvb * 8;
    bf16_t* CKVALL = (bf16_t*)(p.ws + WS_CKVALL); bf16_t* KRALL = (bf16_t*)(p.ws + WS_KRALL);
    const float* ssq = (const float*)(p.ws + WS_SSQ); float* ckv = p.out + O_CKV; const float* gkv = p.in[I_GKV];
    const f32x4 g0 = *(const f32x4*)(gkv + lane * 8), g1 = *(const f32x4*)(gkv + lane * 8 + 4);
    if (which & 1)
    for (int row = gw; row < M; row += NGW) {
        const f32x4* pp = (const f32x4*)(ssq + (size_t)row * 32 + 12);
        const float s = (sum4(pp[0]) + sum4(pp[1])) + (sum4(pp[2]) + sum4(pp[3]));
        const float rs = rsqrtf(s * (1.f / 512.f) + EPS);
        bf16_t* cb = CKVALL + (size_t)kvtok(row) * 512 + lane * 8;
        const u32x4 rw = *(const u32x4*)cb;
        f32x4 a = (f32x4){bflo(rw.x), bfhi(rw.x), bflo(rw.y), bfhi(rw.y)}, b = (f32x4){bflo(rw.z), bfhi(rw.z), bflo(rw.w), bfhi(rw.w)};
        a = a * rs * g0; b = b * rs * g1;
        float* cr = ckv + (size_t)row * 512 + lane * 8;
        __builtin_nontemporal_store(a, (f32x4*)cr); __builtin_nontemporal_store(b, (f32x4*)(cr + 4));
        u32x4 o; o.x = cvtpk(a.x, a.y); o.y = cvtpk(a.z, a.w); o.z = cvtpk(b.x, b.y); o.w = cvtpk(b.z, b.w);
        *(u32x4*)cb = o;
    }
    if (!(which & 2)) return;
    const float* cc = p.in[I_CCKV];
    for (int r = gw; r < 32 * PAST; r += NGW) {
        const int b = r >> 12, s = r & (PAST - 1);
        const f32x4 a = *(const f32x4*)(cc + (size_t)r * 512 + lane * 8), b4 = *(const f32x4*)(cc + (size_t)r * 512 + lane * 8 + 4);
        u32x4 o; o.x = cvtpk(a.x, a.y); o.y = cvtpk(a.z, a.w); o.z = cvtpk(b4.x, b4.y); o.w = cvtpk(b4.z, b4.w);
        *(u32x4*)(CKVALL + (size_t)(MP + b * KVS + s) * 512 + lane * 8) = o;
    }
    const float* ck = p.in[I_CKR];
    for (int it = vb * 512 + tid; it < 32 * PAST * 16; it += nvb * 512) {
        const int r = it >> 4, q = it & 15, b = r >> 12, s = r & (PAST - 1);
        const float* src = ck + (size_t)r * 64;
        u32x2 o; o.x = cvtpk(src[2 * q], src[32 + 2 * q]); o.y = cvtpk(src[2 * q + 1], src[33 + 2 * q]);
        *(u32x2*)(KRALL + (size_t)(MP + b * KVS + s) * 64 + q * 4) = o;
    }
}

__device__ __forceinline__ void phase_final(const Params& p) {
    int tid_ = threadIdx.x; asm volatile("" : "+v"(tid_));
    const int tid = tid_, lane = tid & 63, wave = tid >> 6;
    const int gw = blockIdx.x * 8 + wave, NGW = gridDim.x * 8;
    float* Y = p.out + O_Y; const float* g = p.in[I_NFIN]; const bf16_t* XB = (const bf16_t*)(p.ws + WS_XB); const float* ssp = (const float*)(p.ws + WS_SSP);
    for (int row = gw; row < M; row += NGW) {
        const float rs = rstd_from16(ssp, row);
#pragma unroll
        for (int j = 0; j < 4; ++j) { const u32x2 xb = __builtin_nontemporal_load((const u32x2*)(XB + (size_t)row * D + j * 256 + lane * 4));
            const f32x4 v = (f32x4){bflo(xb.x), bfhi(xb.x), bflo(xb.y), bfhi(xb.y)};
            const f32x4 gg = *(const f32x4*)(g + j * 256 + lane * 4); __builtin_nontemporal_store(v * rs * gg, (f32x4*)(Y + (size_t)row * D + j * 256 + lane * 4)); }
    }
}

__device__ __forceinline__ void skinny_res(const Params& p, LAS unsigned char* lds, const bf16_t* A, const bf16_t* Bt, int K, int job) {
    int tid_ = threadIdx.x; asm volatile("" : "+v"(tid_));
    const int tid = tid_, lane = tid & 63, w = tid >> 6, fr = lane & 15, fq = lane >> 4, rt = w >> 2, ct = w & 3;
    bf16_t* XB = (bf16_t*)(p.ws + WS_XB); float* ssp = (float*)(p.ws + WS_SSP);
    LAS float* red = (LAS float*)lds;
    for (int u = blockIdx.x; u < 256; u += gridDim.x) {
        const int rg = u >> 4, cg = u & 15, row0 = MP + rg * 32 + rt * 16, col0 = cg * 64 + ct * 16;
        const bf16_t* ap = A + (size_t)(row0 + fr) * K + fq * 8;
        const bf16_t* bp = Bt + (size_t)(col0 + fr) * K + fq * 8;
        f32x4 acc0 = (f32x4){0.f, 0.f, 0.f, 0.f}, acc1 = (f32x4){0.f, 0.f, 0.f, 0.f};
        const int nks = K >> 5;
#pragma unroll 4
        for (int ks = 0; ks < nks; ks += 2) {
            const bf16x8 a0 = *(const bf16x8*)(ap + ks * 32), b0 = *(const bf16x8*)(bp + ks * 32);
            const bf16x8 a1 = *(const bf16x8*)(ap + ks * 32 + 32), b1 = *(const bf16x8*)(bp + ks * 32 + 32);
            acc0 = __builtin_amdgcn_mfma_f32_16x16x32_bf16(a0, b0, acc0, 0, 0, 0);
            acc1 = __builtin_amdgcn_mfma_f32_16x16x32_bf16(a1, b1, acc1, 0, 0, 0);
        }
        float ssj[4];
#pragma unroll
        for (int j = 0; j < 4; ++j) {
            const int row = row0 + fq * 4 + j, col = col0 + fr;
            const float x = bf2f(XB[(size_t)row * D + col]) + (acc0[j] + acc1[j]);
            XB[(size_t)row * D + col] = (bf16_t)(cvtpk(x, 0.f) & 0xffff);
            float ss = x * x;
            ss += __shfl_xor(ss, 1); ss += __shfl_xor(ss, 2); ss += __shfl_xor(ss, 4); ss += __shfl_xor(ss, 8);
            ssj[j] = ss;
        }
        __syncthreads();
        if (fr == 0) {
#pragma unroll
            for (int j = 0; j < 4; ++j) red[(rt * 16 + fq * 4 + j) * 4 + ct] = ssj[j];
        }
        __syncthreads();
        if (tid < 32) ssp[(size_t)(MP + rg * 32 + tid) * 16 + cg] = (red[tid * 4] + red[tid * 4 + 1]) + (red[tid * 4 + 2] + red[tid * 4 + 3]);
    }
    __syncthreads();
}

#define XB_TMO      128
#define XB_XCNT(j)  (256  + 64 * (j))
#define XB_XSUB(j)  (1280 + 64 * (j))
#define XB_XGEN(j)  (2304 + 64 * (j))
#define XB_TOP      3328
#define XB_TOPGEN   3392
#define XCD_BAR_WORDS 3456
#define XB_SPIN_CAP (1u << 18)

__device__ __forceinline__ unsigned xb_ld(unsigned* p)              { return __hip_atomic_load(p, __ATOMIC_RELAXED, __HIP_MEMORY_SCOPE_AGENT); }
__device__ __forceinline__ unsigned xb_add(unsigned* p, unsigned v) { return __hip_atomic_fetch_add(p, v, __ATOMIC_RELAXED, __HIP_MEMORY_SCOPE_AGENT); }
__device__ __forceinline__ unsigned xb_xcc_id() { return (unsigned)__builtin_amdgcn_s_getreg((3 << 11) | 20) & 0xFu; }
#define XB_SPIN(cond, bar) do { unsigned _sp = 0; while (cond) { __builtin_amdgcn_s_sleep(1); \
    if ((++_sp & 255u) == 0u) { if (xb_ld(&(bar)[XB_TMO])) break; if (_sp > XB_SPIN_CAP) { atomicAdd(&(bar)[XB_TMO], 1u); break; } } } } while (0)

struct XcdBarrier {
    unsigned* bar; unsigned x;
    volatile LAS unsigned* st;
};

__device__ __forceinline__ XcdBarrier xcd_barrier_post(unsigned* bar, volatile LAS unsigned* st) {
    XcdBarrier b; b.bar = bar; b.x = xb_xcc_id(); b.st = st;
    if (threadIdx.x == 0) (void)xb_add(&bar[XB_XCNT(b.x)], 1u);
    return b;
}
__device__ __forceinline__ void xcd_barrier_complete(unsigned* bar, unsigned x, unsigned& nloc, unsigned& nx) {
    const unsigned G = gridDim.x * gridDim.y * gridDim.z;
    unsigned sum, cnt, mine, sp = 0u;
    for (;;) {
        sum = 0u; cnt = 0u; mine = 0u;
#pragma unroll
        for (unsigned j = 0; j < 16; ++j) { const unsigned c = xb_ld(&bar[XB_XCNT(j)]); sum += c; cnt += (c > 0u) ? 1u : 0u; mine = (j == x) ? c : mine; }
        if (sum == G) break;
        __builtin_amdgcn_s_sleep(1);
        if ((++sp & 255u) == 0u) { if (xb_ld(&bar[XB_TMO])) break; if (sp > XB_SPIN_CAP) { atomicAdd(&bar[XB_TMO], 1u); break; } }
    }
    nloc = mine > 0u ? mine : 1u; nx = cnt > 0u ? cnt : 1u;
}

__device__ __forceinline__ void xcd_barrier(const XcdBarrier& b) {
    asm volatile("s_waitcnt vmcnt(0)" ::: "memory");
    __syncthreads();
    if (threadIdx.x == 0) {
        unsigned* bar = b.bar;
        __builtin_amdgcn_s_waitcnt(0);
        unsigned nloc = b.st[0], nx = b.st[1];
        if (nloc == 0u) { xcd_barrier_complete(bar, b.x, nloc, nx); b.st[0] = nloc; b.st[1] = nx; }
        const unsigned old = xb_add(&bar[XB_XSUB(b.x)], 1u);
        const unsigned gen = old / nloc;
        if (old + 1u == (gen + 1u) * nloc) {
            __builtin_amdgcn_fence(__ATOMIC_RELEASE, "agent");
            asm volatile("s_waitcnt vmcnt(0)" ::: "memory");
            const unsigned og = xb_add(&bar[XB_TOP], 1u);
            const unsigned tg = og / nx;
            if (og + 1u == (tg + 1u) * nx) xb_add(&bar[XB_TOPGEN], 1u);
            else XB_SPIN(xb_ld(&bar[XB_TOPGEN]) == tg, bar);
            __builtin_amdgcn_fence(__ATOMIC_ACQUIRE, "agent");
            xb_add(&bar[XB_XGEN(b.x)], 1u);
            asm volatile("s_waitcnt vmcnt(0)" ::: "memory");
        } else {
            XB_SPIN(xb_ld(&bar[XB_XGEN(b.x)]) == gen, bar);
            __builtin_amdgcn_fence(__ATOMIC_ACQUIRE, "agent");
            asm volatile("s_waitcnt vmcnt(0)" ::: "memory");
        }
    }
    __syncthreads();
}


#ifdef DBG_ZERO
constexpr int NPHASE = 17;
#else
constexpr int NPHASE = 16;
#endif
__global__ void __launch_bounds__(512, 2) mega_fwd(Params pk) {
    extern __shared__ __attribute__((aligned(16))) unsigned char smem[];
    LAS unsigned char* lds = (LAS unsigned char*)smem;
    const int G = gridDim.x, bx = blockIdx.x;
#ifndef PHMASK
#define PHMASK 0x1FFFF
#endif
#define PH(k) ((((PHMASK) >> (k)) & 1) && ph == (k))
#ifndef REPMASK
#define REPMASK 0
#endif
    volatile LAS unsigned* bst = (volatile LAS unsigned*)(lds + LDS_BYTES - 64);
    if (threadIdx.x < 2) bst[threadIdx.x] = 0u;
    __syncthreads();
    XcdBarrier xbar; xbar.bar = (unsigned*)pk.ws; xbar.x = 0; xbar.st = bst;
    if (pk.ph_hi - pk.ph_lo > 1) xbar = xcd_barrier_post((unsigned*)pk.ws, bst);
    bool first = true; int nseam = 0;
#pragma unroll 1
    for (int slot = 2 * pk.ph_lo; slot < 2 * pk.ph_hi; ++slot) {
        const int ph = slot >> 1;
        if ((slot & 1) && !((REPMASK >> ph) & 1)) continue;
        if (!first) { if (pk.ph_lo < 0) cg::this_grid().sync(); else xcd_barrier(xbar); ++nseam; }
        first = false;
        const __attribute__((address_space(4))) char* ka = (const __attribute__((address_space(4))) char*)__builtin_amdgcn_kernarg_segment_ptr();
        asm volatile("" : "+s"(ka));
        const Params& p = *(const Params*)(const char*)ka;
        unsigned char* ws = p.ws;
        bf16_t* XB = (bf16_t*)(ws + WS_XB);
        if (PH(0)) { phase_prologue(p, lds, G == 256 ? 1 : 7, bx, G); if (G != 256) fold_wql(p, bx, G); }
        else if (PH(1) || PH(8) || PH(9)) {
            const bool ql8 = (G == 256);
            int nsub = (ph == 9) ? (ql8 ? 3 : 4) : 1;
            if (ph == 8) nsub = (ql8 && bx < 44) ? 1 : 0;
#pragma unroll 1
            for (int sub = 0; sub < nsub; ++sub) {
                pg8::Gemm g; EpiBf E; E.pp = &p;
                if (ph == 1) { g = pg8::Gemm{XB, (const bf16_t*)(ws + WS_W_INAB), M, NAB, 1024}; E.job = 1; }
                else if ((ph == 8 && bx < 32) || sub == 3) { g = pg8::Gemm{(const bf16_t*)(ws + WS_CQ) + (size_t)MP * 384, (const bf16_t*)(ws + WS_W_QL), MS, 4096, 384}; E.job = 93; }
                else if (ph == 8) { g = pg8::Gemm{(const bf16_t*)(ws + WS_CQ) + (size_t)MP * 384, (const bf16_t*)(ws + WS_W_UQ), MS, 1536, 384}; E.job = 94; }
                else if (sub == 0) { g = pg8::Gemm{(const bf16_t*)(ws + WS_CQ), (const bf16_t*)(ws + WS_W_UQ), ql8 ? MP : M, 1536, 384}; E.job = 90; }
                else if (sub == 1) { g = pg8::Gemm{(const bf16_t*)(ws + WS_CKVALL), (const bf16_t*)(ws + WS_W_UK), MP, 1024, 512}; E.job = 91; }
                else { g = pg8::Gemm{(const bf16_t*)(ws + WS_W_UV), (const bf16_t*)(ws + WS_CKVALL), 1024, MP, 512}; E.job = 92; }
                pg8::StaticOrder S; S.init(g.M, g.N, ph == 8 ? (bx < 32 ? 32 : 12) : G, ph == 8 && bx >= 32 ? bx - 32 : bx);
                pg8::gemm_phase(lds, g, S, E);
            }
            if (ph == 8) { if (!ql8) phase_fix(p, 3, bx, G); else if (bx >= 44) phase_fix(p, 1, bx - 44, G - 44); }
        }
        else if (PH(4) || PH(12)) {
            const int layer = ph == 12;
            { int t_ = threadIdx.x; asm volatile("" : "+v"(t_)); const float* ssp = (const float*)(ws + WS_SSP); float* rsp = (float*)(ws + WS_RS);
              for (int row = bx * 512 + t_; row < M; row += G * 512) rsp[row] = rstd_from16(ssp, row); }
            xcd_barrier(xbar);
            pg8::Gemm g{XB, (const bf16_t*)(ws + WS_W_FFNIN) + (size_t)layer * 5632 * 1024, M, 5632, 1024};
            EpiFfn E{&p, layer};
#ifndef WGM_FFNUP
#define WGM_FFNUP 4
#endif
            pg8::StaticOrder S; S.init(g.M, g.N, G, bx, WGM_FFNUP);
            pg8::gemm_phase(lds, g, S, E);
            if (ph == 4 && G == 256 && bx >= 44) phase_prologue(p, lds, 4, bx - 44, G - 44);
        }
        else if (PH(2)) {
#pragma unroll 1
            for (int u = bx; u < 384; u += G) dla_unit(p, lds, u);
            if (G == 256 && bx >= 128) { __syncthreads(); phase_prologue(p, lds, 2, bx - 128, G - 128); fold_wql(p, bx - 128, G - 128); }
        }
        else if (PH(3) || PH(6) || PH(11) || PH(14)) {
            if (ph == 11) {
#pragma unroll 1
                for (int u = bx; u < 256; u += G) attn_latent_combine(p, lds, u >> 3, u & 7);
                xcd_barrier(xbar);
            }
            pg8::Gemm g; EpiRes E; E.pp = &p; E.job = ph;
            if (ph == 3) { g = pg8::Gemm{(const bf16_t*)(ws + WS_MIX), (const bf16_t*)(ws + WS_W_OUTAB), MP, 1024, 1024}; }
            else if (ph == 11) { g = pg8::Gemm{(const bf16_t*)(ws + WS_AO), (const bf16_t*)(ws + WS_W_OUTC), MP, 1024, 1024}; }
            else { const int layer = ph == 14; g = pg8::Gemm{(const bf16_t*)(ws + WS_ACT), (const bf16_t*)(ws + WS_W_FFNOUT) + (size_t)layer * 1024 * 2816, MP, 1024, 2816}; }
            pg8::StaticOrder S; S.init(g.M, g.N, G, bx);
            pg8::gemm_phase(lds, g, S, E);
            skinny_res(p, lds, g.A, g.Bt, g.K, ph);
        }
        else if (PH(5) || PH(13)) { phase_ffn_fix(p, ph == 13); }
        else if (PH(7)) {
            pg8::Gemm g{XB, (const bf16_t*)(ws + WS_W_INC), M, 1024, 1024}; pg8::StaticOrder S; S.init(M, 1024, G, bx);
            EpiInC E{&p};
            pg8::gemm_phase(lds, g, S, E);
            if (G == 256 && bx >= 8) phase_fix(p, 2, bx - 8, G - 8);
        }
        else if (PH(10)) {
#pragma unroll 1
            for (int u = bx; u < 1280; u += G) {
                const int c = u & 255, i = u >> 8;
                if (i < 4) { const int bh = c >> 1, par = c & 1; const int qb = par ? (i == 0 ? 1 : i == 1 ? 2 : i == 2 ? 5 : 6) : (i == 0 ? 0 : i == 1 ? 3 : i == 2 ? 4 : 7);
                    const int b = bh >> 3, h = bh & 7;
                    attn_unit(p, lds, b * SEQ + qb * 256, 256, b * SEQ, (qb + 1) * 256, h, true); }
                else attn_latent_unit(p, lds, c >> 3, (c >> 2) & 1, c & 3);
            }
        }
        else if (PH(15)) { phase_final(p); }
#ifdef DBG_ZERO
        else if (ph == 16) {
            int tz_ = threadIdx.x; asm volatile("" : "+v"(tz_));
#define DZ(o, lo, hi) if ((DBG_ZERO >> (o)) & 1) { for (size_t i = (size_t)(lo) + (size_t)bx * 512 + tz_; i < (size_t)(hi); i += (size_t)G * 512) p.out[i] = 0.f; }
        DZ(0, 0, (size_t)MP * D) DZ(1, (size_t)MP * D, O_GLA_P) DZ(2, O_GLA_P, O_GLA_S) DZ(3, O_GLA_S, O_RET_P) DZ(4, O_RET_P, O_RET_S) DZ(5, O_RET_S, O_CKV)
        DZ(6, O_CKV, O_CKV + (size_t)MP * 512) DZ(7, O_CKV + (size_t)MP * 512, O_KR) DZ(8, O_KR, O_KR + (size_t)MP * 64) DZ(9, O_KR + (size_t)MP * 64, O_CONV_P)
        DZ(10, O_CONV_P, O_CONV_S) DZ(11, O_CONV_S, O_CONV_S + 2 * 32 * 2 * DFF)
        }
#endif
    }
}

extern "C" void kernel_launch(void* const* d_in, const int* in_sizes, int n_in, void* d_out, int out_size, void* d_ws, size_t ws_size, hipStream_t stream) {
    static int grid = 0;
    if (grid == 0) {
        int dev = 0, cus = 0, per_cu = 0;
        (void)hipGetDevice(&dev);
        (void)hipDeviceGetAttribute(&cus, hipDeviceAttributeMultiprocessorCount, dev);
        (void)hipFuncSetAttribute((const void*)mega_fwd, hipFuncAttributeMaxDynamicSharedMemorySize, LDS_BYTES);
        (void)hipOccupancyMaxActiveBlocksPerMultiprocessor(&per_cu, (const void*)mega_fwd, 512, LDS_BYTES);
        if (per_cu < 1) per_cu = 1;
        grid = cus * per_cu;
        (void)hipGetLastError();
        if (n_in != 27 || ws_size < WS_END) { fprintf(stderr, "kernel_launch: unexpected n_in %d / ws_size %zu\n", n_in, ws_size); }
    }
    Params p{};
    for (int i = 0; i < 27; ++i) p.in[i] = (const float*)d_in[i];
    p.out = (float*)d_out; p.ws = (unsigned char*)d_ws;
#if ONE_LAUNCH
    (void)hipMemsetAsync(d_ws, 0, 16384, stream);
    p.ph_lo = 0; p.ph_hi = NPHASE;
    void* args[] = {&p};
    hipError_t e = hipLaunchCooperativeKernel((const void*)mega_fwd, dim3(grid), dim3(512), args, LDS_BYTES, stream);
    if (e != hipSuccess) fprintf(stderr, "cooperative launch failed: %s (grid %d)\n", hipGetErrorString(e), grid);
#else
    for (int ph = 0; ph < NPHASE; ++ph) {
        p.ph_lo = ph; p.ph_hi = ph + 1;
        hipLaunchKernelGGL(mega_fwd, dim3(grid), dim3(512), LDS_BYTES, stream, p);
    }
#endif
}
```

```cpp
#include <hip/hip_runtime.h>
#include <hip/hip_cooperative_groups.h>
#include <cstdio>
#include <cstdint>
namespace cg = cooperative_groups;

#ifndef ONE_LAUNCH
#define ONE_LAUNCH 1


#endif

#define LAS __attribute__((address_space(3)))
typedef unsigned short bf16_t;
typedef short bf16x8 __attribute__((ext_vector_type(8)));
typedef float f32x4 __attribute__((ext_vector_type(4)));
typedef float f32x2 __attribute__((ext_vector_type(2)));
typedef unsigned u32x4 __attribute__((ext_vector_type(4)));
typedef unsigned u32x2 __attribute__((ext_vector_type(2)));
typedef __bf16 bf16x2_t __attribute__((ext_vector_type(2)));

__device__ __forceinline__ unsigned cvtpk(float lo, float hi) { f32x2 v = {lo, hi}; bf16x2_t b = __builtin_convertvector(v, bf16x2_t); return __builtin_bit_cast(unsigned, b); }
__device__ __forceinline__ float bf2f(unsigned short h) { return __uint_as_float(((unsigned)h) << 16); }
__device__ __forceinline__ float bflo(unsigned w) { return __uint_as_float(w << 16); }
__device__ __forceinline__ float bfhi(unsigned w) { return __uint_as_float(w & 0xffff0000u); }

constexpr int D = 1024, MP = 32768, MS = 512, M = MP + MS, SEQ = 2048, DSEQ = 16, PAST = 4096;
constexpr int KVS = PAST + DSEQ;
constexpr int NKV = MP + 32 * KVS;
constexpr int NAB = 3328;
constexpr int DFF = 2816;
constexpr float EPS = 1e-6f;
constexpr int NPOS = SEQ + DSEQ;

constexpr size_t O_Y = 0;
constexpr size_t O_GLA_P = (size_t)M * D;
constexpr size_t O_GLA_S = O_GLA_P + 16 * 4 * 64 * 128;
constexpr size_t O_RET_P = O_GLA_S + 32 * 4 * 64 * 128;
constexpr size_t O_RET_S = O_RET_P + 16 * 4 * 64 * 128;
constexpr size_t O_CKV = O_RET_S + 32 * 4 * 64 * 128;
constexpr size_t O_KR = O_CKV + (size_t)M * 512;
constexpr size_t O_CONV_P = O_KR + (size_t)M * 64;
constexpr size_t O_CONV_S = O_CONV_P + 2 * 16 * 2 * DFF;

constexpr size_t MiB = 1u << 20;
constexpr size_t WS_W_INAB = 1 * MiB;
constexpr size_t WS_W_OUTAB = 8 * MiB;
constexpr size_t WS_W_FFNIN = 10 * MiB;
constexpr size_t WS_W_FFNOUT = 32 * MiB;
constexpr size_t WS_W_INC = 43 * MiB;
constexpr size_t WS_W_UQ = 45 * MiB;
constexpr size_t WS_W_UK = 47 * MiB;
constexpr size_t WS_W_UV = 48 * MiB;
constexpr size_t WS_W_OUTC = 49 * MiB;
constexpr size_t WS_ROT = 51 * MiB;
constexpr size_t WS_SSP = 52 * MiB;
constexpr size_t WS_SSQ = 55 * MiB;
constexpr size_t WS_RS = 60 * MiB;
constexpr size_t WS_W_QL = 61 * MiB;
constexpr size_t WS_R = 64 * MiB;
constexpr size_t WS_P = WS_R;
constexpr size_t WS_MIX = WS_R + 212 * MiB;
constexpr int NBLK = MP / 64 + 32;
constexpr size_t WS_SIDEA = WS_R;
constexpr size_t WS_SIDEB = WS_R + 8 * MiB;
constexpr size_t WS_SIDEU = WS_R + 16 * MiB;
constexpr size_t WS_ACT = WS_R + 358 * MiB;
constexpr size_t WS_XB = WS_R + 540 * MiB;
constexpr size_t WS_CKVALL = WS_R;
constexpr size_t WS_AO = WS_R + 430 * MiB;
constexpr size_t WS_CQ = WS_R + 161 * MiB;
constexpr size_t WS_KRALL = WS_R + 186 * MiB;
constexpr size_t WS_Q = WS_R + 207 * MiB;
constexpr size_t WS_KN = WS_R + 305 * MiB;
constexpr size_t WS_VT = WS_R + 626 * MiB;
constexpr size_t WS_QL = WS_R + 370 * MiB;
constexpr size_t WS_PO = WS_R + 380 * MiB;
constexpr size_t WS_PM = WS_R + 420 * MiB;
constexpr size_t WS_PL = WS_R + 421 * MiB;
constexpr size_t WS_END = WS_R + 948 * MiB;
static_assert(WS_END <= 1024 * MiB, "ws map");

constexpr int LDS_BYTES = 147456;

__device__ __forceinline__ int kvtok(int row) { return row < MP ? row : MP + ((row - MP) >> 4) * KVS + PAST + ((row - MP) & 15); }
__device__ __forceinline__ int posidx(int row) { return row < MP ? (row & (SEQ - 1)) : SEQ + ((row - MP) & 15); }

namespace pg8 {
constexpr int BM = 256, BK = 64, HALF = 128, HTB = HALF * BK * 2, STAGE_BYTES = 8 * HTB, NXCD = 8, WGM = 4;
__host__ __device__ __forceinline__ int lds_byte(int r, int c) { const int st = (r >> 4) * 2 + (c >> 5), rr = r & 15, cc = c & 31, ob = rr * 64 + cc * 2; return st * 1024 + (ob ^ (((ob >> 9) & 1) << 5)); }
__host__ __device__ __forceinline__ void stage_rc(int b, int& R, int& C) { const int st = b / 1024, sb = b % 1024, swz = sb ^ (((sb >> 9) & 1) << 5); R = (st >> 1) * 16 + swz / 64; C = (st & 1) * 32 + (swz % 64) / 2; }
__host__ __device__ __forceinline__ int perm32(int rho) { const int n = rho >> 4, i = rho & 15; return 8 * (i >> 2) + 4 * n + (i & 3); }
struct Unit { int pm, pn; };
struct Gemm { const bf16_t* A; const bf16_t* Bt; int M, N, K; };
struct StaticOrder {
    int nM, nN, nwg, G, c, wgm;
    __host__ __device__ void init(int M_, int N_, int G_, int c_, int wgm_ = WGM) { nM = M_ / BM; nN = N_ / BM; nwg = nM * nN; G = G_; c = c_; wgm = wgm_; }
    __host__ __device__ bool next(int i, Unit& u) const {
        const long L = (long)i * G + c; if (L >= nwg) return false;
        int wgid = (int)L; { const int q = nwg / NXCD, r = nwg % NXCD, xcd = wgid % NXCD, off = wgid / NXCD; wgid = (xcd < r ? xcd * (q + 1) : r * (q + 1) + (xcd - r) * q) + off; }
        const int nig = wgm * nN, gid = wgid / nig, fm = gid * wgm, gsz = (nM - fm) < wgm ? (nM - fm) : wgm;
        u.pm = fm + ((wgid % nig) % gsz); u.pn = (wgid % nig) / gsz; return true;
    }
};
template <class Epi>
__device__ __forceinline__ void gemm_phase(LAS unsigned char* lds, const Gemm g, const StaticOrder& S, const Epi& E) {
    int tid_ = threadIdx.x; asm volatile("" : "+v"(tid_));
    const int tid = tid_, wid = __builtin_amdgcn_readfirstlane(tid >> 6), lane = tid & 63, wr = wid >> 2, wc = wid & 3, fr = lane & 15, fq = lane >> 4;
    const int K = g.K, nt = K / BK;
    unsigned voffA[2], voffB[2];
#pragma unroll
    for (int i = 0; i < 2; ++i) { int R, C; stage_rc(tid * 16 + i * 8192, R, C); const int Rb = Epi::PERM ? ((R & ~31) + perm32(R & 31)) : R;
        voffA[i] = (unsigned)(R * K + C) * 2u; voffB[i] = (unsigned)(Rb * K + C) * 2u; }
    const size_t kstep = (size_t)(BK * 2);
    const size_t hstep = (size_t)HALF * K * 2;
    const size_t tstep = 2 * hstep;
    const unsigned ldsw = (unsigned)wid * 1024u;
    const int aoff = lds_byte(wr * 64 + fr, fq * 8), boff = lds_byte(wc * 32 + fr, fq * 8);
#define PG8_SA(b, h) (((b) * 2 + (h)) * HTB)
#define PG8_SB(b, h) ((4 + (b) * 2 + (h)) * HTB)
#define PG8_STAGE(bufoff, gbase, voff) do { _Pragma("unroll") for (int _i = 0; _i < 2; ++_i) \
        __builtin_amdgcn_global_load_lds((const unsigned*)((const char*)(gbase) + (voff)[_i]), (LAS unsigned*)(lds + (bufoff) + ldsw + _i * 8192), 16, 0, 0); } while (0)
#define PG8_LDA(dst, b, h) do { _Pragma("unroll") for (int m = 0; m < 4; ++m) _Pragma("unroll") for (int k = 0; k < 2; ++k) dst[m][k] = *(const LAS bf16x8*)(lds + PG8_SA(b, h) + aoff + m * 2048 + k * 1024); } while (0)
#define PG8_LDB(dst, b, h) do { _Pragma("unroll") for (int n = 0; n < 2; ++n) _Pragma("unroll") for (int k = 0; k < 2; ++k) dst[n][k] = *(const LAS bf16x8*)(lds + PG8_SB(b, h) + boff + n * 2048 + k * 1024); } while (0)
#define PG8_MMA(ai, bj, At, Bt) do { __builtin_amdgcn_s_setprio(1); _Pragma("unroll") for (int m = 0; m < 4; ++m) _Pragma("unroll") for (int n = 0; n < 2; ++n) _Pragma("unroll") for (int k = 0; k < 2; ++k) \
        acc[ai][bj][m][n] = __builtin_amdgcn_mfma_f32_16x16x32_bf16(Bt[n][k], At[m][k], acc[ai][bj][m][n], 0, 0, 0); __builtin_amdgcn_s_setprio(0); } while (0)
#define PG8_WAIT_V(n) asm volatile("s_waitcnt vmcnt(" #n ")" ::: "memory")
#define PG8_WAIT_L(n) asm volatile("s_waitcnt lgkmcnt(" #n ")" ::: "memory")
#define PG8_BAR __builtin_amdgcn_s_barrier()
#define PG8_SCHED __builtin_amdgcn_sched_barrier(0)
    Unit cur, nxt; int ui = 0;
    if (!S.next(0, cur)) return;
    f32x4 acc[2][2][4][2];
#pragma unroll
    for (int a = 0; a < 2; ++a)
#pragma unroll
        for (int b = 0; b < 2; ++b)
#pragma unroll
            for (int m = 0; m < 4; ++m)
#pragma unroll
                for (int n = 0; n < 2; ++n) acc[a][b][m][n] = (f32x4){0.f, 0.f, 0.f, 0.f};
    bf16x8 At[4][2], B0[2][2], B1[2][2];
    const char* cA = (const char*)g.A + (size_t)cur.pm * tstep; const char* cB = (const char*)g.Bt + (size_t)cur.pn * tstep;
    PG8_STAGE(PG8_SB(0, 0), cB, voffB); PG8_STAGE(PG8_SB(0, 1), cB + hstep, voffB); PG8_STAGE(PG8_SA(0, 0), cA, voffA); PG8_STAGE(PG8_SA(0, 1), cA + hstep, voffA);
    if (wr == 1) PG8_BAR;
    PG8_WAIT_V(2); PG8_BAR;
    PG8_STAGE(PG8_SB(1, 0), cB + kstep, voffB); PG8_STAGE(PG8_SA(1, 0), cA + kstep, voffA); PG8_STAGE(PG8_SB(1, 1), cB + hstep + kstep, voffB);
    PG8_WAIT_V(6); PG8_BAR;
    for (;;) {
        const bool has_next = S.next(ui + 1, nxt);
        const char* nA = has_next ? (const char*)g.A + (size_t)nxt.pm * tstep : cA; const char* nB = has_next ? (const char*)g.Bt + (size_t)nxt.pn * tstep : cB;
        for (int t = 0; t < nt; t += 2) {
            const bool last = (t == nt - 2);
            const char* a1 = cA + (size_t)(t + 1) * kstep;
            const char* a2 = last ? nA : cA + (size_t)(t + 2) * kstep; const char* b2 = last ? nB : cB + (size_t)(t + 2) * kstep;
            const char* a3 = a2 + kstep; const char* b3 = b2 + kstep;
            PG8_LDB(B0, 0, 0); PG8_LDB(B1, 0, 1); PG8_SCHED; PG8_LDA(At, 0, 0); PG8_STAGE(PG8_SA(1, 1), a1 + hstep, voffA);
            PG8_WAIT_V(8); PG8_WAIT_L(0); PG8_BAR; PG8_MMA(0, 0, At, B0); PG8_MMA(0, 1, At, B1); PG8_BAR; PG8_SCHED;
            PG8_LDA(At, 0, 1); PG8_STAGE(PG8_SB(0, 0), b2, voffB); PG8_STAGE(PG8_SB(0, 1), b2 + hstep, voffB); PG8_STAGE(PG8_SA(0, 0), a2, voffA);
            PG8_WAIT_V(8); PG8_WAIT_L(0); PG8_BAR; PG8_MMA(1, 0, At, B0); PG8_MMA(1, 1, At, B1); PG8_BAR; PG8_SCHED;
            PG8_LDB(B0, 1, 0); PG8_LDB(B1, 1, 1); PG8_SCHED; PG8_LDA(At, 1, 0); PG8_STAGE(PG8_SA(0, 1), a2 + hstep, voffA);
            PG8_WAIT_V(8); PG8_WAIT_L(0); PG8_BAR; PG8_MMA(0, 0, At, B0); PG8_MMA(0, 1, At, B1); PG8_BAR; PG8_SCHED;
            PG8_LDA(At, 1, 1); PG8_STAGE(PG8_SB(1, 0), b3, voffB); PG8_STAGE(PG8_SB(1, 1), b3 + hstep, voffB); PG8_STAGE(PG8_SA(1, 0), a3, voffA);
            PG8_WAIT_V(8); PG8_WAIT_L(0); PG8_BAR; PG8_MMA(1, 0, At, B0); PG8_MMA(1, 1, At, B1); PG8_BAR; PG8_SCHED;
        }
        if (wr == 0) PG8_BAR;
        E(acc, cur, wr, wc, fr, fq);
        if (!has_next) break;
#pragma unroll
        for (int a = 0; a < 2; ++a)
#pragma unroll
            for (int b = 0; b < 2; ++b)
#pragma unroll
                for (int m = 0; m < 4; ++m)
#pragma unroll
                    for (int n = 0; n < 2; ++n) acc[a][b][m][n] = (f32x4){0.f, 0.f, 0.f, 0.f};
        cur = nxt; cA = nA; cB = nB; ++ui;
        if (wr == 1) PG8_BAR;
    }
    PG8_WAIT_V(0);
    PG8_BAR;
#undef PG8_SA
#undef PG8_SB
#undef PG8_STAGE
#undef PG8_LDA
#undef PG8_LDB
#undef PG8_MMA
#undef PG8_WAIT_V
#undef PG8_WAIT_L
#undef PG8_BAR
#undef PG8_SCHED
}
}

struct Params { const float* in[27]; float* out; unsigned char* ws; int ph_lo, ph_hi; };
enum { I_XP = 0, I_XS, I_SGLA, I_SRET, I_CCKV, I_CKR, I_SCONV, I_NMIX, I_NFFN, I_NFIN, I_WINAB, I_WGU, I_BG, I_GGLA, I_GRET, I_WOUTAB, I_WINC, I_GQ, I_GKV, I_WUQ, I_WUK, I_WUV, I_WOUTC, I_WFFNIN, I_WDW, I_BDW, I_WFFNOUT };

__device__ __forceinline__ float sum4(f32x4 a) { return (a.x + a.y) + (a.z + a.w); }
__device__ __forceinline__ float rstd_from16(const float* ssp, int row) {
    const f32x4* p = (const f32x4*)(ssp + (size_t)row * 16);
    const f32x4 a = p[0], b = p[1], c = p[2], d = p[3];
    const float s = (sum4(a) + sum4(b)) + (sum4(c) + sum4(d));
    return rsqrtf(s * (1.0f / 1024.0f) + EPS);
}
__device__ __forceinline__ f32x4 rope4(f32x4 v, f32x4 cs) { f32x4 r; r.x = v.x * cs.x - v.y * cs.y; r.y = v.x * cs.y + v.y * cs.x; r.z = v.z * cs.z - v.w * cs.w; r.w = v.z * cs.w + v.w * cs.z; return r; }
__device__ __forceinline__ float logsig(float x) { return fminf(x, 0.f) - log1pf(__expf(-fabsf(x))); }

struct EpiBf {
    static constexpr bool PERM = true;
    const Params* pp; int job;
    __device__ __forceinline__ void operator()(const f32x4 (&acc)[2][2][4][2], const pg8::Unit& u, int wr, int wc, int fr, int fq) const {
        const Params* q_ = pp; asm volatile("" : "+s"(q_));
        unsigned char* ws = q_->ws;
        const int MODE = job == 1 ? 2 : (job == 90 || job == 93 || job == 94) ? 3 : 0;
        bf16_t* O = (bf16_t*)(ws + (job == 1 ? WS_P : (job == 90 || job == 94) ? WS_Q : job == 91 ? WS_KN : job == 93 ? WS_QL : WS_VT)) + (job == 94 ? (size_t)MP * 1536 : 0);
        const int ldc = job == 1 ? NAB : (job == 90 || job == 94) ? 1536 : job == 91 ? 1024 : job == 93 ? 4096 : NKV;
        const int rowoff = (job == 93 || job == 94) ? MP : 0;
        const float* ssp = (const float*)(ws + ((job == 90 || job == 93 || job == 94) ? WS_SSQ : WS_SSP));
        const float* rot = (const float*)(ws + WS_ROT);
        const float* bgate = q_->in[I_BG];
        const int row0 = u.pm * 256 + wr * 64 + fr, col0 = u.pn * 256 + wc * 32 + 8 * fq;
        float rsv[2][4];
#pragma unroll
        for (int ai = 0; ai < 2; ++ai) {
#pragma unroll
            for (int m = 0; m < 4; ++m) {
                const int row = row0 + ai * 128 + m * 16;
                float r_ = 1.f;
                if (MODE == 1 || MODE == 2) r_ = rstd_from16(ssp, row);
                if (MODE == 3) { const f32x4* p = (const f32x4*)(ssp + (size_t)(row + rowoff) * 32); const float s = sum4(p[0]) + sum4(p[1]) + sum4(p[2]); r_ = rsqrtf(s * (1.0f / 384.0f) + EPS); }
                rsv[ai][m] = r_;
                if (m & 1) asm volatile("" ::: "memory");
            }
        }
#pragma unroll
        for (int ai = 0; ai < 2; ++ai)
#pragma unroll
            for (int m = 0; m < 4; ++m) {
                const int row = row0 + ai * 128 + m * 16;
                const float rs = rsv[ai][m];
#pragma unroll
                for (int bj = 0; bj < 2; ++bj) {
                    const int col = col0 + bj * 128;
                    f32x4 v0 = acc[ai][bj][m][0] * rs, v1 = acc[ai][bj][m][1] * rs;
                    bool dorope = false; int i0 = 0;
                    if (MODE == 2) { if (u.pn == 6 || u.pn == 7) { dorope = true; i0 = (col & 63) >> 1; } }
                    if (MODE == 3 && job != 93) { const int within = col % 192; if (within >= 128) { dorope = true; i0 = (within - 128) >> 1; } }
                    if (dorope) {
                        const f32x4* cs = (const f32x4*)(rot + ((size_t)posidx(row + rowoff) * 32 + i0) * 2);
                        const f32x4 c0 = cs[0], c1 = cs[1];
                        v0 = rope4(v0, c0);
                        v1 = rope4(v1, c1);
                    }
                    if (MODE == 2) { if (u.pn == 12) {
                        const f32x4 b0 = *(const f32x4*)(bgate + (col - 3072)), b1 = *(const f32x4*)(bgate + (col - 3072) + 4);
                        v0.x = logsig(v0.x + b0.x) * 0.0625f; v0.y = logsig(v0.y + b0.y) * 0.0625f; v0.z = logsig(v0.z + b0.z) * 0.0625f; v0.w = logsig(v0.w + b0.w) * 0.0625f;
                        v1.x = logsig(v1.x + b1.x) * 0.0625f; v1.y = logsig(v1.y + b1.y) * 0.0625f; v1.z = logsig(v1.z + b1.z) * 0.0625f; v1.w = logsig(v1.w + b1.w) * 0.0625f;
                    } }
                    u32x4 w; w.x = cvtpk(v0.x, v0.y); w.y = cvtpk(v0.z, v0.w); w.z = cvtpk(v1.x, v1.y); w.w = cvtpk(v1.z, v1.w);
                    *(u32x4*)(O + (size_t)row * ldc + col) = w;
                }
            }
    }
};

struct EpiRes {
    static constexpr bool PERM = false;
    const Params* pp; int job;
    __device__ __forceinline__ void operator()(const f32x4 (&acc)[2][2][4][2], const pg8::Unit& u, int wr, int wc, int fr, int fq) const {
        const Params* q_ = pp; asm volatile("" : "+s"(q_));
        bf16_t* XB = (bf16_t*)(q_->ws + WS_XB); float* ssp = (float*)(q_->ws + WS_SSP);
        const int row0 = u.pm * 256 + wr * 64 + fr, col0 = u.pn * 256 + wc * 32 + 4 * fq;
#pragma unroll
        for (int ai = 0; ai < 2; ++ai)
#pragma unroll
            for (int m = 0; m < 4; ++m) {
                const int row = row0 + ai * 128 + m * 16;
                float ss = 0.f;
#pragma unroll
                for (int bj = 0; bj < 2; ++bj)
#pragma unroll
                    for (int n = 0; n < 2; ++n) {
                        const int col = col0 + bj * 128 + n * 16;
                        const u32x2 rb = *(const u32x2*)(XB + (size_t)row * D + col);
                        const f32x4 r = (f32x4){bflo(rb.x), bfhi(rb.x), bflo(rb.y), bfhi(rb.y)};
                        const f32x4 x = r + acc[ai][bj][m][n];
                        { u32x2 w; w.x = cvtpk(x.x, x.y); w.y = cvtpk(x.z, x.w); *(u32x2*)(XB + (size_t)row * D + col) = w; }
                        ss += (x.x * x.x + x.y * x.y) + (x.z * x.z + x.w * x.w);
                    }
                ss += __shfl_xor(ss, 16); ss += __shfl_xor(ss, 32);
                if (fq == 0) ssp[(size_t)row * 16 + u.pn * 4 + wc] = ss;
                if (m & 1) asm volatile("" ::: "memory");
            }
    }
};

struct EpiInC {
    static constexpr bool PERM = false;
    const Params* pp;
    __device__ __forceinline__ void operator()(const f32x4 (&acc)[2][2][4][2], const pg8::Unit& u, int wr, int wc, int fr, int fq) const {
        const Params* q_ = pp; asm volatile("" : "+s"(q_));
        unsigned char* ws = q_->ws;
        const float* ssp = (const float*)(ws + WS_SSP); const float* rot = (const float*)(ws + WS_ROT); bf16_t* CQ = (bf16_t*)(ws + WS_CQ);
        bf16_t* CKVALL = (bf16_t*)(ws + WS_CKVALL); float* krout = q_->out + O_KR; bf16_t* KRALL = (bf16_t*)(ws + WS_KRALL); float* ssq = (float*)(ws + WS_SSQ);
        const int row0 = u.pm * 256 + wr * 64 + fr, col0 = u.pn * 256 + wc * 32 + 4 * fq;

#pragma unroll
        for (int ai = 0; ai < 2; ++ai)
#pragma unroll
            for (int m = 0; m < 4; ++m) {
                const int row = row0 + ai * 128 + m * 16;
                const float rs = rstd_from16(ssp, row);
#pragma unroll
                for (int bj = 0; bj < 2; ++bj) {
                    const int blk = u.pn * 2 + bj;
                    float ss = 0.f;
#pragma unroll
                    for (int n = 0; n < 2; ++n) {
                        const int col = col0 + bj * 128 + n * 16;
                        f32x4 v = acc[ai][bj][m][n] * rs;
                        if (blk < 3) {
                            u32x2 w; w.x = cvtpk(v.x, v.y); w.y = cvtpk(v.z, v.w);
                            *(u32x2*)(CQ + (size_t)row * 384 + col) = w;
                        } else if (blk < 7) {
                            u32x2 w; w.x = cvtpk(v.x, v.y); w.y = cvtpk(v.z, v.w);
                            *(u32x2*)(CKVALL + (size_t)kvtok(row) * 512 + (col - 384)) = w;
                        } else if (col < 960) {
                            const int j = col - 896, i0 = j >> 1;
                            const f32x4 cs = *(const f32x4*)(rot + ((size_t)posidx(row) * 32 + i0) * 2);
                            v = rope4(v, cs);
                            float* ko = krout + (size_t)row * 64;
                            ko[i0] = v.x; ko[32 + i0] = v.y; ko[i0 + 1] = v.z; ko[33 + i0] = v.w;
                            u32x2 w; w.x = cvtpk(v.x, v.y); w.y = cvtpk(v.z, v.w);
                            *(u32x2*)(KRALL + (size_t)kvtok(row) * 64 + j) = w;
                        }
                        ss += (v.x * v.x + v.y * v.y) + (v.z * v.z + v.w * v.w);
                    }
                    ss += __shfl_xor(ss, 16); ss += __shfl_xor(ss, 32);
                    if (fq == 0) ssq[(size_t)row * 32 + blk * 4 + wc] = ss;
                }
                asm volatile("" ::: "memory");
            }
    }
};

__device__ __forceinline__ f32x2 gelu_pk(f32x2 v) {
    const f32x2 av = __builtin_elementwise_abs(v), d = av * 0.2316418882f + 1.0f;
    f32x2 t; t.x = __builtin_amdgcn_rcpf(d.x); t.y = __builtin_amdgcn_rcpf(d.y);
    f32x2 q = t * 0.5307027145f + (-0.7265760135f); q = q * t + 0.7107068705f; q = q * t + (-0.142248368f); q = q * t + 0.127414796f; q = q * t;
    const f32x2 sx = (v * v) * (-0.72134752044f);
    f32x2 e; e.x = __builtin_amdgcn_exp2f(sx.x); e.y = __builtin_amdgcn_exp2f(sx.y);
    const f32x2 m = v * (q * e), r = v - m;
    f32x2 o; o.x = v.x < 0.f ? m.x : r.x; o.y = v.y < 0.f ? m.y : r.y; return o;
}
__device__ __forceinline__ void attn_sample_unit(const Params& p, LAS unsigned char* lds, int b, int h) {
    int tid_ = threadIdx.x; asm volatile("" : "+v"(tid_));
    const int tid = tid_, lane = tid & 63, w = tid >> 6, fr = lane & 15, fq = lane >> 4;
    const bf16_t* Q = (const bf16_t*)(p.ws + WS_Q); const bf16_t* KN = (const bf16_t*)(p.ws + WS_KN);
    const bf16_t* KRA = (const bf16_t*)(p.ws + WS_KRALL); const bf16_t* VT = (const bf16_t*)(p.ws + WS_VT);
    bf16_t* AO = (bf16_t*)(p.ws + WS_AO);
    const int qrow0 = MP + b * DSEQ, kv0 = MP + b * KVS;
    bf16x8 qf[6];
#pragma unroll
    for (int ks = 0; ks < 6; ++ks) qf[ks] = *(const bf16x8*)(Q + (size_t)(qrow0 + fr) * 1536 + h * 192 + ks * 32 + fq * 8);
    f32x4 oacc[8];
#pragma unroll
    for (int dt = 0; dt < 8; ++dt) oacc[dt] = (f32x4){0.f, 0.f, 0.f, 0.f};
    float mrun = -1e30f, lrun = 0.f;
    constexpr int NSTEP = (KVS + 31) / 32;
    bf16x8 kf[2][6];
#define SMP_KLOAD(ss) do { const int kb_ = (ss) * 32; \
        _Pragma("unroll") for (int e = 0; e < 2; ++e) { const size_t tok = (size_t)(kv0 + kb_ + e * 16 + fr); \
            _Pragma("unroll") for (int ks = 0; ks < 4; ++ks) kf[e][ks] = *(const bf16x8*)(KN + tok * 1024 + h * 128 + ks * 32 + fq * 8); \
            _Pragma("unroll") for (int ks = 4; ks < 6; ++ks) kf[e][ks] = *(const bf16x8*)(KRA + tok * 64 + (ks - 4) * 32 + fq * 8); } } while (0)
    if (w < NSTEP) SMP_KLOAD(w);
    for (int st = w; st < NSTEP; st += 8) {
        const int kb = st * 32;
        u32x2 va0[8], va1[8];
#pragma unroll
        for (int dt = 0; dt < 8; ++dt) { const bf16_t* vp = VT + (size_t)(h * 128 + dt * 16 + fr) * NKV + kv0 + kb + fq * 4;
            va0[dt] = *(const u32x2*)vp; va1[dt] = *(const u32x2*)(vp + 16); }
        f32x4 s0 = (f32x4){0.f, 0.f, 0.f, 0.f}, s1 = (f32x4){0.f, 0.f, 0.f, 0.f};
#pragma unroll
        for (int ks = 0; ks < 6; ++ks) { s0 = __builtin_amdgcn_mfma_f32_16x16x32_bf16(kf[0][ks], qf[ks], s0, 0, 0, 0); s1 = __builtin_amdgcn_mfma_f32_16x16x32_bf16(kf[1][ks], qf[ks], s1, 0, 0, 0); }
        if (st + 8 < NSTEP) SMP_KLOAD(st + 8);
        if (kb + 32 > KVS) {
#pragma unroll
            for (int j = 0; j < 4; ++j) { if (kb + fq * 4 + j >= KVS) s0[j] = -1e30f; if (kb + 16 + fq * 4 + j >= KVS) s1[j] = -1e30f; }
        }
        float mx = fmaxf(fmaxf(fmaxf(s0[0], s0[1]), fmaxf(s0[2], s0[3])), fmaxf(fmaxf(s1[0], s1[1]), fmaxf(s1[2], s1[3])));
        mx = fmaxf(mx, __shfl_xor(mx, 16)); mx = fmaxf(mx, __shfl_xor(mx, 32));
        const float mnew = fmaxf(mrun, mx), alpha = __builtin_amdgcn_exp2f(mrun - mnew);
        mrun = mnew;
        float ps = 0.f;
#pragma unroll
        for (int j = 0; j < 4; ++j) { s0[j] = __builtin_amdgcn_exp2f(s0[j] - mnew); s1[j] = __builtin_amdgcn_exp2f(s1[j] - mnew); ps += s0[j] + s1[j]; }
        lrun = lrun * alpha + ps;
        u32x4 wv; wv.x = cvtpk(s0[0], s0[1]); wv.y = cvtpk(s0[2], s0[3]); wv.z = cvtpk(s1[0], s1[1]); wv.w = cvtpk(s1[2], s1[3]);
        const bf16x8 pf = __builtin_bit_cast(bf16x8, wv);
#pragma unroll
        for (int dt = 0; dt < 8; ++dt) {
            const bf16x8 vf = __builtin_bit_cast(bf16x8, (u32x4){va0[dt].x, va0[dt].y, va1[dt].x, va1[dt].y});
            oacc[dt] = __builtin_amdgcn_mfma_f32_16x16x32_bf16(vf, pf, oacc[dt] * alpha, 0, 0, 0);
        }
    }
#undef SMP_KLOAD
    { float l = lrun; l += __shfl_xor(l, 16); l += __shfl_xor(l, 32);
      LAS float* OW = (LAS float*)(lds + w * 8192); LAS float* ML = (LAS float*)(lds + 65536 + w * 128);
#pragma unroll
      for (int dt = 0; dt < 8; ++dt)
#pragma unroll
          for (int j = 0; j < 4; ++j) OW[(dt * 16 + fq * 4 + j) * 16 + fr] = oacc[dt][j];
      if (fq == 0) { ML[fr] = mrun; ML[16 + fr] = l; } }
    __syncthreads();
    { const int q = tid & 15, dc = tid >> 4;
      float mw[8], M_ = -1e30f;
#pragma unroll
      for (int ww = 0; ww < 8; ++ww) { mw[ww] = ((LAS float*)(lds + 65536 + ww * 128))[q]; M_ = fmaxf(M_, mw[ww]); }
      float L_ = 0.f, o[4] = {0.f, 0.f, 0.f, 0.f};
#pragma unroll
      for (int ww = 0; ww < 8; ++ww) { const float sc = __builtin_amdgcn_exp2f(mw[ww] - M_); L_ += sc * ((LAS float*)(lds + 65536 + ww * 128))[16 + q];
          const LAS float* OW = (LAS float*)(lds + ww * 8192);
#pragma unroll
          for (int i = 0; i < 4; ++i) o[i] += sc * OW[(dc * 4 + i) * 16 + q]; }
      const float inv = 1.f / L_;
      u32x2 wv; wv.x = cvtpk(o[0] * inv, o[1] * inv); wv.y = cvtpk(o[2] * inv, o[3] * inv);
      *(u32x2*)(AO + (size_t)(qrow0 + q) * D + h * 128 + dc * 4) = wv; }
    __syncthreads();
}

struct EpiFfn {
    static constexpr bool PERM = true;
    const Params* pp; int layer;
    __device__ __forceinline__ void operator()(f32x4 (&acc)[2][2][4][2], const pg8::Unit& u, int wr_, int wc_, int fr_, int fq_) const {
        const Params* q_ = pp; asm volatile("" : "+s"(q_));
        int wr = wr_, wc = wc_, fr = fr_, fq = fq_;
        asm volatile("" : "+s"(wr), "+s"(wc), "+v"(fr), "+v"(fq));
        unsigned char* ws = q_->ws;
        const float* rsp = (const float*)(ws + WS_RS);
        const int row0 = u.pm * 256 + wr * 64 + fr;
#pragma unroll
        for (int ai = 0; ai < 2; ++ai)
#pragma unroll
            for (int m = 0; m < 4; ++m) {
                const float rs = rsp[row0 + ai * 128 + m * 16];
#pragma unroll
                for (int bj = 0; bj < 2; ++bj)
#pragma unroll
                    for (int n = 0; n < 2; ++n) acc[ai][bj][m][n] *= rs;
                if (m & 1) asm volatile("" ::: "memory");
            }
        bf16_t* ACT = (bf16_t*)(ws + WS_ACT); bf16_t* SA = (bf16_t*)(ws + WS_SIDEA); bf16_t* SB = (bf16_t*)(ws + WS_SIDEB); bf16_t* SU = (bf16_t*)(ws + WS_SIDEU);
        const float* wd = q_->in[I_WDW] + (size_t)layer * 3 * DFF; const float* bd = q_->in[I_BDW] + (size_t)layer * DFF;
        const int lane = fq * 16 + fr, src1 = (lane & 48) | ((fr + 15) & 15), src2 = (lane & 48) | ((fr + 14) & 15);
        const bool smp = u.pm * 256 >= MP;
#pragma unroll
        for (int n = 0; n < 2; ++n) {
            asm volatile("" ::: "memory");
            int col = u.pn * 128 + wc * 32 + 8 * fq + 4 * n;
            asm volatile("" : "+v"(col));
            const f32x4 w0 = *(const f32x4*)(wd + col), w1 = *(const f32x4*)(wd + DFF + col), w2 = *(const f32x4*)(wd + 2 * DFF + col), bi = *(const f32x4*)(bd + col);
#pragma unroll
            for (int ai = 0; ai < 2; ++ai) {
                f32x4 pr1 = (f32x4){0.f, 0.f, 0.f, 0.f}, pr2 = pr1;
#pragma unroll
                for (int m = 0; m < 4; ++m) {
                    int row = row0 + ai * 128 + m * 16;
                    asm volatile("" : "+v"(row));
                    const f32x4 a = acc[ai][0][m][n], uu = acc[ai][1][m][n];
                    f32x4 r1, r2;
#pragma unroll
                    for (int e = 0; e < 4; ++e) { r1[e] = __shfl(a[e], src1); r2[e] = __shfl(a[e], src2); }
                    const f32x4 p1 = fr >= 1 ? r1 : pr1, p2 = fr >= 2 ? r2 : pr2;
                    const bool deferred = smp ? (fr < 2) : (m == 0 && fr < 2);
                    const int blk = smp ? (MP / 64 + ((row - MP) >> 4)) : (row >> 6);
                    if (!deferred) {
                        const f32x4 cv = bi + p2 * w0 + p1 * w1 + a * w2;
                        const f32x2 g0 = gelu_pk((f32x2){cv.x, cv.y}), g1 = gelu_pk((f32x2){cv.z, cv.w});
                        u32x2 o; o.x = cvtpk(g0.x * uu.x, g0.y * uu.y); o.y = cvtpk(g1.x * uu.z, g1.y * uu.w);
                        *(u32x2*)(ACT + (size_t)row * DFF + col) = o;
                    } else {
                        u32x2 oa, ou; oa.x = cvtpk(a.x, a.y); oa.y = cvtpk(a.z, a.w); ou.x = cvtpk(uu.x, uu.y); ou.y = cvtpk(uu.z, uu.w);
                        *(u32x2*)(SB + ((size_t)blk * 2 + fr) * DFF + col) = oa; *(u32x2*)(SU + ((size_t)blk * 2 + fr) * DFF + col) = ou;
                    }
                    if (fr >= 14 && (smp || m == 3)) { u32x2 oa; oa.x = cvtpk(a.x, a.y); oa.y = cvtpk(a.z, a.w); *(u32x2*)(SA + ((size_t)blk * 2 + (fr - 14)) * DFF + col) = oa; }
                    pr1 = r1; pr2 = r2;
                    __builtin_amdgcn_sched_barrier(0);
                }
            }
        }
    }
};

template <class F> __device__ __forceinline__ void tr_item(const F& f, int K, bf16_t* WT, int item, int nblk, LAS float* scr, int lane) {
    const int kb = item / nblk, nb = item % nblk, k0 = 64 * kb, n0 = 32 * nb;
#pragma unroll 4
    for (int i = 0; i < 32; ++i) { const int kk = 2 * i + (lane >> 5); scr[kk * 33 + (lane & 31)] = f(k0 + kk, n0 + (lane & 31)); }
    asm volatile("s_waitcnt lgkmcnt(0)" ::: "memory");
    const int c = lane & 7;
#pragma unroll
    for (int j = 0; j < 4; ++j) { const int n = (lane >> 3) + 8 * j; const LAS float* s = scr + (8 * c) * 33 + n;
        u32x4 o; o.x = cvtpk(s[0 * 33], s[1 * 33]); o.y = cvtpk(s[2 * 33], s[3 * 33]); o.z = cvtpk(s[4 * 33], s[5 * 33]); o.w = cvtpk(s[6 * 33], s[7 * 33]);
        *(u32x4*)(WT + (size_t)(n0 + n) * K + k0 + 8 * c) = o; }
    asm volatile("s_waitcnt lgkmcnt(0)" ::: "memory");
}
template <bool FFNPERM = false>
__device__ __forceinline__ void tr_item_plain(const float* W, int ldw, const float* g, int K, bf16_t* WT, int item, int nblk, LAS float* scr, int lane) {
    const int kb = item / nblk, nb = item % nblk, k0 = 64 * kb, n0 = 32 * nb;
    const int c4 = (lane & 7) * 4, kr = lane >> 3;
    const int ns = FFNPERM ? (((n0 & 255) >> 7) * DFF + (n0 >> 8) * 128 + (n0 & 127)) : n0;
#pragma unroll
    for (int i = 0; i < 8; ++i) { const int kk = i * 8 + kr; f32x4 v = __builtin_nontemporal_load((const f32x4*)(W + (size_t)(k0 + kk) * ldw + ns + c4));
        if (g) v = v * g[k0 + kk];
        scr[kk * 33 + c4] = v.x; scr[kk * 33 + c4 + 1] = v.y; scr[kk * 33 + c4 + 2] = v.z; scr[kk * 33 + c4 + 3] = v.w; }
    asm volatile("s_waitcnt lgkmcnt(0)" ::: "memory");
    const int c = lane & 7;
#pragma unroll
    for (int j = 0; j < 4; ++j) { const int n = (lane >> 3) + 8 * j; const LAS float* s = scr + (8 * c) * 33 + n;
        u32x4 o; o.x = cvtpk(s[0 * 33], s[1 * 33]); o.y = cvtpk(s[2 * 33], s[3 * 33]); o.z = cvtpk(s[4 * 33], s[5 * 33]); o.w = cvtpk(s[6 * 33], s[7 * 33]);
        *(u32x4*)(WT + (size_t)(n0 + n) * K + k0 + 8 * c) = o; }
    asm volatile("s_waitcnt lgkmcnt(0)" ::: "memory");
}
struct FPlain { const float* W; int ldw; const float* g; float sc;
    __device__ __forceinline__ float operator()(int k, int n) const { float v = W[(size_t)k * ldw + n] * sc; if (g) v *= g[k]; return v; } };
struct FInAB { const float* W; const float* g; const float* wgu;
    __device__ __forceinline__ float operator()(int k, int n) const {
        const float* wr = W + (size_t)k * 3088; float v;
        if (n < 1536) { v = wr[n]; if (n < 256) v *= 0.125f; }
        else if (n < 2048) { const int q = n - 1536, isk = q >> 8, r = q & 255, h = r >> 6, j = r & 63, i = j >> 1, hf = j & 1;
            v = wr[(isk ? 1808 : 1552) + h * 64 + hf * 32 + i]; if (isk) v *= 0.125f; }
        else if (n < 3072) { v = wr[n + 16]; }
        else { const int c = n - 3072; float s = 0.f;
#pragma unroll
            for (int r = 0; r < 16; ++r) s += wr[1536 + r] * wgu[r * 256 + c];
            v = s; }
        return v * g[k];
    } };
struct FInC { const float* W; const float* g;
    __device__ __forceinline__ float operator()(int k, int n) const {
        const float* wr = W + (size_t)k * 960; float v;
        if (n < 896) v = wr[n];
        else if (n < 960) { const int j = n - 896; v = wr[896 + (j & 1) * 32 + (j >> 1)]; }
        else v = 0.f;
        return v * g[k];
    } };
struct FUq { const float* W; const float* g; float sc;
    __device__ __forceinline__ float operator()(int k, int n) const {
        const int h = n / 192, j = n % 192; int src = n;
        if (j >= 128) { const int jj = j - 128; src = h * 192 + 128 + (jj & 1) * 32 + (jj >> 1); }
        return W[(size_t)k * 1536 + src] * g[k] * sc;
    } };

struct FQl { const float* wuq; const float* wuk; const float* g; float sc;
    __device__ __forceinline__ float operator()(int k, int n) const {
        const int h = n >> 9, l = n & 511; const float* a = wuq + (size_t)k * 1536 + h * 192; const float* b = wuk + ((size_t)l * 8 + h) * 128;
        float s0 = 0.f, s1 = 0.f;
#pragma unroll 8
        for (int q = 0; q < 128; q += 2) { s0 += a[q] * b[q]; s1 += a[q + 1] * b[q + 1]; }
        return (s0 + s1) * g[k] * sc;
    } };

__device__ __forceinline__ bf16x8 cvt8(const float* p) { const f32x4 a = *(const f32x4*)p, b = *(const f32x4*)(p + 4); u32x4 w; w.x = cvtpk(a.x, a.y); w.y = cvtpk(a.z, a.w); w.z = cvtpk(b.x, b.y); w.w = cvtpk(b.z, b.w); return __builtin_bit_cast(bf16x8, w); }
__device__ __forceinline__ void fold_wql(const Params& p, int vb, int nvb) {
    int tid_ = threadIdx.x; asm volatile("" : "+v"(tid_));
    const int lane = tid_ & 63, wave = tid_ >> 6, fr = lane & 15, fq = lane >> 4;
    const float* wuq = p.in[I_WUQ]; const float* wuk = p.in[I_WUK]; const float* g = p.in[I_GQ];
    bf16_t* WQL = (bf16_t*)(p.ws + WS_W_QL);
    const float sc = 0.07216878364870322f * 1.4426950408889634f;
    for (int it = vb * 8 + wave; it < 8 * 32 * 24; it += nvb * 8) {
        const int h = it / (32 * 24), lt = (it / 24) % 32, kt = it % 24;
        const float* ap = wuk + ((size_t)(lt * 16 + fr) * 8 + h) * 128 + fq * 8;
        const float* bp = wuq + (size_t)(kt * 16 + fr) * 1536 + h * 192 + fq * 8;
        f32x4 acc = (f32x4){0.f, 0.f, 0.f, 0.f};
#pragma unroll
        for (int ks = 0; ks < 4; ++ks) acc = __builtin_amdgcn_mfma_f32_16x16x32_bf16(cvt8(ap + ks * 32), cvt8(bp + ks * 32), acc, 0, 0, 0);
        const int kk = kt * 16 + fr; const float gs = g[kk] * sc;
#pragma unroll
        for (int j = 0; j < 4; ++j) WQL[(size_t)(h * 512 + lt * 16 + fq * 4 + j) * 384 + kk] = (bf16_t)(cvtpk(acc[j] * gs, 0.f) & 0xffff);
    }
}

__device__ __forceinline__ float wave_sum(float v) {
#pragma unroll
    for (int o = 1; o < 64; o <<= 1) v += __shfl_xor(v, o);
    return v;
}

__device__ __forceinline__ void phase_prologue(const Params& p, LAS unsigned char* lds, int which, int vb, int nvb) {
    int tid_ = threadIdx.x; asm volatile("" : "+v"(tid_));
    const int tid = tid_, lane = tid & 63, wave = tid >> 6;
    const int gw = vb * 8 + wave, NGW = nvb * 8;
    LAS float* scr = (LAS float*)(lds + wave * 16384);
    unsigned char* ws = p.ws;
    constexpr int I1 = 16 * (NAB / 32), I2 = 16 * 32, I3 = 16 * (5632 / 32), I4 = 44 * 32, I5 = 16 * 32, I6 = 6 * 48, I7 = 8 * 32, I8 = 8 * 32, I9 = 16 * 32;
    constexpr int NIT = I1 + I2 + 2 * I3 + 2 * I4 + I5 + I6 + I7 + I8 + I9;
    for (int it = gw; it < NIT; it += NGW) {
        int r = it;
        { int cls = it < I1 ? 0 : 1;
          const int r3 = it - (I1 + I2); if (r3 >= I3 && r3 < 2 * I3) cls = 2;
          const int r4 = r3 - 2 * I3; if (r4 >= I4 && r4 < 2 * I4) cls = 2;
          if (!((which >> cls) & 1)) continue; }
        if (r < I1) { FInAB f{p.in[I_WINAB], p.in[I_NMIX], p.in[I_WGU]}; tr_item(f, 1024, (bf16_t*)(ws + WS_W_INAB), r, NAB / 32, scr, lane); continue; } r -= I1;
        if (r < I2) { tr_item_plain(p.in[I_WOUTAB], 1024, nullptr, 1024, (bf16_t*)(ws + WS_W_OUTAB), r, 32, scr, lane); continue; } r -= I2;
        if (r < 2 * I3) { const int l = r / I3; r -= l * I3; tr_item_plain<true>(p.in[I_WFFNIN] + (size_t)l * 1024 * 5632, 5632, p.in[I_NFFN] + l * 1024, 1024, (bf16_t*)(ws + WS_W_FFNIN) + (size_t)l * 5632 * 1024, r, 176, scr, lane); continue; } r -= 2 * I3;
        if (r < 2 * I4) { const int l = r / I4; r -= l * I4; tr_item_plain(p.in[I_WFFNOUT] + (size_t)l * 2816 * 1024, 1024, nullptr, 2816, (bf16_t*)(ws + WS_W_FFNOUT) + (size_t)l * 1024 * 2816, r, 32, scr, lane); continue; } r -= 2 * I4;
        if (r < I5) { FInC f{p.in[I_WINC], p.in[I_NMIX] + 1024}; tr_item(f, 1024, (bf16_t*)(ws + WS_W_INC), r, 32, scr, lane); continue; } r -= I5;
        if (r < I6) { FUq f{p.in[I_WUQ], p.in[I_GQ], 0.07216878364870322f * 1.4426950408889634f}; tr_item(f, 384, (bf16_t*)(ws + WS_W_UQ), r, 48, scr, lane); continue; } r -= I6;
        if (r < I7) { tr_item_plain(p.in[I_WUK], 1024, nullptr, 512, (bf16_t*)(ws + WS_W_UK), r, 32, scr, lane); continue; } r -= I7;
        if (r < I8) { tr_item_plain(p.in[I_WUV], 1024, nullptr, 512, (bf16_t*)(ws + WS_W_UV), r, 32, scr, lane); continue; } r -= I8;
        { tr_item_plain(p.in[I_WOUTC], 1024, nullptr, 1024, (bf16_t*)(ws + WS_W_OUTC), r, 32, scr, lane); }
    }
    if (!(which & 1)) return;
    bf16_t* XB = (bf16_t*)(ws + WS_XB); float* ssp = (float*)(ws + WS_SSP);
    for (int row = gw; row < M; row += NGW) {
        const float* x = row < MP ? p.in[I_XP] + (size_t)row * D : p.in[I_XS] + (size_t)(row - MP) * D;
        float ss = 0.f;
#pragma unroll
        for (int j = 0; j < 4; ++j) { const f32x4 v = __builtin_nontemporal_load((const f32x4*)(x + j * 256 + lane * 4)); ss += (v.x * v.x + v.y * v.y) + (v.z * v.z + v.w * v.w);
            u32x2 w; w.x = cvtpk(v.x, v.y); w.y = cvtpk(v.z, v.w); *(u32x2*)(XB + (size_t)row * D + j * 256 + lane * 4) = w; }
        ss = wave_sum(ss);
        if (lane < 16) ssp[(size_t)row * 16 + lane] = lane == 0 ? ss : 0.f;
    }
    float* rot = (float*)(ws + WS_ROT);
    for (int idx = vb * 512 + tid; idx < NPOS * 32; idx += nvb * 512) {
        const int pi = idx >> 5, i = idx & 31; const double pos = (double)(pi < SEQ ? pi : PAST + (pi - SEQ));
        double fr = 1.0; for (int q = 0; q < i; ++q) fr *= 0.7498942093324559;
        const double ang = pos * fr; const double TWO_PI = 6.283185307179586476925287;
        const double kq = __builtin_rint(ang / TWO_PI); const double r = ang - kq * TWO_PI; const double r2 = r * r;
        double sn = 0.0, cn = 0.0, ts = r, tc = 1.0;
        for (int q = 0; q < 15; ++q) { sn += ts; cn += tc; tc = -tc * r2 / (double)((2 * q + 1) * (2 * q + 2)); ts = -ts * r2 / (double)((2 * q + 2) * (2 * q + 3)); }
        rot[(size_t)idx * 2] = (float)cn; rot[(size_t)idx * 2 + 1] = (float)sn;
    }
}

constexpr int SK = 72;
constexpr int L_QR = 0, L_KR = 9216, L_QD = 18432, L_KD = 27648, L_SC = 36864, L_VT = 46080, L_ST = 64512, L_O = 82944, L_SEG = 116736, L_BREF = 118784, L_BLAST = 119040;
constexpr int OS = 132;

__device__ __forceinline__ bf16x8 ldfrag(const LAS unsigned char* base, int row, int col) { return *(const LAS bf16x8*)(base + (row * SK + col) * 2); }

__device__ __forceinline__ void dla_unit(const Params& p, LAS unsigned char* lds, int u) {
    int tid_ = threadIdx.x; asm volatile("" : "+v"(tid_));
    const int tid = tid_, lane = tid & 63, w = tid >> 6, fr = lane & 15, fq = lane >> 4;
    int mixer, b, h, row0, T, c; const float* s_in; float* s_out;
    if (u < 128) { mixer = u >> 6; b = (u & 63) >> 2; h = u & 3; row0 = b * SEQ; T = SEQ; c = 64; s_in = nullptr;
        s_out = p.out + (mixer ? O_RET_P : O_GLA_P) + (size_t)(b * 4 + h) * 64 * 128; }
    else { const int v = u - 128; mixer = v >> 7; b = (v & 127) >> 2; h = v & 3; row0 = MP + b * DSEQ; T = DSEQ; c = 16;
        s_in = p.in[mixer ? I_SRET : I_SGLA] + (size_t)(b * 4 + h) * 64 * 128;
        s_out = p.out + (mixer ? O_RET_S : O_GLA_S) + (size_t)(b * 4 + h) * 64 * 128; }
    const bf16_t* P = (const bf16_t*)(p.ws + WS_P);
    bf16_t* MIX = (bf16_t*)(p.ws + WS_MIX);
    const int qc = (mixer ? 1536 : 0) + h * 64, kc = (mixer ? 1792 : 256) + h * 64, vc0 = (mixer ? 2048 : 512) + h * 128, gc0 = (mixer ? 2560 : 1024) + h * 128, lac = 3072 + h * 64;
    const float* gn = p.in[mixer ? I_GRET : I_GGLA] + h * 128;
    const float lgam = log1pf(-exp2f(-5.0f - (float)h));
    const int tref = (c - 1) >> 1;
    LAS float* SEG = (LAS float*)(lds + L_SEG); LAS float* BREF = (LAS float*)(lds + L_BREF); LAS float* BLAST = (LAS float*)(lds + L_BLAST);
    LAS float* OL = (LAS float*)(lds + L_O);
    const int kr = w & 3, vt0 = (w >> 2) * 4;
    f32x4 Sacc[4];
#pragma unroll
    for (int i = 0; i < 4; ++i) {
        if (s_in) { for (int j = 0; j < 4; ++j) { const int km = kr * 16 + fq * 4 + j, ko = mixer ? ((km & 1) * 32 + (km >> 1)) : km;
            Sacc[i][j] = s_in[(size_t)ko * 128 + (vt0 + i) * 16 + fr]; } }
        else Sacc[i] = (f32x4){0.f, 0.f, 0.f, 0.f};
    }
    __syncthreads();
#pragma unroll
    for (int i = 0; i < 4; ++i) { u32x2 wv; wv.x = cvtpk(Sacc[i][0], Sacc[i][1]); wv.y = cvtpk(Sacc[i][2], Sacc[i][3]);
        *(LAS u32x2*)(lds + L_ST + (((vt0 + i) * 16 + fr) * SK + kr * 16 + fq * 4) * 2) = wv; }
    const int kcol = lane, seg = w;
    const int nch = T / c;
    unsigned short la_r[8], q_r[8], k_r[8], v_r[16];
    const int vv_ = tid & 127, sg_ = tid >> 7;
#define DLA_LOAD(rr) do { \
        _Pragma("unroll") for (int i = 0; i < 8; ++i) { const int t = seg * 8 + i; const bool ok = t < c; const size_t ro = (size_t)((rr) + (ok ? t : 0)) * NAB; \
            la_r[i] = (ok && !mixer) ? P[ro + lac + kcol] : (unsigned short)0; q_r[i] = ok ? P[ro + qc + kcol] : (unsigned short)0; k_r[i] = ok ? P[ro + kc + kcol] : (unsigned short)0; } \
        _Pragma("unroll") for (int i = 0; i < 16; ++i) { const int s_ = sg_ * 16 + i; v_r[i] = (s_ < c) ? P[(size_t)((rr) + s_) * NAB + vc0 + vv_] : (unsigned short)0; } } while (0)
    DLA_LOAD(row0);
    float gnv[16];
#pragma unroll
    for (int i = 0; i < 16; ++i) gnv[i] = gn[(tid & 7) * 16 + i];
    for (int n = 0; n < nch; ++n) {
        const int r0 = row0 + n * c;
        float bb[8];
        {
            float run = 0.f;
#pragma unroll
            for (int i = 0; i < 8; ++i) { const int t = seg * 8 + i; float la = 0.f;
                if (t < c) la = mixer ? lgam : bf2f(la_r[i]);
                run += la; bb[i] = run; }
            SEG[seg * 64 + kcol] = run;
        }
        __syncthreads();
        {
            float off = 0.f;
            for (int s = 0; s < seg; ++s) off += SEG[s * 64 + kcol];
#pragma unroll
            for (int i = 0; i < 8; ++i) { bb[i] += off; if (seg * 8 + i == tref) BREF[kcol] = bb[i]; if (seg * 8 + i == 63) BLAST[kcol] = bb[i]; }
        }
        __syncthreads();
        {
            const float bref = BREF[kcol], blast = BLAST[kcol];
            float kd[8];
#pragma unroll
            for (int i = 0; i < 8; ++i) { const int t = seg * 8 + i; const float q = bf2f(q_r[i]), k = bf2f(k_r[i]);
                const float e1 = __expf(bb[i] - bref), e2 = __expf(bref - bb[i]), e3 = __expf(bb[i]), e4 = __expf(blast - bb[i]);
                *(LAS bf16_t*)(lds + L_QR + (t * SK + kcol) * 2) = (bf16_t)(cvtpk(q * e1, 0.f) & 0xffff);
                *(LAS bf16_t*)(lds + L_KR + (t * SK + kcol) * 2) = (bf16_t)(cvtpk(k * e2, 0.f) & 0xffff);
                *(LAS bf16_t*)(lds + L_QD + (t * SK + kcol) * 2) = (bf16_t)(cvtpk(q * e3, 0.f) & 0xffff);
                kd[i] = k * e4; }
            u32x4 wv; wv.x = cvtpk(kd[0], kd[1]); wv.y = cvtpk(kd[2], kd[3]); wv.z = cvtpk(kd[4], kd[5]); wv.w = cvtpk(kd[6], kd[7]);
            *(LAS u32x4*)(lds + L_KD + (kcol * SK + seg * 8) * 2) = wv;
            const int v = tid & 127, sg = tid >> 7;
            float vv[16];
#pragma unroll
            for (int i = 0; i < 16; ++i) vv[i] = bf2f(v_r[i]);
            u32x4 w0, w1; w0.x = cvtpk(vv[0], vv[1]); w0.y = cvtpk(vv[2], vv[3]); w0.z = cvtpk(vv[4], vv[5]); w0.w = cvtpk(vv[6], vv[7]);
            w1.x = cvtpk(vv[8], vv[9]); w1.y = cvtpk(vv[10], vv[11]); w1.z = cvtpk(vv[12], vv[13]); w1.w = cvtpk(vv[14], vv[15]);
            *(LAS u32x4*)(lds + L_VT + (v * SK + sg * 16) * 2) = w0; *(LAS u32x4*)(lds + L_VT + (v * SK + sg * 16 + 8) * 2) = w1;
        }
        if (n + 1 < nch) DLA_LOAD(r0 + c);
        u32x4 gate0, gate1;
        { const int tj = tid >> 3, vsj = (tid & 7) * 16; const size_t rowg = (size_t)(r0 + (tj < c ? tj : 0));
          gate0 = *(const u32x4*)(P + rowg * NAB + gc0 + vsj); gate1 = *(const u32x4*)(P + rowg * NAB + gc0 + vsj + 8); }
        __syncthreads();
        {
            const int tr = w & 3;
#pragma unroll
            for (int e = 0; e < 2; ++e) { const int sc = (w >> 2) * 2 + e; f32x4 a = (f32x4){0.f, 0.f, 0.f, 0.f};
#pragma unroll
                for (int ks = 0; ks < 2; ++ks) a = __builtin_amdgcn_mfma_f32_16x16x32_bf16(ldfrag(lds + L_QR, tr * 16 + fr, ks * 32 + fq * 8), ldfrag(lds + L_KR, sc * 16 + fr, ks * 32 + fq * 8), a, 0, 0, 0);
#pragma unroll
                for (int j = 0; j < 4; ++j) { const int t = tr * 16 + fq * 4 + j, s = sc * 16 + fr; const float val = (s <= t) ? a[j] : 0.f;
                    *(LAS bf16_t*)(lds + L_SC + (t * SK + s) * 2) = (bf16_t)(cvtpk(val, 0.f) & 0xffff); } }
        }
        __syncthreads();
        {
            const int tr = w & 3;
#pragma unroll
            for (int i = 0; i < 4; ++i) { const int vt = vt0 + i; f32x4 a = (f32x4){0.f, 0.f, 0.f, 0.f};
#pragma unroll
                for (int ks = 0; ks < 2; ++ks) {
                    a = __builtin_amdgcn_mfma_f32_16x16x32_bf16(ldfrag(lds + L_SC, tr * 16 + fr, ks * 32 + fq * 8), ldfrag(lds + L_VT, vt * 16 + fr, ks * 32 + fq * 8), a, 0, 0, 0);
                    a = __builtin_amdgcn_mfma_f32_16x16x32_bf16(ldfrag(lds + L_QD, tr * 16 + fr, ks * 32 + fq * 8), ldfrag(lds + L_ST, vt * 16 + fr, ks * 32 + fq * 8), a, 0, 0, 0); }
#pragma unroll
                for (int j = 0; j < 4; ++j) OL[(tr * 16 + fq * 4 + j) * OS + vt * 16 + fr] = a[j]; }
            float dec[4];
#pragma unroll
            for (int j = 0; j < 4; ++j) dec[j] = __expf(BLAST[kr * 16 + fq * 4 + j]);
#pragma unroll
            for (int i = 0; i < 4; ++i) { const int vt = vt0 + i; f32x4 a = Sacc[i];
#pragma unroll
                for (int j = 0; j < 4; ++j) a[j] *= dec[j];
#pragma unroll
                for (int ks = 0; ks < 2; ++ks) a = __builtin_amdgcn_mfma_f32_16x16x32_bf16(ldfrag(lds + L_KD, kr * 16 + fr, ks * 32 + fq * 8), ldfrag(lds + L_VT, vt * 16 + fr, ks * 32 + fq * 8), a, 0, 0, 0);
                Sacc[i] = a; }
        }
        __syncthreads();
#pragma unroll
        for (int i = 0; i < 4; ++i) { u32x2 wv; wv.x = cvtpk(Sacc[i][0], Sacc[i][1]); wv.y = cvtpk(Sacc[i][2], Sacc[i][3]);
            *(LAS u32x2*)(lds + L_ST + (((vt0 + i) * 16 + fr) * SK + kr * 16 + fq * 4) * 2) = wv; }
        {
            const int t = tid >> 3, vs = (tid & 7) * 16;
            float o[16]; float s1 = 0.f, s2 = 0.f;
#pragma unroll
            for (int i = 0; i < 16; ++i) { o[i] = OL[t * OS + vs + i]; s1 += o[i]; s2 += o[i] * o[i]; }
            s1 += __shfl_xor(s1, 1); s1 += __shfl_xor(s1, 2); s1 += __shfl_xor(s1, 4);
            s2 += __shfl_xor(s2, 1); s2 += __shfl_xor(s2, 2); s2 += __shfl_xor(s2, 4);
            float mu = 0.f, rs;
            if (mixer) { mu = s1 * (1.f / 128.f); const float var = fmaxf(s2 * (1.f / 128.f) - mu * mu, 0.f); rs = rsqrtf(var + EPS); }
            else rs = rsqrtf(s2 * (1.f / 128.f) + EPS);
            if (t < c) {
                const size_t rowg = (size_t)(r0 + t);
                const unsigned gw[8] = {gate0.x, gate0.y, gate0.z, gate0.w, gate1.x, gate1.y, gate1.z, gate1.w};
                unsigned ow[8];
#pragma unroll
                for (int i = 0; i < 8; ++i) {
                    const float ga = bflo(gw[i]), gb = bfhi(gw[i]);
                    const float ya = (o[2 * i] - mu) * rs * gnv[2 * i] * (ga / (1.f + __expf(-ga)));
                    const float yb = (o[2 * i + 1] - mu) * rs * gnv[2 * i + 1] * (gb / (1.f + __expf(-gb)));
                    ow[i] = cvtpk(ya, yb); }
                bf16_t* mo = MIX + rowg * D + mixer * 512 + h * 128 + vs;
                *(u32x4*)mo = (u32x4){ow[0], ow[1], ow[2], ow[3]}; *(u32x4*)(mo + 8) = (u32x4){ow[4], ow[5], ow[6], ow[7]};
            }
        }
    }
#pragma unroll
    for (int i = 0; i < 4; ++i)
#pragma unroll
        for (int j = 0; j < 4; ++j) { const int km = kr * 16 + fq * 4 + j, ko = mixer ? ((km & 1) * 32 + (km >> 1)) : km;
            s_out[(size_t)ko * 128 + (vt0 + i) * 16 + fr] = Sacc[i][j]; }
    __syncthreads();
}

constexpr int KST = 200;
constexpr int L_AK = 0, L_AV = 64 * KST * 2;

__device__ __forceinline__ void attn_tile(const LAS unsigned char* lds, int kb, int klim, int fr, int fq, const bf16x8 (&qf)[2][6], f32x4 (&oacc)[8][2], float (&mrun)[2], float (&lrun)[2]) {
#pragma unroll 1
        for (int half = 0; half < 2; ++half) {
            const int kb2 = kb + half * 32;
            if (kb2 >= klim) break;
            const bool first0 = mrun[0] < -1e29f, first1 = mrun[1] < -1e29f;
            const float mref0 = first0 ? 0.f : mrun[0], mref1 = first1 ? 0.f : mrun[1];
            f32x4 s[2][2];
#pragma unroll
            for (int e = 0; e < 2; ++e) {
                s[e][0] = (f32x4){-mref0, -mref0, -mref0, -mref0}; s[e][1] = (f32x4){-mref1, -mref1, -mref1, -mref1};
#pragma unroll
                for (int kg = 0; kg < 2; ++kg) {
                    bf16x8 kfr[3];
#pragma unroll
                    for (int k3 = 0; k3 < 3; ++k3) kfr[k3] = *(const LAS bf16x8*)(lds + L_AK + (((half * 2 + e) * 16 + fr) * KST + (kg * 3 + k3) * 32 + fq * 8) * 2);
                    __builtin_amdgcn_sched_barrier(0);
#pragma unroll
                    for (int k3 = 0; k3 < 3; ++k3) {
                        s[e][0] = __builtin_amdgcn_mfma_f32_16x16x32_bf16(kfr[k3], qf[0][kg * 3 + k3], s[e][0], 0, 0, 0);
                        s[e][1] = __builtin_amdgcn_mfma_f32_16x16x32_bf16(kfr[k3], qf[1][kg * 3 + k3], s[e][1], 0, 0, 0); }
                    __builtin_amdgcn_sched_barrier(0);
                }
            }
            if (kb2 + 32 > klim) {
#pragma unroll
                for (int e = 0; e < 2; ++e)
#pragma unroll
                    for (int j = 0; j < 4; ++j) if (kb2 + e * 16 + fq * 4 + j >= klim) { s[e][0][j] = -1e30f; s[e][1][j] = -1e30f; }
            }
            float dl[2];
#pragma unroll
            for (int qt = 0; qt < 2; ++qt) {
                float mx = fmaxf(fmaxf(fmaxf(s[0][qt][0], s[0][qt][1]), fmaxf(s[0][qt][2], s[0][qt][3])), fmaxf(fmaxf(s[1][qt][0], s[1][qt][1]), fmaxf(s[1][qt][2], s[1][qt][3])));
                mx = fmaxf(mx, __shfl_xor(mx, 16)); mx = fmaxf(mx, __shfl_xor(mx, 32));
                dl[qt] = (qt ? first1 : first0) ? mx : fmaxf(mx, 0.f);
            }
            if (__any(dl[0] != 0.f || dl[1] != 0.f)) {
#pragma unroll
                for (int qt = 0; qt < 2; ++qt) {
                    const float alpha = __builtin_amdgcn_exp2f(-dl[qt]);
                    const float al = (qt ? first1 : first0) ? 0.f : alpha;
                    mrun[qt] = (qt ? mref1 : mref0) + dl[qt];
                    lrun[qt] *= al;
#pragma unroll
                    for (int dt = 0; dt < 8; ++dt) oacc[dt][qt] *= al;
#pragma unroll
                    for (int e = 0; e < 2; ++e)
#pragma unroll
                        for (int j = 0; j < 4; ++j) s[e][qt][j] -= dl[qt];
                }
            }
            bf16x8 pf[2];
#pragma unroll
            for (int qt = 0; qt < 2; ++qt) {
                float ps = 0.f;
#pragma unroll
                for (int e = 0; e < 2; ++e)
#pragma unroll
                    for (int j = 0; j < 4; ++j) { const float ex = __builtin_amdgcn_exp2f(s[e][qt][j]); s[e][qt][j] = ex; ps += ex; }
                lrun[qt] += ps;
                u32x4 wv;
                wv.x = cvtpk(s[0][qt][0], s[0][qt][1]); wv.y = cvtpk(s[0][qt][2], s[0][qt][3]);
                wv.z = cvtpk(s[1][qt][0], s[1][qt][1]); wv.w = cvtpk(s[1][qt][2], s[1][qt][3]);
                pf[qt] = __builtin_bit_cast(bf16x8, wv);
            }
#pragma unroll
            for (int dg = 0; dg < 2; ++dg) {
                u32x2 va0[4], va1[4];
#pragma unroll
                for (int d4 = 0; d4 < 4; ++d4) { const int dt = dg * 4 + d4;
                    va0[d4] = *(const LAS u32x2*)(lds + L_AV + ((dt * 16 + fr) * SK + half * 32 + fq * 4) * 2);
                    va1[d4] = *(const LAS u32x2*)(lds + L_AV + ((dt * 16 + fr) * SK + half * 32 + 16 + fq * 4) * 2); }
                __builtin_amdgcn_sched_barrier(0);
#pragma unroll
                for (int d4 = 0; d4 < 4; ++d4) { const int dt = dg * 4 + d4;
                    const bf16x8 vf = __builtin_bit_cast(bf16x8, (u32x4){va0[d4].x, va0[d4].y, va1[d4].x, va1[d4].y});
                    oacc[dt][0] = __builtin_amdgcn_mfma_f32_16x16x32_bf16(vf, pf[0], oacc[dt][0], 0, 0, 0);
                    oacc[dt][1] = __builtin_amdgcn_mfma_f32_16x16x32_bf16(vf, pf[1], oacc[dt][1], 0, 0, 0); }
                __builtin_amdgcn_sched_barrier(0);
            }
        }
}

__device__ __forceinline__ void attn_unit(const Params& p, LAS unsigned char* lds, int qrow0, int nqv, int kv0, int nkeys_unit, int h, bool causal) {
    int tid_ = threadIdx.x; asm volatile("" : "+v"(tid_));
    const int tid = tid_, lane = tid & 63, w = tid >> 6, fr = lane & 15, fq = lane >> 4;
    const bf16_t* Q = (const bf16_t*)(p.ws + WS_Q); const bf16_t* KN = (const bf16_t*)(p.ws + WS_KN);
    const bf16_t* KRA = (const bf16_t*)(p.ws + WS_KRALL); const bf16_t* VT = (const bf16_t*)(p.ws + WS_VT);
    bf16_t* AO = (bf16_t*)(p.ws + WS_AO);
    const int klim = causal ? 64 * ((w >> 1) + 1) + (nkeys_unit - 256) : nkeys_unit;
    const bool active = (w * 32) < nqv;
    bf16x8 qf[2][6];
#pragma unroll
    for (int qt = 0; qt < 2; ++qt) { int qi = w * 32 + qt * 16 + fr; if (qi >= nqv) qi = 0;
#pragma unroll
        for (int ks = 0; ks < 6; ++ks) qf[qt][ks] = *(const bf16x8*)(Q + (size_t)(qrow0 + qi) * 1536 + h * 192 + ks * 32 + fq * 8); }
    f32x4 oacc[8][2];
#pragma unroll
    for (int dt = 0; dt < 8; ++dt) { oacc[dt][0] = (f32x4){0.f, 0.f, 0.f, 0.f}; oacc[dt][1] = (f32x4){0.f, 0.f, 0.f, 0.f}; }
    float mrun[2] = {-1e30f, -1e30f}, lrun[2] = {0.f, 0.f};
    const int ntile = (nkeys_unit + 63) >> 6;
    u32x4 kregA[3], vregA[2];
#define ATT_LOAD(KR_, VR_, tt) do { const int kb_ = (tt) * 64; \
        _Pragma("unroll") for (int i = 0; i < 3; ++i) { const int ch = tid + i * 512, r = ch / 24, cc = ch % 24; const size_t tok = (size_t)(kv0 + kb_ + r); \
            KR_[i] = (cc < 16) ? *(const u32x4*)(KN + tok * 1024 + h * 128 + cc * 8) : *(const u32x4*)(KRA + tok * 64 + (cc - 16) * 8); } \
        _Pragma("unroll") for (int i = 0; i < 2; ++i) { const int ch = tid + i * 512, r = ch >> 3, cc = ch & 7; \
            VR_[i] = *(const u32x4*)(VT + (size_t)(h * 128 + r) * NKV + kv0 + kb_ + cc * 8); } } while (0)
#define ATT_STORE(KR_, VR_) do { \
        _Pragma("unroll") for (int i = 0; i < 3; ++i) { const int ch = tid + i * 512, r = ch / 24, cc = ch % 24; *(LAS u32x4*)(lds + L_AK + (r * KST + cc * 8) * 2) = KR_[i]; } \
        _Pragma("unroll") for (int i = 0; i < 2; ++i) { const int ch = tid + i * 512, r = ch >> 3, cc = ch & 7; *(LAS u32x4*)(lds + L_AV + (r * SK + cc * 8) * 2) = VR_[i]; } } while (0)
#define ATT_BAR() asm volatile("s_waitcnt lgkmcnt(0)\n\ts_barrier" ::: "memory")
    u32x4 kregB[3], vregB[2];
    ATT_LOAD(kregA, vregA, 0);
    if (ntile > 1) ATT_LOAD(kregB, vregB, 1);
    for (int t = 0; t < ntile; t += 2) {
        ATT_BAR();
        ATT_STORE(kregA, vregA);
        ATT_BAR();
        if (t + 2 < ntile) ATT_LOAD(kregA, vregA, t + 2);
        if (active && t * 64 < klim) attn_tile(lds, t * 64, klim, fr, fq, qf, oacc, mrun, lrun);
        if (t + 1 < ntile) {
            ATT_BAR();
            ATT_STORE(kregB, vregB);
            ATT_BAR();
            if (t + 3 < ntile) ATT_LOAD(kregB, vregB, t + 3);
            if (active && (t + 1) * 64 < klim) attn_tile(lds, (t + 1) * 64, klim, fr, fq, qf, oacc, mrun, lrun);
        }
    }
    if (active) {
#pragma unroll
        for (int qt = 0; qt < 2; ++qt) {
            float l = lrun[qt]; l += __shfl_xor(l, 16); l += __shfl_xor(l, 32);
            const float inv = 1.f / l; const int qi = w * 32 + qt * 16 + fr;
            if (qi < nqv) {
#pragma unroll
                for (int dt = 0; dt < 8; ++dt) { u32x2 wv; wv.x = cvtpk(oacc[dt][qt][0] * inv, oacc[dt][qt][1] * inv); wv.y = cvtpk(oacc[dt][qt][2] * inv, oacc[dt][qt][3] * inv);
                    *(u32x2*)(AO + (size_t)(qrow0 + qi) * D + h * 128 + dt * 16 + fq * 4) = wv; }
            }
        }
    }
    __syncthreads();
}

constexpr int LKS = 584;
constexpr int LVS = 40;
constexpr int LKT = 5 * 512 * 16;
constexpr int L_LK = 0, L_LV = 3 * LKT;
constexpr int KSPLIT = KVS / 4;
__device__ __forceinline__ void attn_latent_unit(const Params& p, LAS unsigned char* lds, int b, int dh, int ks) {
    int tid_ = threadIdx.x; asm volatile("" : "+v"(tid_));
    const int tid = tid_, lane = tid & 63, fr = lane & 15, fq = lane >> 4;
    const int w = __builtin_amdgcn_readfirstlane(tid >> 6);
    const bf16_t* CK = (const bf16_t*)(p.ws + WS_CKVALL); const bf16_t* KRA = (const bf16_t*)(p.ws + WS_KRALL);
    const bf16_t* QL = (const bf16_t*)(p.ws + WS_QL); const bf16_t* Q = (const bf16_t*)(p.ws + WS_Q);
    float* PO = (float*)(p.ws + WS_PO); float* PM = (float*)(p.ws + WS_PM); float* PL = (float*)(p.ws + WS_PL);
    const int kv0 = MP + b * KVS + ks * KSPLIT;
    bf16x8 qf[18];
#pragma unroll
    for (int kq = 0; kq < 16; ++kq) qf[kq] = *(const bf16x8*)(QL + (size_t)(b * 16 + fr) * 4096 + w * 512 + kq * 32 + fq * 8);
#pragma unroll
    for (int kq = 16; kq < 18; ++kq) qf[kq] = *(const bf16x8*)(Q + (size_t)(MP + b * 16 + fr) * 1536 + w * 192 + 128 + (kq - 16) * 32 + fq * 8);
    f32x4 oacc[16];
#pragma unroll
    for (int dt = 0; dt < 16; ++dt) oacc[dt] = (f32x4){0.f, 0.f, 0.f, 0.f};
    float mrun = -1e30f, lrun = 0.f;
    constexpr int NST = (KSPLIT + 31) / 32;
#define LAT_DMA(ss, bufi) do { _Pragma("unroll") for (int i = 0; i < 5; ++i) { const int slot = i * 512 + tid; int r = slot / 73, cc = slot % 73; if (r > 31) { r = 31; cc = 0; } if (cc > 71) cc = 0; \
            const size_t tok = (size_t)(kv0 + (ss) * 32 + r); const bf16_t* src = (cc < 64) ? CK + tok * 512 + cc * 8 : KRA + tok * 64 + (cc - 64) * 8; \
            __builtin_amdgcn_global_load_lds((const unsigned*)src, (LAS unsigned*)(lds + L_LK + (bufi) * LKT + (i * 512 + w * 64) * 16), 16, 0, 0); } } while (0)
    LAT_DMA(0, 0);
    LAT_DMA(1, 1);
    int bufc = 0, bufn = 2;
    for (int st = 0; st < NST; ++st) {
        if (st + 1 < NST) asm volatile("s_waitcnt vmcnt(5) lgkmcnt(0)\n\ts_barrier" ::: "memory");
        else asm volatile("s_waitcnt vmcnt(0) lgkmcnt(0)\n\ts_barrier" ::: "memory");
        if (st + 2 < NST) LAT_DMA(st + 2, bufn);
        const LAS unsigned char* kt = lds + L_LK + bufc * LKT;
#pragma unroll
        for (int ps_ = 0; ps_ < 2; ++ps_) {
            const int r = tid & 31, c32 = (tid >> 5) + ps_ * 16;
            const u32x4 v = *(const LAS u32x4*)(kt + (r * LKS + dh * 256 + c32 * 8) * 2);
            const unsigned ww[4] = {v.x, v.y, v.z, v.w};
#pragma unroll
            for (int e = 0; e < 4; ++e) { *(LAS bf16_t*)(lds + L_LV + ((c32 * 8 + 2 * e) * LVS + r) * 2) = (bf16_t)(ww[e] & 0xffffu); *(LAS bf16_t*)(lds + L_LV + ((c32 * 8 + 2 * e + 1) * LVS + r) * 2) = (bf16_t)(ww[e] >> 16); }
        }
        asm volatile("s_waitcnt lgkmcnt(0)\n\ts_barrier" ::: "memory");
        const int kb = st * 32;
        f32x4 s0 = (f32x4){0.f, 0.f, 0.f, 0.f}, s1 = (f32x4){0.f, 0.f, 0.f, 0.f};
#pragma unroll
        for (int kg = 0; kg < 9; ++kg) {
            bf16x8 k0[2], k1[2];
#pragma unroll
            for (int k3 = 0; k3 < 2; ++k3) { const int kq = kg * 2 + k3;
                k0[k3] = *(const LAS bf16x8*)(kt + (fr * LKS + kq * 32 + fq * 8) * 2);
                k1[k3] = *(const LAS bf16x8*)(kt + ((16 + fr) * LKS + kq * 32 + fq * 8) * 2); }
            __builtin_amdgcn_sched_barrier(0);
#pragma unroll
            for (int k3 = 0; k3 < 2; ++k3) { const int kq = kg * 2 + k3;
                s0 = __builtin_amdgcn_mfma_f32_16x16x32_bf16(k0[k3], qf[kq], s0, 0, 0, 0); s1 = __builtin_amdgcn_mfma_f32_16x16x32_bf16(k1[k3], qf[kq], s1, 0, 0, 0); }
            __builtin_amdgcn_sched_barrier(0);
        }
        if (kb + 32 > KSPLIT) {
#pragma unroll
            for (int j = 0; j < 4; ++j) { if (kb + fq * 4 + j >= KSPLIT) s0[j] = -1e30f; if (kb + 16 + fq * 4 + j >= KSPLIT) s1[j] = -1e30f; }
        }
        float mx = fmaxf(fmaxf(fmaxf(s0[0], s0[1]), fmaxf(s0[2], s0[3])), fmaxf(fmaxf(s1[0], s1[1]), fmaxf(s1[2], s1[3])));
        mx = fmaxf(mx, __shfl_xor(mx, 16)); mx = fmaxf(mx, __shfl_xor(mx, 32));
        const float mnew = fmaxf(mrun, mx), alpha = __builtin_amdgcn_exp2f(mrun - mnew);
        mrun = mnew;
        float ps = 0.f;
#pragma unroll
        for (int j = 0; j < 4; ++j) { s0[j] = __builtin_amdgcn_exp2f(s0[j] - mnew); s1[j] = __builtin_amdgcn_exp2f(s1[j] - mnew); ps += s0[j] + s1[j]; }
        lrun = lrun * alpha + ps;
        u32x4 wv; wv.x = cvtpk(s0[0], s0[1]); wv.y = cvtpk(s0[2], s0[3]); wv.z = cvtpk(s1[0], s1[1]); wv.w = cvtpk(s1[2], s1[3]);
        const bf16x8 pf = __builtin_bit_cast(bf16x8, wv);
#pragma unroll
        for (int dg = 0; dg < 8; ++dg) {
            u32x2 va0[2], va1[2];
#pragma unroll
            for (int d4 = 0; d4 < 2; ++d4) { const int dt = dg * 2 + d4;
                va0[d4] = *(const LAS u32x2*)(lds + L_LV + ((dt * 16 + fr) * LVS + fq * 4) * 2);
                va1[d4] = *(const LAS u32x2*)(lds + L_LV + ((dt * 16 + fr) * LVS + 16 + fq * 4) * 2); }
            __builtin_amdgcn_sched_barrier(0);
#pragma unroll
            for (int d4 = 0; d4 < 2; ++d4) { const int dt = dg * 2 + d4;
                const bf16x8 vf = __builtin_bit_cast(bf16x8, (u32x4){va0[d4].x, va0[d4].y, va1[d4].x, va1[d4].y});
                oacc[dt] = __builtin_amdgcn_mfma_f32_16x16x32_bf16(vf, pf, oacc[dt] * alpha, 0, 0, 0); }
            __builtin_amdgcn_sched_barrier(0);
        }
        bufc = bufc == 2 ? 0 : bufc + 1; bufn = bufn == 2 ? 0 : bufn + 1;
    }
#undef LAT_DMA
    { float l = lrun; l += __shfl_xor(l, 16); l += __shfl_xor(l, 32);
      const size_t prow = (size_t)((b * 4 + ks) * 8 + w) * 16 + fr;
#pragma unroll
      for (int dt = 0; dt < 16; ++dt) *(f32x4*)(PO + prow * 512 + dh * 256 + dt * 16 + fq * 4) = oacc[dt];
      if (dh == 0 && fq == 0) { PM[prow] = mrun; PL[prow] = l; } }
    asm volatile("s_waitcnt vmcnt(0) lgkmcnt(0)\n\ts_barrier" ::: "memory");
}

constexpr int OLS = 520;
__device__ __forceinline__ void attn_latent_combine(const Params& p, LAS unsigned char* lds, int b, int h) {
    int tid_ = threadIdx.x; asm volatile("" : "+v"(tid_));
    const int tid = tid_, lane = tid & 63, w = tid >> 6, fr = lane & 15, fq = lane >> 4;
    const float* PO = (const float*)(p.ws + WS_PO); const float* PM = (const float*)(p.ws + WS_PM); const float* PL = (const float*)(p.ws + WS_PL);
    const bf16_t* WUV = (const bf16_t*)(p.ws + WS_W_UV); bf16_t* AO = (bf16_t*)(p.ws + WS_AO);
    {
        const int t = tid >> 5, d0 = (tid & 31) * 16;
        float mk[4], M_ = -1e30f;
#pragma unroll
        for (int k = 0; k < 4; ++k) { mk[k] = PM[(size_t)((b * 4 + k) * 8 + h) * 16 + t]; M_ = fmaxf(M_, mk[k]); }
        float L_ = 0.f; f32x4 o[4];
#pragma unroll
        for (int i = 0; i < 4; ++i) o[i] = (f32x4){0.f, 0.f, 0.f, 0.f};
#pragma unroll
        for (int k = 0; k < 4; ++k) { const size_t prow = (size_t)((b * 4 + k) * 8 + h) * 16 + t; const float sc = __builtin_amdgcn_exp2f(mk[k] - M_); L_ += sc * PL[prow];
#pragma unroll
            for (int i = 0; i < 4; ++i) o[i] += *(const f32x4*)(PO + prow * 512 + d0 + i * 4) * sc; }
        const float inv = 1.f / L_;
        u32x4 w0, w1; w0.x = cvtpk(o[0].x * inv, o[0].y * inv); w0.y = cvtpk(o[0].z * inv, o[0].w * inv); w0.z = cvtpk(o[1].x * inv, o[1].y * inv); w0.w = cvtpk(o[1].z * inv, o[1].w * inv);
        w1.x = cvtpk(o[2].x * inv, o[2].y * inv); w1.y = cvtpk(o[2].z * inv, o[2].w * inv); w1.z = cvtpk(o[3].x * inv, o[3].y * inv); w1.w = cvtpk(o[3].z * inv, o[3].w * inv);
        *(LAS u32x4*)(lds + (t * OLS + d0) * 2) = w0; *(LAS u32x4*)(lds + (t * OLS + d0 + 8) * 2) = w1;
    }
    __syncthreads();
    {
        f32x4 acc = (f32x4){0.f, 0.f, 0.f, 0.f};
#pragma unroll 4
        for (int kq = 0; kq < 16; ++kq) {
            const bf16x8 a = *(const LAS bf16x8*)(lds + (fr * OLS + kq * 32 + fq * 8) * 2);
            const bf16x8 bb = *(const bf16x8*)(WUV + (size_t)(h * 128 + w * 16 + fr) * 512 + kq * 32 + fq * 8);
            acc = __builtin_amdgcn_mfma_f32_16x16x32_bf16(a, bb, acc, 0, 0, 0);
        }
#pragma unroll
        for (int j = 0; j < 4; ++j) AO[(size_t)(MP + b * 16 + fq * 4 + j) * D + h * 128 + w * 16 + fr] = (bf16_t)(cvtpk(acc[j], 0.f) & 0xffff);
    }
    __syncthreads();
}

__device__ __forceinline__ void unpack8(const u32x4 w, float (&f)[8]) { f[0] = bflo(w.x); f[1] = bfhi(w.x); f[2] = bflo(w.y); f[3] = bfhi(w.y); f[4] = bflo(w.z); f[5] = bfhi(w.z); f[6] = bflo(w.w); f[7] = bfhi(w.w); }
__device__ __forceinline__ void phase_ffn_fix(const Params& p, int layer) {
    const bf16_t* SA = (const bf16_t*)(p.ws + WS_SIDEA); const bf16_t* SB = (const bf16_t*)(p.ws + WS_SIDEB); const bf16_t* SU = (const bf16_t*)(p.ws + WS_SIDEU);
    bf16_t* ACT = (bf16_t*)(p.ws + WS_ACT);
    const float* wd = p.in[I_WDW] + (size_t)layer * 3 * DFF; const float* bd = p.in[I_BDW] + (size_t)layer * DFF;
    constexpr int NCC = DFF / 8;
    int tid_ = threadIdx.x; asm volatile("" : "+v"(tid_));
    for (int item = blockIdx.x * 512 + tid_; item < NBLK * NCC; item += gridDim.x * 512) {
        const int blk = item / NCC, cc = item % NCC, c0 = cc * 8;
        const bool smp = blk >= MP / 64;
        const int row0 = smp ? MP + (blk - MP / 64) * 16 : blk * 64;
        float w0[8], w1[8], w2[8], bi[8], am2[8], am1[8], a0[8], a1[8], u0[8], u1[8];
#pragma unroll
        for (int i = 0; i < 8; ++i) { w0[i] = wd[c0 + i]; w1[i] = wd[DFF + c0 + i]; w2[i] = wd[2 * DFF + c0 + i]; bi[i] = bd[c0 + i]; }
        if (smp) { const float* sc = p.in[I_SCONV] + ((size_t)(layer * 32 + (blk - MP / 64)) * 2) * DFF + c0;
#pragma unroll
            for (int i = 0; i < 8; ++i) { am2[i] = sc[i]; am1[i] = sc[DFF + i]; } }
        else if ((blk & 31) == 0) {
#pragma unroll
            for (int i = 0; i < 8; ++i) { am2[i] = 0.f; am1[i] = 0.f; } }
        else { unpack8(*(const u32x4*)(SA + ((size_t)(blk - 1) * 2) * DFF + c0), am2); unpack8(*(const u32x4*)(SA + ((size_t)(blk - 1) * 2 + 1) * DFF + c0), am1); }
        unpack8(*(const u32x4*)(SB + ((size_t)blk * 2) * DFF + c0), a0); unpack8(*(const u32x4*)(SB + ((size_t)blk * 2 + 1) * DFF + c0), a1);
        unpack8(*(const u32x4*)(SU + ((size_t)blk * 2) * DFF + c0), u0); unpack8(*(const u32x4*)(SU + ((size_t)blk * 2 + 1) * DFF + c0), u1);
        float y0[8], y1[8];
#pragma unroll
        for (int i = 0; i < 8; i += 2) {
            f32x2 c0v, c1v;
            c0v.x = bi[i] + am2[i] * w0[i] + am1[i] * w1[i] + a0[i] * w2[i]; c0v.y = bi[i + 1] + am2[i + 1] * w0[i + 1] + am1[i + 1] * w1[i + 1] + a0[i + 1] * w2[i + 1];
            c1v.x = bi[i] + am1[i] * w0[i] + a0[i] * w1[i] + a1[i] * w2[i]; c1v.y = bi[i + 1] + am1[i + 1] * w0[i + 1] + a0[i + 1] * w1[i + 1] + a1[i + 1] * w2[i + 1];
            const f32x2 g0 = gelu_pk(c0v), g1 = gelu_pk(c1v);
            y0[i] = g0.x * u0[i]; y0[i + 1] = g0.y * u0[i + 1]; y1[i] = g1.x * u1[i]; y1[i + 1] = g1.y * u1[i + 1]; }
        u32x4 o; o.x = cvtpk(y0[0], y0[1]); o.y = cvtpk(y0[2], y0[3]); o.z = cvtpk(y0[4], y0[5]); o.w = cvtpk(y0[6], y0[7]);
        *(u32x4*)(ACT + (size_t)row0 * DFF + c0) = o;
        o.x = cvtpk(y1[0], y1[1]); o.y = cvtpk(y1[2], y1[3]); o.z = cvtpk(y1[4], y1[5]); o.w = cvtpk(y1[6], y1[7]);
        *(u32x4*)(ACT + (size_t)(row0 + 1) * DFF + c0) = o;
        if (smp || (blk & 31) == 31) {
            float l0[8], l1[8];
            unpack8(*(const u32x4*)(SA + ((size_t)blk * 2) * DFF + c0), l0); unpack8(*(const u32x4*)(SA + ((size_t)blk * 2 + 1) * DFF + c0), l1);
            float* co = smp ? p.out + O_CONV_S + ((size_t)(layer * 32 + (blk - MP / 64)) * 2) * DFF + c0
                            : p.out + O_CONV_P + ((size_t)(layer * 16 + (blk >> 5)) * 2) * DFF + c0;
#pragma unroll
            for (int i = 0; i < 8; ++i) { co[i] = l0[i]; co[DFF + i] = l1[i]; }
        }
    }
}

__device__ __forceinline__ void phase_fix(const Params& p, int which, int vb, int nvb) {
    int tid_ = threadIdx.x; asm volatile("" : "+v"(tid_));
    const int tid = tid_, lane = tid & 63, wave = tid >> 6;
    const int gw = vb * 8 + wave, NGW = nvb * 8;
    bf16_t* CKVALL = (bf16_t*)(p.ws + WS_CKVALL); bf16_t* KRALL = (bf16_t*)(p.ws + WS_KRALL);
    const float* ssq = (const float*)(p.ws + WS_SSQ); float* ckv = p.out + O_CKV; const float* gkv = p.in[I_GKV];
    const f32x4 g0 = *(const f32x4*)(gkv + lane * 8), g1 = *(const f32x4*)(gkv + lane * 8 + 4);
    if (which & 1)
    for (int row = gw; row < M; row += NGW) {
        const f32x4* pp = (const f32x4*)(ssq + (size_t)row * 32 + 12);
        const float s = (sum4(pp[0]) + sum4(pp[1])) + (sum4(pp[2]) + sum4(pp[3]));
        const float rs = rsqrtf(s * (1.f / 512.f) + EPS);
        bf16_t* cb = CKVALL + (size_t)kvtok(row) * 512 + lane * 8;
        const u32x4 rw = *(const u32x4*)cb;
        f32x4 a = (f32x4){bflo(rw.x), bfhi(rw.x), bflo(rw.y), bfhi(rw.y)}, b = (f32x4){bflo(rw.z), bfhi(rw.z), bflo(rw.w), bfhi(rw.w)};
        a = a * rs * g0; b = b * rs * g1;
        float* cr = ckv + (size_t)row * 512 + lane * 8;
        __builtin_nontemporal_store(a, (f32x4*)cr); __builtin_nontemporal_store(b, (f32x4*)(cr + 4));
        u32x4 o; o.x = cvtpk(a.x, a.y); o.y = cvtpk(a.z, a.w); o.z = cvtpk(b.x, b.y); o.w = cvtpk(b.z, b.w);
        *(u32x4*)cb = o;
    }
    if (!(which & 2)) return;
    const float* cc = p.in[I_CCKV];
    for (int r = gw; r < 32 * PAST; r += NGW) {
        const int b = r >> 12, s = r & (PAST - 1);
        const f32x4 a = __builtin_nontemporal_load((const f32x4*)(cc + (size_t)r * 512 + lane * 8)), b4 = __builtin_nontemporal_load((const f32x4*)(cc + (size_t)r * 512 + lane * 8 + 4));
        u32x4 o; o.x = cvtpk(a.x, a.y); o.y = cvtpk(a.z, a.w); o.z = cvtpk(b4.x, b4.y); o.w = cvtpk(b4.z, b4.w);
        *(u32x4*)(CKVALL + (size_t)(MP + b * KVS + s) * 512 + lane * 8) = o;
    }
    const float* ck = p.in[I_CKR];
    for (int it = vb * 512 + tid; it < 32 * PAST * 16; it += nvb * 512) {
        const int r = it >> 4, q = it & 15, b = r >> 12, s = r & (PAST - 1);
        const float* src = ck + (size_t)r * 64;
        u32x2 o; o.x = cvtpk(src[2 * q], src[32 + 2 * q]); o.y = cvtpk(src[2 * q + 1], src[33 + 2 * q]);
        *(u32x2*)(KRALL + (size_t)(MP + b * KVS + s) * 64 + q * 4) = o;
    }
}

__device__ __forceinline__ void phase_final(const Params& p) {
    int tid_ = threadIdx.x; asm volatile("" : "+v"(tid_));
    const int tid = tid_, lane = tid & 63, wave = tid >> 6;
    const int gw = blockIdx.x * 8 + wave, NGW = gridDim.x * 8;
    float* Y = p.out + O_Y; const float* g = p.in[I_NFIN]; const bf16_t* XB = (const bf16_t*)(p.ws + WS_XB); const float* ssp = (const float*)(p.ws + WS_SSP);
    for (int row = gw; row < M; row += NGW) {
        const float rs = rstd_from16(ssp, row);
#pragma unroll
        for (int j = 0; j < 4; ++j) { const u32x2 xb = __builtin_nontemporal_load((const u32x2*)(XB + (size_t)row * D + j * 256 + lane * 4));
            const f32x4 v = (f32x4){bflo(xb.x), bfhi(xb.x), bflo(xb.y), bfhi(xb.y)};
            const f32x4 gg = *(const f32x4*)(g + j * 256 + lane * 4); __builtin_nontemporal_store(v * rs * gg, (f32x4*)(Y + (size_t)row * D + j * 256 + lane * 4)); }
    }
}

__device__ __forceinline__ void skinny_res(const Params& p, LAS unsigned char* lds, const bf16_t* A, const bf16_t* Bt, int K, int job) {
    int tid_ = threadIdx.x; asm volatile("" : "+v"(tid_));
    const int tid = tid_, lane = tid & 63, w = tid >> 6, fr = lane & 15, fq = lane >> 4, rt = w >> 2, ct = w & 3;
    bf16_t* XB = (bf16_t*)(p.ws + WS_XB); float* ssp = (float*)(p.ws + WS_SSP);
    LAS float* red = (LAS float*)lds;
    for (int u = blockIdx.x; u < 256; u += gridDim.x) {
        const int rg = u >> 4, cg = u & 15, row0 = MP + rg * 32 + rt * 16, col0 = cg * 64 + ct * 16;
        const bf16_t* ap = A + (size_t)(row0 + fr) * K + fq * 8;
        const bf16_t* bp = Bt + (size_t)(col0 + fr) * K + fq * 8;
        f32x4 acc0 = (f32x4){0.f, 0.f, 0.f, 0.f}, acc1 = (f32x4){0.f, 0.f, 0.f, 0.f};
        const int nks = K >> 5;
#pragma unroll 4
        for (int ks = 0; ks < nks; ks += 2) {
            const bf16x8 a0 = *(const bf16x8*)(ap + ks * 32), b0 = *(const bf16x8*)(bp + ks * 32);
            const bf16x8 a1 = *(const bf16x8*)(ap + ks * 32 + 32), b1 = *(const bf16x8*)(bp + ks * 32 + 32);
            acc0 = __builtin_amdgcn_mfma_f32_16x16x32_bf16(a0, b0, acc0, 0, 0, 0);
            acc1 = __builtin_amdgcn_mfma_f32_16x16x32_bf16(a1, b1, acc1, 0, 0, 0);
        }
        float ssj[4];
#pragma unroll
        for (int j = 0; j < 4; ++j) {
            const int row = row0 + fq * 4 + j, col = col0 + fr;
            const float x = bf2f(XB[(size_t)row * D + col]) + (acc0[j] + acc1[j]);
            XB[(size_t)row * D + col] = (bf16_t)(cvtpk(x, 0.f) & 0xffff);
            float ss = x * x;
            ss += __shfl_xor(ss, 1); ss += __shfl_xor(ss, 2); ss += __shfl_xor(ss, 4); ss += __shfl_xor(ss, 8);
            ssj[j] = ss;
        }
        __syncthreads();
        if (fr == 0) {
#pragma unroll
            for (int j = 0; j < 4; ++j) red[(rt * 16 + fq * 4 + j) * 4 + ct] = ssj[j];
        }
        __syncthreads();
        if (tid < 32) ssp[(size_t)(MP + rg * 32 + tid) * 16 + cg] = (red[tid * 4] + red[tid * 4 + 1]) + (red[tid * 4 + 2] + red[tid * 4 + 3]);
    }
    __syncthreads();
}

#define XB_TMO      128
#define XB_XCNT(j)  (256  + 64 * (j))
#define XB_XSUB(j)  (1280 + 64 * (j))
#define XB_XGEN(j)  (2304 + 64 * (j))
#define XB_TOP      3328
#define XB_TOPGEN   3392
#define XCD_BAR_WORDS 3456
#define XB_SPIN_CAP (1u << 18)

__device__ __forceinline__ unsigned xb_ld(unsigned* p)              { return __hip_atomic_load(p, __ATOMIC_RELAXED, __HIP_MEMORY_SCOPE_AGENT); }
__device__ __forceinline__ unsigned xb_add(unsigned* p, unsigned v) { return __hip_atomic_fetch_add(p, v, __ATOMIC_RELAXED, __HIP_MEMORY_SCOPE_AGENT); }
__device__ __forceinline__ unsigned xb_xcc_id() { return (unsigned)__builtin_amdgcn_s_getreg((3 << 11) | 20) & 0xFu; }
#define XB_SPIN(cond, bar) do { unsigned _sp = 0; while (cond) { __builtin_amdgcn_s_sleep(1); \
    if ((++_sp & 255u) == 0u) { if (xb_ld(&(bar)[XB_TMO])) break; if (_sp > XB_SPIN_CAP) { atomicAdd(&(bar)[XB_TMO], 1u); break; } } } } while (0)

struct XcdBarrier {
    unsigned* bar; unsigned x;
    volatile LAS unsigned* st;
};

__device__ __forceinline__ XcdBarrier xcd_barrier_post(unsigned* bar, volatile LAS unsigned* st) {
    XcdBarrier b; b.bar = bar; b.x = xb_xcc_id(); b.st = st;
    if (threadIdx.x == 0) (void)xb_add(&bar[XB_XCNT(b.x)], 1u);
    return b;
}
__device__ __forceinline__ void xcd_barrier_complete(unsigned* bar, unsigned x, unsigned& nloc, unsigned& nx) {
    const unsigned G = gridDim.x * gridDim.y * gridDim.z;
    unsigned sum, cnt, mine, sp = 0u;
    for (;;) {
        sum = 0u; cnt = 0u; mine = 0u;
#pragma unroll
        for (unsigned j = 0; j < 16; ++j) { const unsigned c = xb_ld(&bar[XB_XCNT(j)]); sum += c; cnt += (c > 0u) ? 1u : 0u; mine = (j == x) ? c : mine; }
        if (sum == G) break;
        __builtin_amdgcn_s_sleep(1);
        if ((++sp & 255u) == 0u) { if (xb_ld(&bar[XB_TMO])) break; if (sp > XB_SPIN_CAP) { atomicAdd(&bar[XB_TMO], 1u); break; } }
    }
    nloc = mine > 0u ? mine : 1u; nx = cnt > 0u ? cnt : 1u;
}

__device__ __forceinline__ void xcd_barrier(const XcdBarrier& b) {
    asm volatile("s_waitcnt vmcnt(0)" ::: "memory");
    __syncthreads();
    if (threadIdx.x == 0) {
        unsigned* bar = b.bar;
        __builtin_amdgcn_s_waitcnt(0);
        unsigned nloc = b.st[0], nx = b.st[1];
        if (nloc == 0u) { xcd_barrier_complete(bar, b.x, nloc, nx); b.st[0] = nloc; b.st[1] = nx; }
        const unsigned old = xb_add(&bar[XB_XSUB(b.x)], 1u);
        const unsigned gen = old / nloc;
        if (old + 1u == (gen + 1u) * nloc) {
            __builtin_amdgcn_fence(__ATOMIC_RELEASE, "agent");
            asm volatile("s_waitcnt vmcnt(0)" ::: "memory");
            const unsigned og = xb_add(&bar[XB_TOP], 1u);
            const unsigned tg = og / nx;
            if (og + 1u == (tg + 1u) * nx) xb_add(&bar[XB_TOPGEN], 1u);
            else XB_SPIN(xb_ld(&bar[XB_TOPGEN]) == tg, bar);
            __builtin_amdgcn_fence(__ATOMIC_ACQUIRE, "agent");
            xb_add(&bar[XB_XGEN(b.x)], 1u);
            asm volatile("s_waitcnt vmcnt(0)" ::: "memory");
        } else {
            XB_SPIN(xb_ld(&bar[XB_XGEN(b.x)]) == gen, bar);
            __builtin_amdgcn_fence(__ATOMIC_ACQUIRE, "agent");
            asm volatile("s_waitcnt vmcnt(0)" ::: "memory");
        }
    }
    __syncthreads();
}


#ifdef DBG_ZERO
constexpr int NPHASE = 17;
#else
constexpr int NPHASE = 16;
#endif
__global__ void __launch_bounds__(512, 2) mega_fwd(Params pk) {
    extern __shared__ __attribute__((aligned(16))) unsigned char smem[];
    LAS unsigned char* lds = (LAS unsigned char*)smem;
    const int G = gridDim.x, bx = blockIdx.x;
#ifndef PHMASK
#define PHMASK 0x1FFFF
#endif
#define PH(k) ((((PHMASK) >> (k)) & 1) && ph == (k))
#ifndef REPMASK
#define REPMASK 0
#endif
    volatile LAS unsigned* bst = (volatile LAS unsigned*)(lds + LDS_BYTES - 64);
    if (threadIdx.x < 2) bst[threadIdx.x] = 0u;
    __syncthreads();
    XcdBarrier xbar; xbar.bar = (unsigned*)pk.ws; xbar.x = 0; xbar.st = bst;
    if (pk.ph_hi - pk.ph_lo > 1) xbar = xcd_barrier_post((unsigned*)pk.ws, bst);
    bool first = true; int nseam = 0;
#pragma unroll 1
    for (int slot = 2 * pk.ph_lo; slot < 2 * pk.ph_hi; ++slot) {
        const int ph = slot >> 1;
        if ((slot & 1) && !((REPMASK >> ph) & 1)) continue;
        if (!first) { if (pk.ph_lo < 0) cg::this_grid().sync(); else xcd_barrier(xbar); ++nseam; }
        first = false;
        const __attribute__((address_space(4))) char* ka = (const __attribute__((address_space(4))) char*)__builtin_amdgcn_kernarg_segment_ptr();
        asm volatile("" : "+s"(ka));
        const Params& p = *(const Params*)(const char*)ka;
        unsigned char* ws = p.ws;
        bf16_t* XB = (bf16_t*)(ws + WS_XB);
        if (PH(0)) { phase_prologue(p, lds, G == 256 ? 1 : 7, bx, G); if (G != 256) fold_wql(p, bx, G); }
        else if (PH(1) || PH(8) || PH(9)) {
            const bool ql8 = (G == 256);
            int nsub = (ph == 9) ? (ql8 ? 3 : 4) : 1;
            if (ph == 8) nsub = (ql8 && bx < 44) ? 1 : 0;
#pragma unroll 1
            for (int sub = 0; sub < nsub; ++sub) {
                pg8::Gemm g; EpiBf E; E.pp = &p;
                if (ph == 1) { g = pg8::Gemm{XB, (const bf16_t*)(ws + WS_W_INAB), M, NAB, 1024}; E.job = 1; }
                else if ((ph == 8 && bx < 32) || sub == 3) { g = pg8::Gemm{(const bf16_t*)(ws + WS_CQ) + (size_t)MP * 384, (const bf16_t*)(ws + WS_W_QL), MS, 4096, 384}; E.job = 93; }
                else if (ph == 8) { g = pg8::Gemm{(const bf16_t*)(ws + WS_CQ) + (size_t)MP * 384, (const bf16_t*)(ws + WS_W_UQ), MS, 1536, 384}; E.job = 94; }
                else if (sub == 0) { g = pg8::Gemm{(const bf16_t*)(ws + WS_CQ), (const bf16_t*)(ws + WS_W_UQ), ql8 ? MP : M, 1536, 384}; E.job = 90; }
                else if (sub == 1) { g = pg8::Gemm{(const bf16_t*)(ws + WS_CKVALL), (const bf16_t*)(ws + WS_W_UK), MP, 1024, 512}; E.job = 91; }
                else { g = pg8::Gemm{(const bf16_t*)(ws + WS_W_UV), (const bf16_t*)(ws + WS_CKVALL), 1024, MP, 512}; E.job = 92; }
                pg8::StaticOrder S; S.init(g.M, g.N, ph == 8 ? (bx < 32 ? 32 : 12) : G, ph == 8 && bx >= 32 ? bx - 32 : bx);
                pg8::gemm_phase(lds, g, S, E);
            }
            if (ph == 8) { if (!ql8) phase_fix(p, 3, bx, G); else if (bx >= 44) phase_fix(p, 1, bx - 44, G - 44); }
        }
        else if (PH(4) || PH(12)) {
            const int layer = ph == 12;
            { int t_ = threadIdx.x; asm volatile("" : "+v"(t_)); const float* ssp = (const float*)(ws + WS_SSP); float* rsp = (float*)(ws + WS_RS);
              for (int row = bx * 512 + t_; row < M; row += G * 512) rsp[row] = rstd_from16(ssp, row); }
            xcd_barrier(xbar);
            pg8::Gemm g{XB, (const bf16_t*)(ws + WS_W_FFNIN) + (size_t)layer * 5632 * 1024, M, 5632, 1024};
            EpiFfn E{&p, layer};
#ifndef WGM_FFNUP
#define WGM_FFNUP 4
#endif
            pg8::StaticOrder S; S.init(g.M, g.N, G, bx, WGM_FFNUP);
            pg8::gemm_phase(lds, g, S, E);
            if (ph == 4 && G == 256 && bx >= 44) phase_prologue(p, lds, 4, bx - 44, G - 44);
        }
        else if (PH(2)) {
#pragma unroll 1
            for (int u = bx; u < 384; u += G) dla_unit(p, lds, u);
            if (G == 256 && bx >= 128) { __syncthreads(); phase_prologue(p, lds, 2, bx - 128, G - 128); fold_wql(p, bx - 128, G - 128); }
        }
        else if (PH(3) || PH(6) || PH(11) || PH(14)) {
            if (ph == 11) {
#pragma unroll 1
                for (int u = bx; u < 256; u += G) attn_latent_combine(p, lds, u >> 3, u & 7);
                xcd_barrier(xbar);
            }
            pg8::Gemm g; EpiRes E; E.pp = &p; E.job = ph;
            if (ph == 3) { g = pg8::Gemm{(const bf16_t*)(ws + WS_MIX), (const bf16_t*)(ws + WS_W_OUTAB), MP, 1024, 1024}; }
            else if (ph == 11) { g = pg8::Gemm{(const bf16_t*)(ws + WS_AO), (const bf16_t*)(ws + WS_W_OUTC), MP, 1024, 1024}; }
            else { const int layer = ph == 14; g = pg8::Gemm{(const bf16_t*)(ws + WS_ACT), (const bf16_t*)(ws + WS_W_FFNOUT) + (size_t)layer * 1024 * 2816, MP, 1024, 2816}; }
            pg8::StaticOrder S; S.init(g.M, g.N, G, bx);
            pg8::gemm_phase(lds, g, S, E);
            skinny_res(p, lds, g.A, g.Bt, g.K, ph);
        }
        else if (PH(5) || PH(13)) { phase_ffn_fix(p, ph == 13); }
        else if (PH(7)) {
            pg8::Gemm g{XB, (const bf16_t*)(ws + WS_W_INC), M, 1024, 1024}; pg8::StaticOrder S; S.init(M, 1024, G, bx);
            EpiInC E{&p};
            pg8::gemm_phase(lds, g, S, E);
            if (G == 256 && bx >= 8) phase_fix(p, 2, bx - 8, G - 8);
        }
        else if (PH(10)) {
#pragma unroll 1
            for (int u = bx; u < 1280; u += G) {
                const int c = u & 255, i = u >> 8;
                if (i < 4) { const int bh = c >> 1, par = c & 1; const int qb = par ? (i == 0 ? 1 : i == 1 ? 2 : i == 2 ? 5 : 6) : (i == 0 ? 0 : i == 1 ? 3 : i == 2 ? 4 : 7);
                    const int b = bh >> 3, h = bh & 7;
                    attn_unit(p, lds, b * SEQ + qb * 256, 256, b * SEQ, (qb + 1) * 256, h, true); }
                else attn_latent_unit(p, lds, c >> 3, (c >> 2) & 1, c & 3);
            }
        }
        else if (PH(15)) { phase_final(p); }
#ifdef DBG_ZERO
        else if (ph == 16) {
            int tz_ = threadIdx.x; asm volatile("" : "+v"(tz_));
#define DZ(o, lo, hi) if ((DBG_ZERO >> (o)) & 1) { for (size_t i = (size_t)(lo) + (size_t)bx * 512 + tz_; i < (size_t)(hi); i += (size_t)G * 512) p.out[i] = 0.f; }
        DZ(0, 0, (size_t)MP * D) DZ(1, (size_t)MP * D, O_GLA_P) DZ(2, O_GLA_P, O_GLA_S) DZ(3, O_GLA_S, O_RET_P) DZ(4, O_RET_P, O_RET_S) DZ(5, O_RET_S, O_CKV)
        DZ(6, O_CKV, O_CKV + (size_t)MP * 512) DZ(7, O_CKV + (size_t)MP * 512, O_KR) DZ(8, O_KR, O_KR + (size_t)MP * 64) DZ(9, O_KR + (size_t)MP * 64, O_CONV_P)
        DZ(10, O_CONV_P, O_CONV_S) DZ(11, O_CONV_S, O_CONV_S + 2 * 32 * 2 * DFF)
        }
#endif
    }
}

extern "C" void kernel_launch(void* const* d_in, const int* in_sizes, int n_in, void* d_out, int out_size, void* d_ws, size_t ws_size, hipStream_t stream) {
    static int grid = 0;
    if (grid == 0) {
        int dev = 0, cus = 0, per_cu = 0;
        (void)hipGetDevice(&dev);
        (void)hipDeviceGetAttribute(&cus, hipDeviceAttributeMultiprocessorCount, dev);
        (void)hipFuncSetAttribute((const void*)mega_fwd, hipFuncAttributeMaxDynamicSharedMemorySize, LDS_BYTES);
        (void)hipOccupancyMaxActiveBlocksPerMultiprocessor(&per_cu, (const void*)mega_fwd, 512, LDS_BYTES);
        if (per_cu < 1) per_cu = 1;
        grid = cus * per_cu;
        (void)hipGetLastError();
        if (n_in != 27 || ws_size < WS_END) { fprintf(stderr, "kernel_launch: unexpected n_in %d / ws_size %zu\n", n_in, ws_size); }
    }
    Params p{};
    for (int i = 0; i < 27; ++i) p.in[i] = (const float*)d_in[i];
    p.out = (float*)d_out; p.ws = (unsigned char*)d_ws;
#if ONE_LAUNCH
    (void)hipMemsetAsync(d_ws, 0, 16384, stream);
    p.ph_lo = 0; p.ph_hi = NPHASE;
    void* args[] = {&p};
    hipError_t e = hipLaunchCooperativeKernel((const void*)mega_fwd, dim3(grid), dim3(512), args, LDS_BYTES, stream);
    if (e != hipSuccess) fprintf(stderr, "cooperative launch failed: %s (grid %d)\n", hipGetErrorString(e), grid);
#else
    for (int ph = 0; ph < NPHASE; ++ph) {
        p.ph_lo = ph; p.ph_hi = ph + 1;
        hipLaunchKernelGGL(mega_fwd, dim3(grid), dim3(512), LDS_BYTES, stream, p);
    }
#endif
}
```

```cpp
#include <hip/hip_runtime.h>
#include <hip/hip_cooperative_groups.h>
#include <cstdio>
#include <cstdint>
namespace cg = cooperative_groups;

#ifndef ONE_LAUNCH
#define ONE_LAUNCH 1


#endif

#define LAS __attribute__((address_space(3)))
typedef unsigned short bf16_t;
typedef short bf16x8 __attribute__((ext_vector_type(8)));
typedef float f32x4 __attribute__((ext_vector_type(4)));
typedef float f32x2 __attribute__((ext_vector_type(2)));
typedef unsigned u32x4 __attribute__((ext_vector_type(4)));
typedef unsigned u32x2 __attribute__((ext_vector_type(2)));
typedef __bf16 bf16x2_t __attribute__((ext_vector_type(2)));

__device__ __forceinline__ unsigned cvtpk(float lo, float hi) { f32x2 v = {lo, hi}; bf16x2_t b = __builtin_convertvector(v, bf16x2_t); return __builtin_bit_cast(unsigned, b); }
__device__ __forceinline__ float bf2f(unsigned short h) { return __uint_as_float(((unsigned)h) << 16); }
__device__ __forceinline__ float bflo(unsigned w) { return __uint_as_float(w << 16); }
__device__ __forceinline__ float bfhi(unsigned w) { return __uint_as_float(w & 0xffff0000u); }

constexpr int D = 1024, MP = 32768, MS = 512, M = MP + MS, SEQ = 2048, DSEQ = 16, PAST = 4096;
constexpr int KVS = PAST + DSEQ;
constexpr int NKV = MP + 32 * KVS;
constexpr int NAB = 3328;
constexpr int DFF = 2816;
constexpr float EPS = 1e-6f;
constexpr int NPOS = SEQ + DSEQ;

constexpr size_t O_Y = 0;
constexpr size_t O_GLA_P = (size_t)M * D;
constexpr size_t O_GLA_S = O_GLA_P + 16 * 4 * 64 * 128;
constexpr size_t O_RET_P = O_GLA_S + 32 * 4 * 64 * 128;
constexpr size_t O_RET_S = O_RET_P + 16 * 4 * 64 * 128;
constexpr size_t O_CKV = O_RET_S + 32 * 4 * 64 * 128;
constexpr size_t O_KR = O_CKV + (size_t)M * 512;
constexpr size_t O_CONV_P = O_KR + (size_t)M * 64;
constexpr size_t O_CONV_S = O_CONV_P + 2 * 16 * 2 * DFF;

constexpr size_t MiB = 1u << 20;
constexpr size_t WS_W_INAB = 1 * MiB;
constexpr size_t WS_W_OUTAB = 8 * MiB;
constexpr size_t WS_W_FFNIN = 10 * MiB;
constexpr size_t WS_W_FFNOUT = 32 * MiB;
constexpr size_t WS_W_INC = 43 * MiB;
constexpr size_t WS_W_UQ = 45 * MiB;
constexpr size_t WS_W_UK = 47 * MiB;
constexpr size_t WS_W_UV = 48 * MiB;
constexpr size_t WS_W_OUTC = 49 * MiB;
constexpr size_t WS_ROT = 51 * MiB;
constexpr size_t WS_SSP = 52 * MiB;
constexpr size_t WS_SSQ = 55 * MiB;
constexpr size_t WS_RS = 60 * MiB;
constexpr size_t WS_W_QL = 61 * MiB;
constexpr size_t WS_R = 64 * MiB;
constexpr size_t WS_P = WS_R;
constexpr size_t WS_MIX = WS_R + 212 * MiB;
constexpr int NBLK = MP / 64 + 32;
constexpr size_t WS_SIDEA = WS_R;
constexpr size_t WS_SIDEB = WS_R + 8 * MiB;
constexpr size_t WS_SIDEU = WS_R + 16 * MiB;
constexpr size_t WS_ACT = WS_R + 358 * MiB;
constexpr size_t WS_XB = WS_R + 540 * MiB;
constexpr size_t WS_CKVALL = WS_R;
constexpr size_t WS_AO = WS_R + 430 * MiB;
constexpr size_t WS_CQ = WS_R + 161 * MiB;
constexpr size_t WS_KRALL = WS_R + 186 * MiB;
constexpr size_t WS_Q = WS_R + 207 * MiB;
constexpr size_t WS_KN = WS_R + 305 * MiB;
constexpr size_t WS_VT = WS_R + 626 * MiB;
constexpr size_t WS_QL = WS_R + 370 * MiB;
constexpr size_t WS_PO = WS_R + 380 * MiB;
constexpr size_t WS_PM = WS_R + 420 * MiB;
constexpr size_t WS_PL = WS_R + 421 * MiB;
constexpr size_t WS_END = WS_R + 948 * MiB;
static_assert(WS_END <= 1024 * MiB, "ws map");

constexpr int LDS_BYTES = 147456;

__device__ __forceinline__ int kvtok(int row) { return row < MP ? row : MP + ((row - MP) >> 4) * KVS + PAST + ((row - MP) & 15); }
__device__ __forceinline__ int posidx(int row) { return row < MP ? (row & (SEQ - 1)) : SEQ + ((row - MP) & 15); }

namespace pg8 {
constexpr int BM = 256, BK = 64, HALF = 128, HTB = HALF * BK * 2, STAGE_BYTES = 8 * HTB, NXCD = 8, WGM = 4;
__host__ __device__ __forceinline__ int lds_byte(int r, int c) { const int st = (r >> 4) * 2 + (c >> 5), rr = r & 15, cc = c & 31, ob = rr * 64 + cc * 2; return st * 1024 + (ob ^ (((ob >> 9) & 1) << 5)); }
__host__ __device__ __forceinline__ void stage_rc(int b, int& R, int& C) { const int st = b / 1024, sb = b % 1024, swz = sb ^ (((sb >> 9) & 1) << 5); R = (st >> 1) * 16 + swz / 64; C = (st & 1) * 32 + (swz % 64) / 2; }
__host__ __device__ __forceinline__ int perm32(int rho) { const int n = rho >> 4, i = rho & 15; return 8 * (i >> 2) + 4 * n + (i & 3); }
struct Unit { int pm, pn; };
struct Gemm { const bf16_t* A; const bf16_t* Bt; int M, N, K; };
struct StaticOrder {
    int nM, nN, nwg, G, c, wgm;
    __host__ __device__ void init(int M_, int N_, int G_, int c_, int wgm_ = WGM) { nM = M_ / BM; nN = N_ / BM; nwg = nM * nN; G = G_; c = c_; wgm = wgm_; }
    __host__ __device__ bool next(int i, Unit& u) const {
        const long L = (long)i * G + c; if (L >= nwg) return false;
        int wgid = (int)L; { const int q = nwg / NXCD, r = nwg % NXCD, xcd = wgid % NXCD, off = wgid / NXCD; wgid = (xcd < r ? xcd * (q + 1) : r * (q + 1) + (xcd - r) * q) + off; }
        const int nig = wgm * nN, gid = wgid / nig, fm = gid * wgm, gsz = (nM - fm) < wgm ? (nM - fm) : wgm;
        u.pm = fm + ((wgid % nig) % gsz); u.pn = (wgid % nig) / gsz; return true;
    }
};
template <class Epi>
__device__ __forceinline__ void gemm_phase(LAS unsigned char* lds, const Gemm g, const StaticOrder& S, const Epi& E) {
    int tid_ = threadIdx.x; asm volatile("" : "+v"(tid_));
    const int tid = tid_, wid = __builtin_amdgcn_readfirstlane(tid >> 6), lane = tid & 63, wr = wid >> 2, wc = wid & 3, fr = lane & 15, fq = lane >> 4;
    const int K = g.K, nt = K / BK;
    unsigned voffA[2], voffB[2];
#pragma unroll
    for (int i = 0; i < 2; ++i) { int R, C; stage_rc(tid * 16 + i * 8192, R, C); const int Rb = Epi::PERM ? ((R & ~31) + perm32(R & 31)) : R;
        voffA[i] = (unsigned)(R * K + C) * 2u; voffB[i] = (unsigned)(Rb * K + C) * 2u; }
    const size_t kstep = (size_t)(BK * 2);
    const size_t hstep = (size_t)HALF * K * 2;
    const size_t tstep = 2 * hstep;
    const unsigned ldsw = (unsigned)wid * 1024u;
    const int aoff = lds_byte(wr * 64 + fr, fq * 8), boff = lds_byte(wc * 32 + fr, fq * 8);
#define PG8_SA(b, h) (((b) * 2 + (h)) * HTB)
#define PG8_SB(b, h) ((4 + (b) * 2 + (h)) * HTB)
#define PG8_STAGE(bufoff, gbase, voff) do { _Pragma("unroll") for (int _i = 0; _i < 2; ++_i) \
        __builtin_amdgcn_global_load_lds((const unsigned*)((const char*)(gbase) + (voff)[_i]), (LAS unsigned*)(lds + (bufoff) + ldsw + _i * 8192), 16, 0, 0); } while (0)
#define PG8_LDA(dst, b, h) do { _Pragma("unroll") for (int m = 0; m < 4; ++m) _Pragma("unroll") for (int k = 0; k < 2; ++k) dst[m][k] = *(const LAS bf16x8*)(lds + PG8_SA(b, h) + aoff + m * 2048 + k * 1024); } while (0)
#define PG8_LDB(dst, b, h) do { _Pragma("unroll") for (int n = 0; n < 2; ++n) _Pragma("unroll") for (int k = 0; k < 2; ++k) dst[n][k] = *(const LAS bf16x8*)(lds + PG8_SB(b, h) + boff + n * 2048 + k * 1024); } while (0)
#define PG8_MMA(ai, bj, At, Bt) do { __builtin_amdgcn_s_setprio(1); _Pragma("unroll") for (int m = 0; m < 4; ++m) _Pragma("unroll") for (int n = 0; n < 2; ++n) _Pragma("unroll") for (int k = 0; k < 2; ++k) \
        acc[ai][bj][m][n] = __builtin_amdgcn_mfma_f32_16x16x32_bf16(Bt[n][k], At[m][k], acc[ai][bj][m][n], 0, 0, 0); __builtin_amdgcn_s_setprio(0); } while (0)
#define PG8_WAIT_V(n) asm volatile("s_waitcnt vmcnt(" #n ")" ::: "memory")
#define PG8_WAIT_L(n) asm volatile("s_waitcnt lgkmcnt(" #n ")" ::: "memory")
#define PG8_BAR __builtin_amdgcn_s_barrier()
#define PG8_SCHED __builtin_amdgcn_sched_barrier(0)
    Unit cur, nxt; int ui = 0;
    if (!S.next(0, cur)) return;
    f32x4 acc[2][2][4][2];
#pragma unroll
    for (int a = 0; a < 2; ++a)
#pragma unroll
        for (int b = 0; b < 2; ++b)
#pragma unroll
            for (int m = 0; m < 4; ++m)
#pragma unroll
                for (int n = 0; n < 2; ++n) acc[a][b][m][n] = (f32x4){0.f, 0.f, 0.f, 0.f};
    bf16x8 At[4][2], B0[2][2], B1[2][2];
    const char* cA = (const char*)g.A + (size_t)cur.pm * tstep; const char* cB = (const char*)g.Bt + (size_t)cur.pn * tstep;
    PG8_STAGE(PG8_SB(0, 0), cB, voffB); PG8_STAGE(PG8_SB(0, 1), cB + hstep, voffB); PG8_STAGE(PG8_SA(0, 0), cA, voffA); PG8_STAGE(PG8_SA(0, 1), cA + hstep, voffA);
    if (wr == 1) PG8_BAR;
    PG8_WAIT_V(2); PG8_BAR;
    PG8_STAGE(PG8_SB(1, 0), cB + kstep, voffB); PG8_STAGE(PG8_SA(1, 0), cA + kstep, voffA); PG8_STAGE(PG8_SB(1, 1), cB + hstep + kstep, voffB);
    PG8_WAIT_V(6); PG8_BAR;
    for (;;) {
        const bool has_next = S.next(ui + 1, nxt);
        const char* nA = has_next ? (const char*)g.A + (size_t)nxt.pm * tstep : cA; const char* nB = has_next ? (const char*)g.Bt + (size_t)nxt.pn * tstep : cB;
        for (int t = 0; t < nt; t += 2) {
            const bool last = (t == nt - 2);
            const char* a1 = cA + (size_t)(t + 1) * kstep;
            const char* a2 = last ? nA : cA + (size_t)(t + 2) * kstep; const char* b2 = last ? nB : cB + (size_t)(t + 2) * kstep;
            const char* a3 = a2 + kstep; const char* b3 = b2 + kstep;
            PG8_LDB(B0, 0, 0); PG8_LDB(B1, 0, 1); PG8_SCHED; PG8_LDA(At, 0, 0); PG8_STAGE(PG8_SA(1, 1), a1 + hstep, voffA);
            PG8_WAIT_V(8); PG8_WAIT_L(0); PG8_BAR; PG8_MMA(0, 0, At, B0); PG8_MMA(0, 1, At, B1); PG8_BAR; PG8_SCHED;
            PG8_LDA(At, 0, 1); PG8_STAGE(PG8_SB(0, 0), b2, voffB); PG8_STAGE(PG8_SB(0, 1), b2 + hstep, voffB); PG8_STAGE(PG8_SA(0, 0), a2, voffA);
            PG8_WAIT_V(8); PG8_WAIT_L(0); PG8_BAR; PG8_MMA(1, 0, At, B0); PG8_MMA(1, 1, At, B1); PG8_BAR; PG8_SCHED;
            PG8_LDB(B0, 1, 0); PG8_LDB(B1, 1, 1); PG8_SCHED; PG8_LDA(At, 1, 0); PG8_STAGE(PG8_SA(0, 1), a2 + hstep, voffA);
            PG8_WAIT_V(8); PG8_WAIT_L(0); PG8_BAR; PG8_MMA(0, 0, At, B0); PG8_MMA(0, 1, At, B1); PG8_BAR; PG8_SCHED;
            PG8_LDA(At, 1, 1); PG8_STAGE(PG8_SB(1, 0), b3, voffB); PG8_STAGE(PG8_SB(1, 1), b3 + hstep, voffB); PG8_STAGE(PG8_SA(1, 0), a3, voffA);
            PG8_WAIT_V(8); PG8_WAIT_L(0); PG8_BAR; PG8_MMA(1, 0, At, B0); PG8_MMA(1, 1, At, B1); PG8_BAR; PG8_SCHED;
        }
        if (wr == 0) PG8_BAR;
        E(acc, cur, wr, wc, fr, fq);
        if (!has_next) break;
#pragma unroll
        for (int a = 0; a < 2; ++a)
#pragma unroll
            for (int b = 0; b < 2; ++b)
#pragma unroll
                for (int m = 0; m < 4; ++m)
#pragma unroll
                    for (int n = 0; n < 2; ++n) acc[a][b][m][n] = (f32x4){0.f, 0.f, 0.f, 0.f};
        cur = nxt; cA = nA; cB = nB; ++ui;
        if (wr == 1) PG8_BAR;
    }
    PG8_WAIT_V(0);
    PG8_BAR;
#undef PG8_SA
#undef PG8_SB
#undef PG8_STAGE
#undef PG8_LDA
#undef PG8_LDB
#undef PG8_MMA
#undef PG8_WAIT_V
#undef PG8_WAIT_L
#undef PG8_BAR
#undef PG8_SCHED
}
}

struct Params { const float* in[27]; float* out; unsigned char* ws; int ph_lo, ph_hi; };
enum { I_XP = 0, I_XS, I_SGLA, I_SRET, I_CCKV, I_CKR, I_SCONV, I_NMIX, I_NFFN, I_NFIN, I_WINAB, I_WGU, I_BG, I_GGLA, I_GRET, I_WOUTAB, I_WINC, I_GQ, I_GKV, I_WUQ, I_WUK, I_WUV, I_WOUTC, I_WFFNIN, I_WDW, I_BDW, I_WFFNOUT };

__device__ __forceinline__ float sum4(f32x4 a) { return (a.x + a.y) + (a.z + a.w); }
__device__ __forceinline__ float rstd_from16(const float* ssp, int row) {
    const f32x4* p = (const f32x4*)(ssp + (size_t)row * 16);
    const f32x4 a = p[0], b = p[1], c = p[2], d = p[3];
    const float s = (sum4(a) + sum4(b)) + (sum4(c) + sum4(d));
    return rsqrtf(s * (1.0f / 1024.0f) + EPS);
}
__device__ __forceinline__ f32x4 rope4(f32x4 v, f32x4 cs) { f32x4 r; r.x = v.x * cs.x - v.y * cs.y; r.y = v.x * cs.y + v.y * cs.x; r.z = v.z * cs.z - v.w * cs.w; r.w = v.z * cs.w + v.w * cs.z; return r; }
__device__ __forceinline__ float logsig(float x) { return fminf(x, 0.f) - log1pf(__expf(-fabsf(x))); }

struct EpiBf {
    static constexpr bool PERM = true;
    const Params* pp; int job;
    __device__ __forceinline__ void operator()(const f32x4 (&acc)[2][2][4][2], const pg8::Unit& u, int wr, int wc, int fr, int fq) const {
        const Params* q_ = pp; asm volatile("" : "+s"(q_));
        unsigned char* ws = q_->ws;
        const int MODE = job == 1 ? 2 : (job == 90 || job == 93 || job == 94) ? 3 : 0;
        bf16_t* O = (bf16_t*)(ws + (job == 1 ? WS_P : (job == 90 || job == 94) ? WS_Q : job == 91 ? WS_KN : job == 93 ? WS_QL : WS_VT)) + (job == 94 ? (size_t)MP * 1536 : 0);
        const int ldc = job == 1 ? NAB : (job == 90 || job == 94) ? 1536 : job == 91 ? 1024 : job == 93 ? 4096 : NKV;
        const int rowoff = (job == 93 || job == 94) ? MP : 0;
        const float* ssp = (const float*)(ws + ((job == 90 || job == 93 || job == 94) ? WS_SSQ : WS_SSP));
        const float* rot = (const float*)(ws + WS_ROT);
        const float* bgate = q_->in[I_BG];
        const int row0 = u.pm * 256 + wr * 64 + fr, col0 = u.pn * 256 + wc * 32 + 8 * fq;
        float rsv[2][4];
#pragma unroll
        for (int ai = 0; ai < 2; ++ai) {
#pragma unroll
            for (int m = 0; m < 4; ++m) {
                const int row = row0 + ai * 128 + m * 16;
                float r_ = 1.f;
                if (MODE == 1 || MODE == 2) r_ = rstd_from16(ssp, row);
                if (MODE == 3) { const f32x4* p = (const f32x4*)(ssp + (size_t)(row + rowoff) * 32); const float s = sum4(p[0]) + sum4(p[1]) + sum4(p[2]); r_ = rsqrtf(s * (1.0f / 384.0f) + EPS); }
                rsv[ai][m] = r_;
                if (m & 1) asm volatile("" ::: "memory");
            }
        }
#pragma unroll
        for (int ai = 0; ai < 2; ++ai)
#pragma unroll
            for (int m = 0; m < 4; ++m) {
                const int row = row0 + ai * 128 + m * 16;
                const float rs = rsv[ai][m];
#pragma unroll
                for (int bj = 0; bj < 2; ++bj) {
                    const int col = col0 + bj * 128;
                    f32x4 v0 = acc[ai][bj][m][0] * rs, v1 = acc[ai][bj][m][1] * rs;
                    bool dorope = false; int i0 = 0;
                    if (MODE == 2) { if (u.pn == 6 || u.pn == 7) { dorope = true; i0 = (col & 63) >> 1; } }
                    if (MODE == 3 && job != 93) { const int within = col % 192; if (within >= 128) { dorope = true; i0 = (within - 128) >> 1; } }
                    if (dorope) {
                        const f32x4* cs = (const f32x4*)(rot + ((size_t)posidx(row + rowoff) * 32 + i0) * 2);
                        const f32x4 c0 = cs[0], c1 = cs[1];
                        v0 = rope4(v0, c0);
                        v1 = rope4(v1, c1);
                    }
                    if (MODE == 2) { if (u.pn == 12) {
                        const f32x4 b0 = *(const f32x4*)(bgate + (col - 3072)), b1 = *(const f32x4*)(bgate + (col - 3072) + 4);
                        v0.x = logsig(v0.x + b0.x) * 0.0625f; v0.y = logsig(v0.y + b0.y) * 0.0625f; v0.z = logsig(v0.z + b0.z) * 0.0625f; v0.w = logsig(v0.w + b0.w) * 0.0625f;
                        v1.x = logsig(v1.x + b1.x) * 0.0625f; v1.y = logsig(v1.y + b1.y) * 0.0625f; v1.z = logsig(v1.z + b1.z) * 0.0625f; v1.w = logsig(v1.w + b1.w) * 0.0625f;
                    } }
                    u32x4 w; w.x = cvtpk(v0.x, v0.y); w.y = cvtpk(v0.z, v0.w); w.z = cvtpk(v1.x, v1.y); w.w = cvtpk(v1.z, v1.w);
                    *(u32x4*)(O + (size_t)row * ldc + col) = w;
                }
            }
    }
};

struct EpiRes {
    static constexpr bool PERM = false;
    const Params* pp; int job;
    __device__ __forceinline__ void operator()(const f32x4 (&acc)[2][2][4][2], const pg8::Unit& u, int wr, int wc, int fr, int fq) const {
        const Params* q_ = pp; asm volatile("" : "+s"(q_));
        bf16_t* XB = (bf16_t*)(q_->ws + WS_XB); float* ssp = (float*)(q_->ws + WS_SSP);
        const int row0 = u.pm * 256 + wr * 64 + fr, col0 = u.pn * 256 + wc * 32 + 4 * fq;
#pragma unroll
        for (int ai = 0; ai < 2; ++ai)
#pragma unroll
            for (int m = 0; m < 4; ++m) {
                const int row = row0 + ai * 128 + m * 16;
                float ss = 0.f;
#pragma unroll
                for (int bj = 0; bj < 2; ++bj)
#pragma unroll
                    for (int n = 0; n < 2; ++n) {
                        const int col = col0 + bj * 128 + n * 16;
                        const u32x2 rb = *(const u32x2*)(XB + (size_t)row * D + col);
                        const f32x4 r = (f32x4){bflo(rb.x), bfhi(rb.x), bflo(rb.y), bfhi(rb.y)};
                        const f32x4 x = r + acc[ai][bj][m][n];
                        { u32x2 w; w.x = cvtpk(x.x, x.y); w.y = cvtpk(x.z, x.w); *(u32x2*)(XB + (size_t)row * D + col) = w; }
                        ss += (x.x * x.x + x.y * x.y) + (x.z * x.z + x.w * x.w);
                    }
                ss += __shfl_xor(ss, 16); ss += __shfl_xor(ss, 32);
                if (fq == 0) ssp[(size_t)row * 16 + u.pn * 4 + wc] = ss;
                if (m & 1) asm volatile("" ::: "memory");
            }
    }
};

struct EpiInC {
    static constexpr bool PERM = false;
    const Params* pp;
    __device__ __forceinline__ void operator()(const f32x4 (&acc)[2][2][4][2], const pg8::Unit& u, int wr, int wc, int fr, int fq) const {
        const Params* q_ = pp; asm volatile("" : "+s"(q_));
        unsigned char* ws = q_->ws;
        const float* ssp = (const float*)(ws + WS_SSP); const float* rot = (const float*)(ws + WS_ROT); bf16_t* CQ = (bf16_t*)(ws + WS_CQ);
        bf16_t* CKVALL = (bf16_t*)(ws + WS_CKVALL); float* krout = q_->out + O_KR; bf16_t* KRALL = (bf16_t*)(ws + WS_KRALL); float* ssq = (float*)(ws + WS_SSQ);
        const int row0 = u.pm * 256 + wr * 64 + fr, col0 = u.pn * 256 + wc * 32 + 4 * fq;

#pragma unroll
        for (int ai = 0; ai < 2; ++ai)
#pragma unroll
            for (int m = 0; m < 4; ++m) {
                const int row = row0 + ai * 128 + m * 16;
                const float rs = rstd_from16(ssp, row);
#pragma unroll
                for (int bj = 0; bj < 2; ++bj) {
                    const int blk = u.pn * 2 + bj;
                    float ss = 0.f;
#pragma unroll
                    for (int n = 0; n < 2; ++n) {
                        const int col = col0 + bj * 128 + n * 16;
                        f32x4 v = acc[ai][bj][m][n] * rs;
                        if (blk < 3) {
                            u32x2 w; w.x = cvtpk(v.x, v.y); w.y = cvtpk(v.z, v.w);
                            *(u32x2*)(CQ + (size_t)row * 384 + col) = w;
                        } else if (blk < 7) {
                            u32x2 w; w.x = cvtpk(v.x, v.y); w.y = cvtpk(v.z, v.w);
                            *(u32x2*)(CKVALL + (size_t)kvtok(row) * 512 + (col - 384)) = w;
                        } else if (col < 960) {
                            const int j = col - 896, i0 = j >> 1;
                            const f32x4 cs = *(const f32x4*)(rot + ((size_t)posidx(row) * 32 + i0) * 2);
                            v = rope4(v, cs);
                            float* ko = krout + (size_t)row * 64;
                            ko[i0] = v.x; ko[32 + i0] = v.y; ko[i0 + 1] = v.z; ko[33 + i0] = v.w;
                            u32x2 w; w.x = cvtpk(v.x, v.y); w.y = cvtpk(v.z, v.w);
                            *(u32x2*)(KRALL + (size_t)kvtok(row) * 64 + j) = w;
                        }
                        ss += (v.x * v.x + v.y * v.y) + (v.z * v.z + v.w * v.w);
                    }
                    ss += __shfl_xor(ss, 16); ss += __shfl_xor(ss, 32);
                    if (fq == 0) ssq[(size_t)row * 32 + blk * 4 + wc] = ss;
                }
                asm volatile("" ::: "memory");
            }
    }
};

__device__ __forceinline__ f32x2 gelu_pk(f32x2 v) {
    const f32x2 av = __builtin_elementwise_abs(v), d = av * 0.2316418882f + 1.0f;
    f32x2 t; t.x = __builtin_amdgcn_rcpf(d.x); t.y = __builtin_amdgcn_rcpf(d.y);
    f32x2 q = t * 0.5307027145f + (-0.7265760135f); q = q * t + 0.7107068705f; q = q * t + (-0.142248368f); q = q * t + 0.127414796f; q = q * t;
    const f32x2 sx = (v * v) * (-0.72134752044f);
    f32x2 e; e.x = __builtin_amdgcn_exp2f(sx.x); e.y = __builtin_amdgcn_exp2f(sx.y);
    const f32x2 m = v * (q * e), r = v - m;
    f32x2 o; o.x = v.x < 0.f ? m.x : r.x; o.y = v.y < 0.f ? m.y : r.y; return o;
}
__device__ __forceinline__ void attn_sample_unit(const Params& p, LAS unsigned char* lds, int b, int h) {
    int tid_ = threadIdx.x; asm volatile("" : "+v"(tid_));
    const int tid = tid_, lane = tid & 63, w = tid >> 6, fr = lane & 15, fq = lane >> 4;
    const bf16_t* Q = (const bf16_t*)(p.ws + WS_Q); const bf16_t* KN = (const bf16_t*)(p.ws + WS_KN);
    const bf16_t* KRA = (const bf16_t*)(p.ws + WS_KRALL); const bf16_t* VT = (const bf16_t*)(p.ws + WS_VT);
    bf16_t* AO = (bf16_t*)(p.ws + WS_AO);
    const int qrow0 = MP + b * DSEQ, kv0 = MP + b * KVS;
    bf16x8 qf[6];
#pragma unroll
    for (int ks = 0; ks < 6; ++ks) qf[ks] = *(const bf16x8*)(Q + (size_t)(qrow0 + fr) * 1536 + h * 192 + ks * 32 + fq * 8);
    f32x4 oacc[8];
#pragma unroll
    for (int dt = 0; dt < 8; ++dt) oacc[dt] = (f32x4){0.f, 0.f, 0.f, 0.f};
    float mrun = -1e30f, lrun = 0.f;
    constexpr int NSTEP = (KVS + 31) / 32;
    bf16x8 kf[2][6];
#define SMP_KLOAD(ss) do { const int kb_ = (ss) * 32; \
        _Pragma("unroll") for (int e = 0; e < 2; ++e) { const size_t tok = (size_t)(kv0 + kb_ + e * 16 + fr); \
            _Pragma("unroll") for (int ks = 0; ks < 4; ++ks) kf[e][ks] = *(const bf16x8*)(KN + tok * 1024 + h * 128 + ks * 32 + fq * 8); \
            _Pragma("unroll") for (int ks = 4; ks < 6; ++ks) kf[e][ks] = *(const bf16x8*)(KRA + tok * 64 + (ks - 4) * 32 + fq * 8); } } while (0)
    if (w < NSTEP) SMP_KLOAD(w);
    for (int st = w; st < NSTEP; st += 8) {
        const int kb = st * 32;
        u32x2 va0[8], va1[8];
#pragma unroll
        for (int dt = 0; dt < 8; ++dt) { const bf16_t* vp = VT + (size_t)(h * 128 + dt * 16 + fr) * NKV + kv0 + kb + fq * 4;
            va0[dt] = *(const u32x2*)vp; va1[dt] = *(const u32x2*)(vp + 16); }
        f32x4 s0 = (f32x4){0.f, 0.f, 0.f, 0.f}, s1 = (f32x4){0.f, 0.f, 0.f, 0.f};
#pragma unroll
        for (int ks = 0; ks < 6; ++ks) { s0 = __builtin_amdgcn_mfma_f32_16x16x32_bf16(kf[0][ks], qf[ks], s0, 0, 0, 0); s1 = __builtin_amdgcn_mfma_f32_16x16x32_bf16(kf[1][ks], qf[ks], s1, 0, 0, 0); }
        if (st + 8 < NSTEP) SMP_KLOAD(st + 8);
        if (kb + 32 > KVS) {
#pragma unroll
            for (int j = 0; j < 4; ++j) { if (kb + fq * 4 + j >= KVS) s0[j] = -1e30f; if (kb + 16 + fq * 4 + j >= KVS) s1[j] = -1e30f; }
        }
        float mx = fmaxf(fmaxf(fmaxf(s0[0], s0[1]), fmaxf(s0[2], s0[3])), fmaxf(fmaxf(s1[0], s1[1]), fmaxf(s1[2], s1[3])));
        mx = fmaxf(mx, __shfl_xor(mx, 16)); mx = fmaxf(mx, __shfl_xor(mx, 32));
        const float mnew = fmaxf(mrun, mx), alpha = __builtin_amdgcn_exp2f(mrun - mnew);
        mrun = mnew;
        float ps = 0.f;
#pragma unroll
        for (int j = 0; j < 4; ++j) { s0[j] = __builtin_amdgcn_exp2f(s0[j] - mnew); s1[j] = __builtin_amdgcn_exp2f(s1[j] - mnew); ps += s0[j] + s1[j]; }
        lrun = lrun * alpha + ps;
        u32x4 wv; wv.x = cvtpk(s0[0], s0[1]); wv.y = cvtpk(s0[2], s0[3]); wv.z = cvtpk(s1[0], s1[1]); wv.w = cvtpk(s1[2], s1[3]);
        const bf16x8 pf = __builtin_bit_cast(bf16x8, wv);
#pragma unroll
        for (int dt = 0; dt < 8; ++dt) {
            const bf16x8 vf = __builtin_bit_cast(bf16x8, (u32x4){va0[dt].x, va0[dt].y, va1[dt].x, va1[dt].y});
            oacc[dt] = __builtin_amdgcn_mfma_f32_16x16x32_bf16(vf, pf, oacc[dt] * alpha, 0, 0, 0);
        }
    }
#undef SMP_KLOAD
    { float l = lrun; l += __shfl_xor(l, 16); l += __shfl_xor(l, 32);
      LAS float* OW = (LAS float*)(lds + w * 8192); LAS float* ML = (LAS float*)(lds + 65536 + w * 128);
#pragma unroll
      for (int dt = 0; dt < 8; ++dt)
#pragma unroll
          for (int j = 0; j < 4; ++j) OW[(dt * 16 + fq * 4 + j) * 16 + fr] = oacc[dt][j];
      if (fq == 0) { ML[fr] = mrun; ML[16 + fr] = l; } }
    __syncthreads();
    { const int q = tid & 15, dc = tid >> 4;
      float mw[8], M_ = -1e30f;
#pragma unroll
      for (int ww = 0; ww < 8; ++ww) { mw[ww] = ((LAS float*)(lds + 65536 + ww * 128))[q]; M_ = fmaxf(M_, mw[ww]); }
      float L_ = 0.f, o[4] = {0.f, 0.f, 0.f, 0.f};
#pragma unroll
      for (int ww = 0; ww < 8; ++ww) { const float sc = __builtin_amdgcn_exp2f(mw[ww] - M_); L_ += sc * ((LAS float*)(lds + 65536 + ww * 128))[16 + q];
          const LAS float* OW = (LAS float*)(lds + ww * 8192);
#pragma unroll
          for (int i = 0; i < 4; ++i) o[i] += sc * OW[(dc * 4 + i) * 16 + q]; }
      const float inv = 1.f / L_;
      u32x2 wv; wv.x = cvtpk(o[0] * inv, o[1] * inv); wv.y = cvtpk(o[2] * inv, o[3] * inv);
      *(u32x2*)(AO + (size_t)(qrow0 + q) * D + h * 128 + dc * 4) = wv; }
    __syncthreads();
}

struct EpiFfn {
    static constexpr bool PERM = true;
    const Params* pp; int layer;
    __device__ __forceinline__ void operator()(f32x4 (&acc)[2][2][4][2], const pg8::Unit& u, int wr_, int wc_, int fr_, int fq_) const {
        const Params* q_ = pp; asm volatile("" : "+s"(q_));
        int wr = wr_, wc = wc_, fr = fr_, fq = fq_;
        asm volatile("" : "+s"(wr), "+s"(wc), "+v"(fr), "+v"(fq));
        unsigned char* ws = q_->ws;
        const float* rsp = (const float*)(ws + WS_RS);
        const int row0 = u.pm * 256 + wr * 64 + fr;
#pragma unroll
        for (int ai = 0; ai < 2; ++ai)
#pragma unroll
            for (int m = 0; m < 4; ++m) {
                const float rs = rsp[row0 + ai * 128 + m * 16];
#pragma unroll
                for (int bj = 0; bj < 2; ++bj)
#pragma unroll
                    for (int n = 0; n < 2; ++n) acc[ai][bj][m][n] *= rs;
                if (m & 1) asm volatile("" ::: "memory");
            }
        bf16_t* ACT = (bf16_t*)(ws + WS_ACT); bf16_t* SA = (bf16_t*)(ws + WS_SIDEA); bf16_t* SB = (bf16_t*)(ws + WS_SIDEB); bf16_t* SU = (bf16_t*)(ws + WS_SIDEU);
        const float* wd = q_->in[I_WDW] + (size_t)layer * 3 * DFF; const float* bd = q_->in[I_BDW] + (size_t)layer * DFF;
        const int lane = fq * 16 + fr, src1 = (lane & 48) | ((fr + 15) & 15), src2 = (lane & 48) | ((fr + 14) & 15);
        const bool smp = u.pm * 256 >= MP;
#pragma unroll
        for (int n = 0; n < 2; ++n) {
            asm volatile("" ::: "memory");
            int col = u.pn * 128 + wc * 32 + 8 * fq + 4 * n;
            asm volatile("" : "+v"(col));
            const f32x4 w0 = *(const f32x4*)(wd + col), w1 = *(const f32x4*)(wd + DFF + col), w2 = *(const f32x4*)(wd + 2 * DFF + col), bi = *(const f32x4*)(bd + col);
#pragma unroll
            for (int ai = 0; ai < 2; ++ai) {
                f32x4 pr1 = (f32x4){0.f, 0.f, 0.f, 0.f}, pr2 = pr1;
#pragma unroll
                for (int m = 0; m < 4; ++m) {
                    int row = row0 + ai * 128 + m * 16;
                    asm volatile("" : "+v"(row));
                    const f32x4 a = acc[ai][0][m][n], uu = acc[ai][1][m][n];
                    f32x4 r1, r2;
#pragma unroll
                    for (int e = 0; e < 4; ++e) { r1[e] = __shfl(a[e], src1); r2[e] = __shfl(a[e], src2); }
                    const f32x4 p1 = fr >= 1 ? r1 : pr1, p2 = fr >= 2 ? r2 : pr2;
                    const bool deferred = smp ? (fr < 2) : (m == 0 && fr < 2);
                    const int blk = smp ? (MP / 64 + ((row - MP) >> 4)) : (row >> 6);
                    if (!deferred) {
                        const f32x4 cv = bi + p2 * w0 + p1 * w1 + a * w2;
                        const f32x2 g0 = gelu_pk((f32x2){cv.x, cv.y}), g1 = gelu_pk((f32x2){cv.z, cv.w});
                        u32x2 o; o.x = cvtpk(g0.x * uu.x, g0.y * uu.y); o.y = cvtpk(g1.x * uu.z, g1.y * uu.w);
                        *(u32x2*)(ACT + (size_t)row * DFF + col) = o;
                    } else {
                        u32x2 oa, ou; oa.x = cvtpk(a.x, a.y); oa.y = cvtpk(a.z, a.w); ou.x = cvtpk(uu.x, uu.y); ou.y = cvtpk(uu.z, uu.w);
                        *(u32x2*)(SB + ((size_t)blk * 2 + fr) * DFF + col) = oa; *(u32x2*)(SU + ((size_t)blk * 2 + fr) * DFF + col) = ou;
                    }
                    if (fr >= 14 && (smp || m == 3)) { u32x2 oa; oa.x = cvtpk(a.x, a.y); oa.y = cvtpk(a.z, a.w); *(u32x2*)(SA + ((size_t)blk * 2 + (fr - 14)) * DFF + col) = oa; }
                    pr1 = r1; pr2 = r2;
                    __builtin_amdgcn_sched_barrier(0);
                }
            }
        }
    }
};

template <class F> __device__ __forceinline__ void tr_item(const F& f, int K, bf16_t* WT, int item, int nblk, LAS float* scr, int lane) {
    const int kb = item / nblk, nb = item % nblk, k0 = 64 * kb, n0 = 32 * nb;
#pragma unroll 4
    for (int i = 0; i < 32; ++i) { const int kk = 2 * i + (lane >> 5); scr[kk * 33 + (lane & 31)] = f(k0 + kk, n0 + (lane & 31)); }
    asm volatile("s_waitcnt lgkmcnt(0)" ::: "memory");
    const int c = lane & 7;
#pragma unroll
    for (int j = 0; j < 4; ++j) { const int n = (lane >> 3) + 8 * j; const LAS float* s = scr + (8 * c) * 33 + n;
        u32x4 o; o.x = cvtpk(s[0 * 33], s[1 * 33]); o.y = cvtpk(s[2 * 33], s[3 * 33]); o.z = cvtpk(s[4 * 33], s[5 * 33]); o.w = cvtpk(s[6 * 33], s[7 * 33]);
        *(u32x4*)(WT + (size_t)(n0 + n) * K + k0 + 8 * c) = o; }
    asm volatile("s_waitcnt lgkmcnt(0)" ::: "memory");
}
template <bool FFNPERM = false>
__device__ __forceinline__ void tr_item_plain(const float* W, int ldw, const float* g, int K, bf16_t* WT, int item, int nblk, LAS float* scr, int lane) {
    const int kb = item / nblk, nb = item % nblk, k0 = 64 * kb, n0 = 32 * nb;
    const int c4 = (lane & 7) * 4, kr = lane >> 3;
    const int ns = FFNPERM ? (((n0 & 255) >> 7) * DFF + (n0 >> 8) * 128 + (n0 & 127)) : n0;
#pragma unroll
    for (int i = 0; i < 8; ++i) { const int kk = i * 8 + kr; f32x4 v = __builtin_nontemporal_load((const f32x4*)(W + (size_t)(k0 + kk) * ldw + ns + c4));
        if (g) v = v * g[k0 + kk];
        scr[kk * 33 + c4] = v.x; scr[kk * 33 + c4 + 1] = v.y; scr[kk * 33 + c4 + 2] = v.z; scr[kk * 33 + c4 + 3] = v.w; }
    asm volatile("s_waitcnt lgkmcnt(0)" ::: "memory");
    const int c = lane & 7;
#pragma unroll
    for (int j = 0; j < 4; ++j) { const int n = (lane >> 3) + 8 * j; const LAS float* s = scr + (8 * c) * 33 + n;
        u32x4 o; o.x = cvtpk(s[0 * 33], s[1 * 33]); o.y = cvtpk(s[2 * 33], s[3 * 33]); o.z = cvtpk(s[4 * 33], s[5 * 33]); o.w = cvtpk(s[6 * 33], s[7 * 33]);
        *(u32x4*)(WT + (size_t)(n0 + n) * K + k0 + 8 * c) = o; }
    asm volatile("s_waitcnt lgkmcnt(0)" ::: "memory");
}
struct FPlain { const float* W; int ldw; const float* g; float sc;
    __device__ __forceinline__ float operator()(int k, int n) const { float v = W[(size_t)k * ldw + n] * sc; if (g) v *= g[k]; return v; } };
struct FInAB { const float* W; const float* g; const float* wgu;
    __device__ __forceinline__ float operator()(int k, int n) const {
        const float* wr = W + (size_t)k * 3088; float v;
        if (n < 1536) { v = wr[n]; if (n < 256) v *= 0.125f; }
        else if (n < 2048) { const int q = n - 1536, isk = q >> 8, r = q & 255, h = r >> 6, j = r & 63, i = j >> 1, hf = j & 1;
            v = wr[(isk ? 1808 : 1552) + h * 64 + hf * 32 + i]; if (isk) v *= 0.125f; }
        else if (n < 3072) { v = wr[n + 16]; }
        else { const int c = n - 3072; float s = 0.f;
#pragma unroll
            for (int r = 0; r < 16; ++r) s += wr[1536 + r] * wgu[r * 256 + c];
            v = s; }
        return v * g[k];
    } };
struct FInC { const float* W; const float* g;
    __device__ __forceinline__ float operator()(int k, int n) const {
        const float* wr = W + (size_t)k * 960; float v;
        if (n < 896) v = wr[n];
        else if (n < 960) { const int j = n - 896; v = wr[896 + (j & 1) * 32 + (j >> 1)]; }
        else v = 0.f;
        return v * g[k];
    } };
struct FUq { const float* W; const float* g; float sc;
    __device__ __forceinline__ float operator()(int k, int n) const {
        const int h = n / 192, j = n % 192; int src = n;
        if (j >= 128) { const int jj = j - 128; src = h * 192 + 128 + (jj & 1) * 32 + (jj >> 1); }
        return W[(size_t)k * 1536 + src] * g[k] * sc;
    } };

struct FQl { const float* wuq; const float* wuk; const float* g; float sc;
    __device__ __forceinline__ float operator()(int k, int n) const {
        const int h = n >> 9, l = n & 511; const float* a = wuq + (size_t)k * 1536 + h * 192; const float* b = wuk + ((size_t)l * 8 + h) * 128;
        float s0 = 0.f, s1 = 0.f;
#pragma unroll 8
        for (int q = 0; q < 128; q += 2) { s0 += a[q] * b[q]; s1 += a[q + 1] * b[q + 1]; }
        return (s0 + s1) * g[k] * sc;
    } };

__device__ __forceinline__ bf16x8 cvt8(const float* p) { const f32x4 a = *(const f32x4*)p, b = *(const f32x4*)(p + 4); u32x4 w; w.x = cvtpk(a.x, a.y); w.y = cvtpk(a.z, a.w); w.z = cvtpk(b.x, b.y); w.w = cvtpk(b.z, b.w); return __builtin_bit_cast(bf16x8, w); }
__device__ __forceinline__ void fold_wql(const Params& p, int vb, int nvb) {
    int tid_ = threadIdx.x; asm volatile("" : "+v"(tid_));
    const int lane = tid_ & 63, wave = tid_ >> 6, fr = lane & 15, fq = lane >> 4;
    const float* wuq = p.in[I_WUQ]; const float* wuk = p.in[I_WUK]; const float* g = p.in[I_GQ];
    bf16_t* WQL = (bf16_t*)(p.ws + WS_W_QL);
    const float sc = 0.07216878364870322f * 1.4426950408889634f;
    for (int it = vb * 8 + wave; it < 8 * 32 * 24; it += nvb * 8) {
        const int h = it / (32 * 24), lt = (it / 24) % 32, kt = it % 24;
        const float* ap = wuk + ((size_t)(lt * 16 + fr) * 8 + h) * 128 + fq * 8;
        const float* bp = wuq + (size_t)(kt * 16 + fr) * 1536 + h * 192 + fq * 8;
        f32x4 acc = (f32x4){0.f, 0.f, 0.f, 0.f};
#pragma unroll
        for (int ks = 0; ks < 4; ++ks) acc = __builtin_amdgcn_mfma_f32_16x16x32_bf16(cvt8(ap + ks * 32), cvt8(bp + ks * 32), acc, 0, 0, 0);
        const int kk = kt * 16 + fr; const float gs = g[kk] * sc;
#pragma unroll
        for (int j = 0; j < 4; ++j) WQL[(size_t)(h * 512 + lt * 16 + fq * 4 + j) * 384 + kk] = (bf16_t)(cvtpk(acc[j] * gs, 0.f) & 0xffff);
    }
}

__device__ __forceinline__ float wave_sum(float v) {
#pragma unroll
    for (int o = 1; o < 64; o <<= 1) v += __shfl_xor(v, o);
    return v;
}

__device__ __forceinline__ void phase_prologue(const Params& p, LAS unsigned char* lds, int which, int vb, int nvb) {
    int tid_ = threadIdx.x; asm volatile("" : "+v"(tid_));
    const int tid = tid_, lane = tid & 63, wave = tid >> 6;
    const int gw = vb * 8 + wave, NGW = nvb * 8;
    LAS float* scr = (LAS float*)(lds + wave * 16384);
    unsigned char* ws = p.ws;
    constexpr int I1 = 16 * (NAB / 32), I2 = 16 * 32, I3 = 16 * (5632 / 32), I4 = 44 * 32, I5 = 16 * 32, I6 = 6 * 48, I7 = 8 * 32, I8 = 8 * 32, I9 = 16 * 32;
    constexpr int NIT = I1 + I2 + 2 * I3 + 2 * I4 + I5 + I6 + I7 + I8 + I9;
    for (int it = gw; it < NIT; it += NGW) {
        int r = it;
        { int cls = it < I1 ? 0 : 1;
          const int r3 = it - (I1 + I2); if (r3 >= I3 && r3 < 2 * I3) cls = 2;
          const int r4 = r3 - 2 * I3; if (r4 >= I4 && r4 < 2 * I4) cls = 2;
          if (!((which >> cls) & 1)) continue; }
        if (r < I1) { FInAB f{p.in[I_WINAB], p.in[I_NMIX], p.in[I_WGU]}; tr_item(f, 1024, (bf16_t*)(ws + WS_W_INAB), r, NAB / 32, scr, lane); continue; } r -= I1;
        if (r < I2) { tr_item_plain(p.in[I_WOUTAB], 1024, nullptr, 1024, (bf16_t*)(ws + WS_W_OUTAB), r, 32, scr, lane); continue; } r -= I2;
        if (r < 2 * I3) { const int l = r / I3; r -= l * I3; tr_item_plain<true>(p.in[I_WFFNIN] + (size_t)l * 1024 * 5632, 5632, p.in[I_NFFN] + l * 1024, 1024, (bf16_t*)(ws + WS_W_FFNIN) + (size_t)l * 5632 * 1024, r, 176, scr, lane); continue; } r -= 2 * I3;
        if (r < 2 * I4) { const int l = r / I4; r -= l * I4; tr_item_plain(p.in[I_WFFNOUT] + (size_t)l * 2816 * 1024, 1024, nullptr, 2816, (bf16_t*)(ws + WS_W_FFNOUT) + (size_t)l * 1024 * 2816, r, 32, scr, lane); continue; } r -= 2 * I4;
        if (r < I5) { FInC f{p.in[I_WINC], p.in[I_NMIX] + 1024}; tr_item(f, 1024, (bf16_t*)(ws + WS_W_INC), r, 32, scr, lane); continue; } r -= I5;
        if (r < I6) { FUq f{p.in[I_WUQ], p.in[I_GQ], 0.07216878364870322f * 1.4426950408889634f}; tr_item(f, 384, (bf16_t*)(ws + WS_W_UQ), r, 48, scr, lane); continue; } r -= I6;
        if (r < I7) { tr_item_plain(p.in[I_WUK], 1024, nullptr, 512, (bf16_t*)(ws + WS_W_UK), r, 32, scr, lane); continue; } r -= I7;
        if (r < I8) { tr_item_plain(p.in[I_WUV], 1024, nullptr, 512, (bf16_t*)(ws + WS_W_UV), r, 32, scr, lane); continue; } r -= I8;
        { tr_item_plain(p.in[I_WOUTC], 1024, nullptr, 1024, (bf16_t*)(ws + WS_W_OUTC), r, 32, scr, lane); }
    }
    if (!(which & 1)) return;
    bf16_t* XB = (bf16_t*)(ws + WS_XB); float* ssp = (float*)(ws + WS_SSP);
    for (int row = gw; row < M; row += NGW) {
        const float* x = row < MP ? p.in[I_XP] + (size_t)row * D : p.in[I_XS] + (size_t)(row - MP) * D;
        float ss = 0.f;
#pragma unroll
        for (int j = 0; j < 4; ++j) { const f32x4 v = __builtin_nontemporal_load((const f32x4*)(x + j * 256 + lane * 4)); ss += (v.x * v.x + v.y * v.y) + (v.z * v.z + v.w * v.w);
            u32x2 w; w.x = cvtpk(v.x, v.y); w.y = cvtpk(v.z, v.w); *(u32x2*)(XB + (size_t)row * D + j * 256 + lane * 4) = w; }
        ss = wave_sum(ss);
        if (lane < 16) ssp[(size_t)row * 16 + lane] = lane == 0 ? ss : 0.f;
    }
    float* rot = (float*)(ws + WS_ROT);
    for (int idx = vb * 512 + tid; idx < NPOS * 32; idx += nvb * 512) {
        const int pi = idx >> 5, i = idx & 31; const double pos = (double)(pi < SEQ ? pi : PAST + (pi - SEQ));
        double fr = 1.0; for (int q = 0; q < i; ++q) fr *= 0.7498942093324559;
        const double ang = pos * fr; const double TWO_PI = 6.283185307179586476925287;
        const double kq = __builtin_rint(ang / TWO_PI); const double r = ang - kq * TWO_PI; const double r2 = r * r;
        double sn = 0.0, cn = 0.0, ts = r, tc = 1.0;
        for (int q = 0; q < 15; ++q) { sn += ts; cn += tc; tc = -tc * r2 / (double)((2 * q + 1) * (2 * q + 2)); ts = -ts * r2 / (double)((2 * q + 2) * (2 * q + 3)); }
        rot[(size_t)idx * 2] = (float)cn; rot[(size_t)idx * 2 + 1] = (float)sn;
    }
}

constexpr int SK = 72;
constexpr int L_QR = 0, L_KR = 9216, L_QD = 18432, L_KD = 27648, L_SC = 36864, L_VT = 46080, L_ST = 64512, L_O = 82944, L_SEG = 116736, L_BREF = 118784, L_BLAST = 119040;
constexpr int OS = 132;

__device__ __forceinline__ bf16x8 ldfrag(const LAS unsigned char* base, int row, int col) { return *(const LAS bf16x8*)(base + (row * SK + col) * 2); }

__device__ __forceinline__ void dla_unit(const Params& p, LAS unsigned char* lds, int u) {
    int tid_ = threadIdx.x; asm volatile("" : "+v"(tid_));
    const int tid = tid_, lane = tid & 63, w = tid >> 6, fr = lane & 15, fq = lane >> 4;
    int mixer, b, h, row0, T, c; const float* s_in; float* s_out;
    if (u < 128) { mixer = u >> 6; b = (u & 63) >> 2; h = u & 3; row0 = b * SEQ; T = SEQ; c = 64; s_in = nullptr;
        s_out = p.out + (mixer ? O_RET_P : O_GLA_P) + (size_t)(b * 4 + h) * 64 * 128; }
    else { const int v = u - 128; mixer = v >> 7; b = (v & 127) >> 2; h = v & 3; row0 = MP + b * DSEQ; T = DSEQ; c = 16;
        s_in = p.in[mixer ? I_SRET : I_SGLA] + (size_t)(b * 4 + h) * 64 * 128;
        s_out = p.out + (mixer ? O_RET_S : O_GLA_S) + (size_t)(b * 4 + h) * 64 * 128; }
    const bf16_t* P = (const bf16_t*)(p.ws + WS_P);
    bf16_t* MIX = (bf16_t*)(p.ws + WS_MIX);
    const int qc = (mixer ? 1536 : 0) + h * 64, kc = (mixer ? 1792 : 256) + h * 64, vc0 = (mixer ? 2048 : 512) + h * 128, gc0 = (mixer ? 2560 : 1024) + h * 128, lac = 3072 + h * 64;
    const float* gn = p.in[mixer ? I_GRET : I_GGLA] + h * 128;
    const float lgam = log1pf(-exp2f(-5.0f - (float)h));
    const int tref = (c - 1) >> 1;
    LAS float* SEG = (LAS float*)(lds + L_SEG); LAS float* BREF = (LAS float*)(lds + L_BREF); LAS float* BLAST = (LAS float*)(lds + L_BLAST);
    LAS float* OL = (LAS float*)(lds + L_O);
    const int kr = w & 3, vt0 = (w >> 2) * 4;
    f32x4 Sacc[4];
#pragma unroll
    for (int i = 0; i < 4; ++i) {
        if (s_in) { for (int j = 0; j < 4; ++j) { const int km = kr * 16 + fq * 4 + j, ko = mixer ? ((km & 1) * 32 + (km >> 1)) : km;
            Sacc[i][j] = s_in[(size_t)ko * 128 + (vt0 + i) * 16 + fr]; } }
        else Sacc[i] = (f32x4){0.f, 0.f, 0.f, 0.f};
    }
    __syncthreads();
#pragma unroll
    for (int i = 0; i < 4; ++i) { u32x2 wv; wv.x = cvtpk(Sacc[i][0], Sacc[i][1]); wv.y = cvtpk(Sacc[i][2], Sacc[i][3]);
        *(LAS u32x2*)(lds + L_ST + (((vt0 + i) * 16 + fr) * SK + kr * 16 + fq * 4) * 2) = wv; }
    const int kcol = lane, seg = w;
    const int nch = T / c;
    unsigned short la_r[8], q_r[8], k_r[8], v_r[16];
    const int vv_ = tid & 127, sg_ = tid >> 7;
#define DLA_LOAD(rr) do { \
        _Pragma("unroll") for (int i = 0; i < 8; ++i) { const int t = seg * 8 + i; const bool ok = t < c; const size_t ro = (size_t)((rr) + (ok ? t : 0)) * NAB; \
            la_r[i] = (ok && !mixer) ? __builtin_nontemporal_load(P + ro + lac + kcol) : (unsigned short)0; q_r[i] = ok ? __builtin_nontemporal_load(P + ro + qc + kcol) : (unsigned short)0; k_r[i] = ok ? __builtin_nontemporal_load(P + ro + kc + kcol) : (unsigned short)0; } \
        _Pragma("unroll") for (int i = 0; i < 16; ++i) { const int s_ = sg_ * 16 + i; v_r[i] = (s_ < c) ? __builtin_nontemporal_load(P + (size_t)((rr) + s_) * NAB + vc0 + vv_) : (unsigned short)0; } } while (0)
    DLA_LOAD(row0);
    float gnv[16];
#pragma unroll
    for (int i = 0; i < 16; ++i) gnv[i] = gn[(tid & 7) * 16 + i];
    for (int n = 0; n < nch; ++n) {
        const int r0 = row0 + n * c;
        float bb[8];
        {
            float run = 0.f;
#pragma unroll
            for (int i = 0; i < 8; ++i) { const int t = seg * 8 + i; float la = 0.f;
                if (t < c) la = mixer ? lgam : bf2f(la_r[i]);
                run += la; bb[i] = run; }
            SEG[seg * 64 + kcol] = run;
        }
        __syncthreads();
        {
            float off = 0.f;
            for (int s = 0; s < seg; ++s) off += SEG[s * 64 + kcol];
#pragma unroll
            for (int i = 0; i < 8; ++i) { bb[i] += off; if (seg * 8 + i == tref) BREF[kcol] = bb[i]; if (seg * 8 + i == 63) BLAST[kcol] = bb[i]; }
        }
        __syncthreads();
        {
            const float bref = BREF[kcol], blast = BLAST[kcol];
            float kd[8];
#pragma unroll
            for (int i = 0; i < 8; ++i) { const int t = seg * 8 + i; const float q = bf2f(q_r[i]), k = bf2f(k_r[i]);
                const float e1 = __expf(bb[i] - bref), e2 = __expf(bref - bb[i]), e3 = __expf(bb[i]), e4 = __expf(blast - bb[i]);
                *(LAS bf16_t*)(lds + L_QR + (t * SK + kcol) * 2) = (bf16_t)(cvtpk(q * e1, 0.f) & 0xffff);
                *(LAS bf16_t*)(lds + L_KR + (t * SK + kcol) * 2) = (bf16_t)(cvtpk(k * e2, 0.f) & 0xffff);
                *(LAS bf16_t*)(lds + L_QD + (t * SK + kcol) * 2) = (bf16_t)(cvtpk(q * e3, 0.f) & 0xffff);
                kd[i] = k * e4; }
            u32x4 wv; wv.x = cvtpk(kd[0], kd[1]); wv.y = cvtpk(kd[2], kd[3]); wv.z = cvtpk(kd[4], kd[5]); wv.w = cvtpk(kd[6], kd[7]);
            *(LAS u32x4*)(lds + L_KD + (kcol * SK + seg * 8) * 2) = wv;
            const int v = tid & 127, sg = tid >> 7;
            float vv[16];
#pragma unroll
            for (int i = 0; i < 16; ++i) vv[i] = bf2f(v_r[i]);
            u32x4 w0, w1; w0.x = cvtpk(vv[0], vv[1]); w0.y = cvtpk(vv[2], vv[3]); w0.z = cvtpk(vv[4], vv[5]); w0.w = cvtpk(vv[6], vv[7]);
            w1.x = cvtpk(vv[8], vv[9]); w1.y = cvtpk(vv[10], vv[11]); w1.z = cvtpk(vv[12], vv[13]); w1.w = cvtpk(vv[14], vv[15]);
            *(LAS u32x4*)(lds + L_VT + (v * SK + sg * 16) * 2) = w0; *(LAS u32x4*)(lds + L_VT + (v * SK + sg * 16 + 8) * 2) = w1;
        }
        if (n + 1 < nch) DLA_LOAD(r0 + c);
        u32x4 gate0, gate1;
        { const int tj = tid >> 3, vsj = (tid & 7) * 16; const size_t rowg = (size_t)(r0 + (tj < c ? tj : 0));
          gate0 = __builtin_nontemporal_load((const u32x4*)(P + rowg * NAB + gc0 + vsj)); gate1 = __builtin_nontemporal_load((const u32x4*)(P + rowg * NAB + gc0 + vsj + 8)); }
        __syncthreads();
        {
            const int tr = w & 3;
#pragma unroll
            for (int e = 0; e < 2; ++e) { const int sc = (w >> 2) * 2 + e; f32x4 a = (f32x4){0.f, 0.f, 0.f, 0.f};
#pragma unroll
                for (int ks = 0; ks < 2; ++ks) a = __builtin_amdgcn_mfma_f32_16x16x32_bf16(ldfrag(lds + L_QR, tr * 16 + fr, ks * 32 + fq * 8), ldfrag(lds + L_KR, sc * 16 + fr, ks * 32 + fq * 8), a, 0, 0, 0);
#pragma unroll
                for (int j = 0; j < 4; ++j) { const int t = tr * 16 + fq * 4 + j, s = sc * 16 + fr; const float val = (s <= t) ? a[j] : 0.f;
                    *(LAS bf16_t*)(lds + L_SC + (t * SK + s) * 2) = (bf16_t)(cvtpk(val, 0.f) & 0xffff); } }
        }
        __syncthreads();
        {
            const int tr = w & 3;
#pragma unroll
            for (int i = 0; i < 4; ++i) { const int vt = vt0 + i; f32x4 a = (f32x4){0.f, 0.f, 0.f, 0.f};
#pragma unroll
                for (int ks = 0; ks < 2; ++ks) {
                    a = __builtin_amdgcn_mfma_f32_16x16x32_bf16(ldfrag(lds + L_SC, tr * 16 + fr, ks * 32 + fq * 8), ldfrag(lds + L_VT, vt * 16 + fr, ks * 32 + fq * 8), a, 0, 0, 0);
                    a = __builtin_amdgcn_mfma_f32_16x16x32_bf16(ldfrag(lds + L_QD, tr * 16 + fr, ks * 32 + fq * 8), ldfrag(lds + L_ST, vt * 16 + fr, ks * 32 + fq * 8), a, 0, 0, 0); }
#pragma unroll
                for (int j = 0; j < 4; ++j) OL[(tr * 16 + fq * 4 + j) * OS + vt * 16 + fr] = a[j]; }
            float dec[4];
#pragma unroll
            for (int j = 0; j < 4; ++j) dec[j] = __expf(BLAST[kr * 16 + fq * 4 + j]);
#pragma unroll
            for (int i = 0; i < 4; ++i) { const int vt = vt0 + i; f32x4 a = Sacc[i];
#pragma unroll
                for (int j = 0; j < 4; ++j) a[j] *= dec[j];
#pragma unroll
                for (int ks = 0; ks < 2; ++ks) a = __builtin_amdgcn_mfma_f32_16x16x32_bf16(ldfrag(lds + L_KD, kr * 16 + fr, ks * 32 + fq * 8), ldfrag(lds + L_VT, vt * 16 + fr, ks * 32 + fq * 8), a, 0, 0, 0);
                Sacc[i] = a; }
        }
        __syncthreads();
#pragma unroll
        for (int i = 0; i < 4; ++i) { u32x2 wv; wv.x = cvtpk(Sacc[i][0], Sacc[i][1]); wv.y = cvtpk(Sacc[i][2], Sacc[i][3]);
            *(LAS u32x2*)(lds + L_ST + (((vt0 + i) * 16 + fr) * SK + kr * 16 + fq * 4) * 2) = wv; }
        {
            const int t = tid >> 3, vs = (tid & 7) * 16;
            float o[16]; float s1 = 0.f, s2 = 0.f;
#pragma unroll
            for (int i = 0; i < 16; ++i) { o[i] = OL[t * OS + vs + i]; s1 += o[i]; s2 += o[i] * o[i]; }
            s1 += __shfl_xor(s1, 1); s1 += __shfl_xor(s1, 2); s1 += __shfl_xor(s1, 4);
            s2 += __shfl_xor(s2, 1); s2 += __shfl_xor(s2, 2); s2 += __shfl_xor(s2, 4);
            float mu = 0.f, rs;
            if (mixer) { mu = s1 * (1.f / 128.f); const float var = fmaxf(s2 * (1.f / 128.f) - mu * mu, 0.f); rs = rsqrtf(var + EPS); }
            else rs = rsqrtf(s2 * (1.f / 128.f) + EPS);
            if (t < c) {
                const size_t rowg = (size_t)(r0 + t);
                const unsigned gw[8] = {gate0.x, gate0.y, gate0.z, gate0.w, gate1.x, gate1.y, gate1.z, gate1.w};
                unsigned ow[8];
#pragma unroll
                for (int i = 0; i < 8; ++i) {
                    const float ga = bflo(gw[i]), gb = bfhi(gw[i]);
                    const float ya = (o[2 * i] - mu) * rs * gnv[2 * i] * (ga / (1.f + __expf(-ga)));
                    const float yb = (o[2 * i + 1] - mu) * rs * gnv[2 * i + 1] * (gb / (1.f + __expf(-gb)));
                    ow[i] = cvtpk(ya, yb); }
                bf16_t* mo = MIX + rowg * D + mixer * 512 + h * 128 + vs;
                *(u32x4*)mo = (u32x4){ow[0], ow[1], ow[2], ow[3]}; *(u32x4*)(mo + 8) = (u32x4){ow[4], ow[5], ow[6], ow[7]};
            }
        }
    }
#pragma unroll
    for (int i = 0; i < 4; ++i)
#pragma unroll
        for (int j = 0; j < 4; ++j) { const int km = kr * 16 + fq * 4 + j, ko = mixer ? ((km & 1) * 32 + (km >> 1)) : km;
            s_out[(size_t)ko * 128 + (vt0 + i) * 16 + fr] = Sacc[i][j]; }
    __syncthreads();
}

constexpr int KST = 200;
constexpr int L_AK = 0, L_AV = 64 * KST * 2;

__device__ __forceinline__ void attn_tile(const LAS unsigned char* lds, int kb, int klim, int fr, int fq, const bf16x8 (&qf)[2][6], f32x4 (&oacc)[8][2], float (&mrun)[2], float (&lrun)[2]) {
#pragma unroll 1
        for (int half = 0; half < 2; ++half) {
            const int kb2 = kb + half * 32;
            if (kb2 >= klim) break;
            const bool first0 = mrun[0] < -1e29f, first1 = mrun[1] < -1e29f;
            const float mref0 = first0 ? 0.f : mrun[0], mref1 = first1 ? 0.f : mrun[1];
            f32x4 s[2][2];
#pragma unroll
            for (int e = 0; e < 2; ++e) {
                s[e][0] = (f32x4){-mref0, -mref0, -mref0, -mref0}; s[e][1] = (f32x4){-mref1, -mref1, -mref1, -mref1};
#pragma unroll
                for (int kg = 0; kg < 2; ++kg) {
                    bf16x8 kfr[3];
#pragma unroll
                    for (int k3 = 0; k3 < 3; ++k3) kfr[k3] = *(const LAS bf16x8*)(lds + L_AK + (((half * 2 + e) * 16 + fr) * KST + (kg * 3 + k3) * 32 + fq * 8) * 2);
                    __builtin_amdgcn_sched_barrier(0);
#pragma unroll
                    for (int k3 = 0; k3 < 3; ++k3) {
                        s[e][0] = __builtin_amdgcn_mfma_f32_16x16x32_bf16(kfr[k3], qf[0][kg * 3 + k3], s[e][0], 0, 0, 0);
                        s[e][1] = __builtin_amdgcn_mfma_f32_16x16x32_bf16(kfr[k3], qf[1][kg * 3 + k3], s[e][1], 0, 0, 0); }
                    __builtin_amdgcn_sched_barrier(0);
                }
            }
            if (kb2 + 32 > klim) {
#pragma unroll
                for (int e = 0; e < 2; ++e)
#pragma unroll
                    for (int j = 0; j < 4; ++j) if (kb2 + e * 16 + fq * 4 + j >= klim) { s[e][0][j] = -1e30f; s[e][1][j] = -1e30f; }
            }
            float dl[2];
#pragma unroll
            for (int qt = 0; qt < 2; ++qt) {
                float mx = fmaxf(fmaxf(fmaxf(s[0][qt][0], s[0][qt][1]), fmaxf(s[0][qt][2], s[0][qt][3])), fmaxf(fmaxf(s[1][qt][0], s[1][qt][1]), fmaxf(s[1][qt][2], s[1][qt][3])));
                mx = fmaxf(mx, __shfl_xor(mx, 16)); mx = fmaxf(mx, __shfl_xor(mx, 32));
                dl[qt] = (qt ? first1 : first0) ? mx : fmaxf(mx, 0.f);
            }
            if (__any(dl[0] != 0.f || dl[1] != 0.f)) {
#pragma unroll
                for (int qt = 0; qt < 2; ++qt) {
                    const float alpha = __builtin_amdgcn_exp2f(-dl[qt]);
                    const float al = (qt ? first1 : first0) ? 0.f : alpha;
                    mrun[qt] = (qt ? mref1 : mref0) + dl[qt];
                    lrun[qt] *= al;
#pragma unroll
                    for (int dt = 0; dt < 8; ++dt) oacc[dt][qt] *= al;
#pragma unroll
                    for (int e = 0; e < 2; ++e)
#pragma unroll
                        for (int j = 0; j < 4; ++j) s[e][qt][j] -= dl[qt];
                }
            }
            bf16x8 pf[2];
#pragma unroll
            for (int qt = 0; qt < 2; ++qt) {
                float ps = 0.f;
#pragma unroll
                for (int e = 0; e < 2; ++e)
#pragma unroll
                    for (int j = 0; j < 4; ++j) { const float ex = __builtin_amdgcn_exp2f(s[e][qt][j]); s[e][qt][j] = ex; ps += ex; }
                lrun[qt] += ps;
                u32x4 wv;
                wv.x = cvtpk(s[0][qt][0], s[0][qt][1]); wv.y = cvtpk(s[0][qt][2], s[0][qt][3]);
                wv.z = cvtpk(s[1][qt][0], s[1][qt][1]); wv.w = cvtpk(s[1][qt][2], s[1][qt][3]);
                pf[qt] = __builtin_bit_cast(bf16x8, wv);
            }
#pragma unroll
            for (int dg = 0; dg < 2; ++dg) {
                u32x2 va0[4], va1[4];
#pragma unroll
                for (int d4 = 0; d4 < 4; ++d4) { const int dt = dg * 4 + d4;
                    va0[d4] = *(const LAS u32x2*)(lds + L_AV + ((dt * 16 + fr) * SK + half * 32 + fq * 4) * 2);
                    va1[d4] = *(const LAS u32x2*)(lds + L_AV + ((dt * 16 + fr) * SK + half * 32 + 16 + fq * 4) * 2); }
                __builtin_amdgcn_sched_barrier(0);
#pragma unroll
                for (int d4 = 0; d4 < 4; ++d4) { const int dt = dg * 4 + d4;
                    const bf16x8 vf = __builtin_bit_cast(bf16x8, (u32x4){va0[d4].x, va0[d4].y, va1[d4].x, va1[d4].y});
                    oacc[dt][0] = __builtin_amdgcn_mfma_f32_16x16x32_bf16(vf, pf[0], oacc[dt][0], 0, 0, 0);
                    oacc[dt][1] = __builtin_amdgcn_mfma_f32_16x16x32_bf16(vf, pf[1], oacc[dt][1], 0, 0, 0); }
                __builtin_amdgcn_sched_barrier(0);
            }
        }
}

__device__ __forceinline__ void attn_unit(const Params& p, LAS unsigned char* lds, int qrow0, int nqv, int kv0, int nkeys_unit, int h, bool causal) {
    int tid_ = threadIdx.x; asm volatile("" : "+v"(tid_));
    const int tid = tid_, lane = tid & 63, w = tid >> 6, fr = lane & 15, fq = lane >> 4;
    const bf16_t* Q = (const bf16_t*)(p.ws + WS_Q); const bf16_t* KN = (const bf16_t*)(p.ws + WS_KN);
    const bf16_t* KRA = (const bf16_t*)(p.ws + WS_KRALL); const bf16_t* VT = (const bf16_t*)(p.ws + WS_VT);
    bf16_t* AO = (bf16_t*)(p.ws + WS_AO);
    const int klim = causal ? 64 * ((w >> 1) + 1) + (nkeys_unit - 256) : nkeys_unit;
    const bool active = (w * 32) < nqv;
    bf16x8 qf[2][6];
#pragma unroll
    for (int qt = 0; qt < 2; ++qt) { int qi = w * 32 + qt * 16 + fr; if (qi >= nqv) qi = 0;
#pragma unroll
        for (int ks = 0; ks < 6; ++ks) qf[qt][ks] = *(const bf16x8*)(Q + (size_t)(qrow0 + qi) * 1536 + h * 192 + ks * 32 + fq * 8); }
    f32x4 oacc[8][2];
#pragma unroll
    for (int dt = 0; dt < 8; ++dt) { oacc[dt][0] = (f32x4){0.f, 0.f, 0.f, 0.f}; oacc[dt][1] = (f32x4){0.f, 0.f, 0.f, 0.f}; }
    float mrun[2] = {-1e30f, -1e30f}, lrun[2] = {0.f, 0.f};
    const int ntile = (nkeys_unit + 63) >> 6;
    u32x4 kregA[3], vregA[2];
#define ATT_LOAD(KR_, VR_, tt) do { const int kb_ = (tt) * 64; \
        _Pragma("unroll") for (int i = 0; i < 3; ++i) { const int ch = tid + i * 512, r = ch / 24, cc = ch % 24; const size_t tok = (size_t)(kv0 + kb_ + r); \
            KR_[i] = (cc < 16) ? *(const u32x4*)(KN + tok * 1024 + h * 128 + cc * 8) : *(const u32x4*)(KRA + tok * 64 + (cc - 16) * 8); } \
        _Pragma("unroll") for (int i = 0; i < 2; ++i) { const int ch = tid + i * 512, r = ch >> 3, cc = ch & 7; \
            VR_[i] = *(const u32x4*)(VT + (size_t)(h * 128 + r) * NKV + kv0 + kb_ + cc * 8); } } while (0)
#define ATT_STORE(KR_, VR_) do { \
        _Pragma("unroll") for (int i = 0; i < 3; ++i) { const int ch = tid + i * 512, r = ch / 24, cc = ch % 24; *(LAS u32x4*)(lds + L_AK + (r * KST + cc * 8) * 2) = KR_[i]; } \
        _Pragma("unroll") for (int i = 0; i < 2; ++i) { const int ch = tid + i * 512, r = ch >> 3, cc = ch & 7; *(LAS u32x4*)(lds + L_AV + (r * SK + cc * 8) * 2) = VR_[i]; } } while (0)
#define ATT_BAR() asm volatile("s_waitcnt lgkmcnt(0)\n\ts_barrier" ::: "memory")
    u32x4 kregB[3], vregB[2];
    ATT_LOAD(kregA, vregA, 0);
    if (ntile > 1) ATT_LOAD(kregB, vregB, 1);
    for (int t = 0; t < ntile; t += 2) {
        ATT_BAR();
        ATT_STORE(kregA, vregA);
        ATT_BAR();
        if (t + 2 < ntile) ATT_LOAD(kregA, vregA, t + 2);
        if (active && t * 64 < klim) attn_tile(lds, t * 64, klim, fr, fq, qf, oacc, mrun, lrun);
        if (t + 1 < ntile) {
            ATT_BAR();
            ATT_STORE(kregB, vregB);
            ATT_BAR();
            if (t + 3 < ntile) ATT_LOAD(kregB, vregB, t + 3);
            if (active && (t + 1) * 64 < klim) attn_tile(lds, (t + 1) * 64, klim, fr, fq, qf, oacc, mrun, lrun);
        }
    }
    if (active) {
#pragma unroll
        for (int qt = 0; qt < 2; ++qt) {
            float l = lrun[qt]; l += __shfl_xor(l, 16); l += __shfl_xor(l, 32);
            const float inv = 1.f / l; const int qi = w * 32 + qt * 16 + fr;
            if (qi < nqv) {
#pragma unroll
                for (int dt = 0; dt < 8; ++dt) { u32x2 wv; wv.x = cvtpk(oacc[dt][qt][0] * inv, oacc[dt][qt][1] * inv); wv.y = cvtpk(oacc[dt][qt][2] * inv, oacc[dt][qt][3] * inv);
                    *(u32x2*)(AO + (size_t)(qrow0 + qi) * D + h * 128 + dt * 16 + fq * 4) = wv; }
            }
        }
    }
    __syncthreads();
}

constexpr int LKS = 584;
constexpr int LVS = 40;
constexpr int LKT = 5 * 512 * 16;
constexpr int L_LK = 0, L_LV = 3 * LKT;
constexpr int KSPLIT = KVS / 4;
__device__ __forceinline__ void attn_latent_unit(const Params& p, LAS unsigned char* lds, int b, int dh, int ks) {
    int tid_ = threadIdx.x; asm volatile("" : "+v"(tid_));
    const int tid = tid_, lane = tid & 63, fr = lane & 15, fq = lane >> 4;
    const int w = __builtin_amdgcn_readfirstlane(tid >> 6);
    const bf16_t* CK = (const bf16_t*)(p.ws + WS_CKVALL); const bf16_t* KRA = (const bf16_t*)(p.ws + WS_KRALL);
    const bf16_t* QL = (const bf16_t*)(p.ws + WS_QL); const bf16_t* Q = (const bf16_t*)(p.ws + WS_Q);
    float* PO = (float*)(p.ws + WS_PO); float* PM = (float*)(p.ws + WS_PM); float* PL = (float*)(p.ws + WS_PL);
    const int kv0 = MP + b * KVS + ks * KSPLIT;
    bf16x8 qf[18];
#pragma unroll
    for (int kq = 0; kq < 16; ++kq) qf[kq] = *(const bf16x8*)(QL + (size_t)(b * 16 + fr) * 4096 + w * 512 + kq * 32 + fq * 8);
#pragma unroll
    for (int kq = 16; kq < 18; ++kq) qf[kq] = *(const bf16x8*)(Q + (size_t)(MP + b * 16 + fr) * 1536 + w * 192 + 128 + (kq - 16) * 32 + fq * 8);
    f32x4 oacc[16];
#pragma unroll
    for (int dt = 0; dt < 16; ++dt) oacc[dt] = (f32x4){0.f, 0.f, 0.f, 0.f};
    float mrun = -1e30f, lrun = 0.f;
    constexpr int NST = (KSPLIT + 31) / 32;
#define LAT_DMA(ss, bufi) do { _Pragma("unroll") for (int i = 0; i < 5; ++i) { const int slot = i * 512 + tid; int r = slot / 73, cc = slot % 73; if (r > 31) { r = 31; cc = 0; } if (cc > 71) cc = 0; \
            const size_t tok = (size_t)(kv0 + (ss) * 32 + r); const bf16_t* src = (cc < 64) ? CK + tok * 512 + cc * 8 : KRA + tok * 64 + (cc - 64) * 8; \
            __builtin_amdgcn_global_load_lds((const unsigned*)src, (LAS unsigned*)(lds + L_LK + (bufi) * LKT + (i * 512 + w * 64) * 16), 16, 0, 0); } } while (0)
    LAT_DMA(0, 0);
    LAT_DMA(1, 1);
    int bufc = 0, bufn = 2;
    for (int st = 0; st < NST; ++st) {
        if (st + 1 < NST) asm volatile("s_waitcnt vmcnt(5) lgkmcnt(0)\n\ts_barrier" ::: "memory");
        else asm volatile("s_waitcnt vmcnt(0) lgkmcnt(0)\n\ts_barrier" ::: "memory");
        if (st + 2 < NST) LAT_DMA(st + 2, bufn);
        const LAS unsigned char* kt = lds + L_LK + bufc * LKT;
#pragma unroll
        for (int ps_ = 0; ps_ < 2; ++ps_) {
            const int r = tid & 31, c32 = (tid >> 5) + ps_ * 16;
            const u32x4 v = *(const LAS u32x4*)(kt + (r * LKS + dh * 256 + c32 * 8) * 2);
            const unsigned ww[4] = {v.x, v.y, v.z, v.w};
#pragma unroll
            for (int e = 0; e < 4; ++e) { *(LAS bf16_t*)(lds + L_LV + ((c32 * 8 + 2 * e) * LVS + r) * 2) = (bf16_t)(ww[e] & 0xffffu); *(LAS bf16_t*)(lds + L_LV + ((c32 * 8 + 2 * e + 1) * LVS + r) * 2) = (bf16_t)(ww[e] >> 16); }
        }
        asm volatile("s_waitcnt lgkmcnt(0)\n\ts_barrier" ::: "memory");
        const int kb = st * 32;
        f32x4 s0 = (f32x4){0.f, 0.f, 0.f, 0.f}, s1 = (f32x4){0.f, 0.f, 0.f, 0.f};
#pragma unroll
        for (int kg = 0; kg < 9; ++kg) {
            bf16x8 k0[2], k1[2];
#pragma unroll
            for (int k3 = 0; k3 < 2; ++k3) { const int kq = kg * 2 + k3;
                k0[k3] = *(const LAS bf16x8*)(kt + (fr * LKS + kq * 32 + fq * 8) * 2);
                k1[k3] = *(const LAS bf16x8*)(kt + ((16 + fr) * LKS + kq * 32 + fq * 8) * 2); }
            __builtin_amdgcn_sched_barrier(0);
#pragma unroll
            for (int k3 = 0; k3 < 2; ++k3) { const int kq = kg * 2 + k3;
                s0 = __builtin_amdgcn_mfma_f32_16x16x32_bf16(k0[k3], qf[kq], s0, 0, 0, 0); s1 = __builtin_amdgcn_mfma_f32_16x16x32_bf16(k1[k3], qf[kq], s1, 0, 0, 0); }
            __builtin_amdgcn_sched_barrier(0);
        }
        if (kb + 32 > KSPLIT) {
#pragma unroll
            for (int j = 0; j < 4; ++j) { if (kb + fq * 4 + j >= KSPLIT) s0[j] = -1e30f; if (kb + 16 + fq * 4 + j >= KSPLIT) s1[j] = -1e30f; }
        }
        float mx = fmaxf(fmaxf(fmaxf(s0[0], s0[1]), fmaxf(s0[2], s0[3])), fmaxf(fmaxf(s1[0], s1[1]), fmaxf(s1[2], s1[3])));
        mx = fmaxf(mx, __shfl_xor(mx, 16)); mx = fmaxf(mx, __shfl_xor(mx, 32));
        const float mnew = fmaxf(mrun, mx), alpha = __builtin_amdgcn_exp2f(mrun - mnew);
        mrun = mnew;
        float ps = 0.f;
#pragma unroll
        for (int j = 0; j < 4; ++j) { s0[j] = __builtin_amdgcn_exp2f(s0[j] - mnew); s1[j] = __builtin_amdgcn_exp2f(s1[j] - mnew); ps += s0[j] + s1[j]; }
        lrun = lrun * alpha + ps;
        u32x4 wv; wv.x = cvtpk(s0[0], s0[1]); wv.y = cvtpk(s0[2], s0[3]); wv.z = cvtpk(s1[0], s1[1]); wv.w = cvtpk(s1[2], s1[3]);
        const bf16x8 pf = __builtin_bit_cast(bf16x8, wv);
#pragma unroll
        for (int dg = 0; dg < 8; ++dg) {
            u32x2 va0[2], va1[2];
#pragma unroll
            for (int d4 = 0; d4 < 2; ++d4) { const int dt = dg * 2 + d4;
                va0[d4] = *(const LAS u32x2*)(lds + L_LV + ((dt * 16 + fr) * LVS + fq * 4) * 2);
                va1[d4] = *(const LAS u32x2*)(lds + L_LV + ((dt * 16 + fr) * LVS + 16 + fq * 4) * 2); }
            __builtin_amdgcn_sched_barrier(0);
#pragma unroll
            for (int d4 = 0; d4 < 2; ++d4) { const int dt = dg * 2 + d4;
                const bf16x8 vf = __builtin_bit_cast(bf16x8, (u32x4){va0[d4].x, va0[d4].y, va1[d4].x, va1[d4].y});
                oacc[dt] = __builtin_amdgcn_mfma_f32_16x16x32_bf16(vf, pf, oacc[dt] * alpha, 0, 0, 0); }
            __builtin_amdgcn_sched_barrier(0);
        }
        bufc = bufc == 2 ? 0 : bufc + 1; bufn = bufn == 2 ? 0 : bufn + 1;
    }
#undef LAT_DMA
    { float l = lrun; l += __shfl_xor(l, 16); l += __shfl_xor(l, 32);
      const size_t prow = (size_t)((b * 4 + ks) * 8 + w) * 16 + fr;
#pragma unroll
      for (int dt = 0; dt < 16; ++dt) *(f32x4*)(PO + prow * 512 + dh * 256 + dt * 16 + fq * 4) = oacc[dt];
      if (dh == 0 && fq == 0) { PM[prow] = mrun; PL[prow] = l; } }
    asm volatile("s_waitcnt vmcnt(0) lgkmcnt(0)\n\ts_barrier" ::: "memory");
}

constexpr int OLS = 520;
__device__ __forceinline__ void attn_latent_combine(const Params& p, LAS unsigned char* lds, int b, int h) {
    int tid_ = threadIdx.x; asm volatile("" : "+v"(tid_));
    const int tid = tid_, lane = tid & 63, w = tid >> 6, fr = lane & 15, fq = lane >> 4;
    const float* PO = (const float*)(p.ws + WS_PO); const float* PM = (const float*)(p.ws + WS_PM); const float* PL = (const float*)(p.ws + WS_PL);
    const bf16_t* WUV = (const bf16_t*)(p.ws + WS_W_UV); bf16_t* AO = (bf16_t*)(p.ws + WS_AO);
    {
        const int t = tid >> 5, d0 = (tid & 31) * 16;
        float mk[4], M_ = -1e30f;
#pragma unroll
        for (int k = 0; k < 4; ++k) { mk[k] = PM[(size_t)((b * 4 + k) * 8 + h) * 16 + t]; M_ = fmaxf(M_, mk[k]); }
        float L_ = 0.f; f32x4 o[4];
#pragma unroll
        for (int i = 0; i < 4; ++i) o[i] = (f32x4){0.f, 0.f, 0.f, 0.f};
#pragma unroll
        for (int k = 0; k < 4; ++k) { const size_t prow = (size_t)((b * 4 + k) * 8 + h) * 16 + t; const float sc = __builtin_amdgcn_exp2f(mk[k] - M_); L_ += sc * PL[prow];
#pragma unroll
            for (int i = 0; i < 4; ++i) o[i] += *(const f32x4*)(PO + prow * 512 + d0 + i * 4) * sc; }
        const float inv = 1.f / L_;
        u32x4 w0, w1; w0.x = cvtpk(o[0].x * inv, o[0].y * inv); w0.y = cvtpk(o[0].z * inv, o[0].w * inv); w0.z = cvtpk(o[1].x * inv, o[1].y * inv); w0.w = cvtpk(o[1].z * inv, o[1].w * inv);
        w1.x = cvtpk(o[2].x * inv, o[2].y * inv); w1.y = cvtpk(o[2].z * inv, o[2].w * inv); w1.z = cvtpk(o[3].x * inv, o[3].y * inv); w1.w = cvtpk(o[3].z * inv, o[3].w * inv);
        *(LAS u32x4*)(lds + (t * OLS + d0) * 2) = w0; *(LAS u32x4*)(lds + (t * OLS + d0 + 8) * 2) = w1;
    }
    __syncthreads();
    {
        f32x4 acc = (f32x4){0.f, 0.f, 0.f, 0.f};
#pragma unroll 4
        for (int kq = 0; kq < 16; ++kq) {
            const bf16x8 a = *(const LAS bf16x8*)(lds + (fr * OLS + kq * 32 + fq * 8) * 2);
            const bf16x8 bb = *(const bf16x8*)(WUV + (size_t)(h * 128 + w * 16 + fr) * 512 + kq * 32 + fq * 8);
            acc = __builtin_amdgcn_mfma_f32_16x16x32_bf16(a, bb, acc, 0, 0, 0);
        }
#pragma unroll
        for (int j = 0; j < 4; ++j) AO[(size_t)(MP + b * 16 + fq * 4 + j) * D + h * 128 + w * 16 + fr] = (bf16_t)(cvtpk(acc[j], 0.f) & 0xffff);
    }
    __syncthreads();
}

__device__ __forceinline__ void unpack8(const u32x4 w, float (&f)[8]) { f[0] = bflo(w.x); f[1] = bfhi(w.x); f[2] = bflo(w.y); f[3] = bfhi(w.y); f[4] = bflo(w.z); f[5] = bfhi(w.z); f[6] = bflo(w.w); f[7] = bfhi(w.w); }
__device__ __forceinline__ void phase_ffn_fix(const Params& p, int layer) {
    const bf16_t* SA = (const bf16_t*)(p.ws + WS_SIDEA); const bf16_t* SB = (const bf16_t*)(p.ws + WS_SIDEB); const bf16_t* SU = (const bf16_t*)(p.ws + WS_SIDEU);
    bf16_t* ACT = (bf16_t*)(p.ws + WS_ACT);
    const float* wd = p.in[I_WDW] + (size_t)layer * 3 * DFF; const float* bd = p.in[I_BDW] + (size_t)layer * DFF;
    constexpr int NCC = DFF / 8;
    int tid_ = threadIdx.x; asm volatile("" : "+v"(tid_));
    for (int item = blockIdx.x * 512 + tid_; item < NBLK * NCC; item += gridDim.x * 512) {
        const int blk = item / NCC, cc = item % NCC, c0 = cc * 8;
        const bool smp = blk >= MP / 64;
        const int row0 = smp ? MP + (blk - MP / 64) * 16 : blk * 64;
        float w0[8], w1[8], w2[8], bi[8], am2[8], am1[8], a0[8], a1[8], u0[8], u1[8];
#pragma unroll
        for (int i = 0; i < 8; ++i) { w0[i] = wd[c0 + i]; w1[i] = wd[DFF + c0 + i]; w2[i] = wd[2 * DFF + c0 + i]; bi[i] = bd[c0 + i]; }
        if (smp) { const float* sc = p.in[I_SCONV] + ((size_t)(layer * 32 + (blk - MP / 64)) * 2) * DFF + c0;
#pragma unroll
            for (int i = 0; i < 8; ++i) { am2[i] = sc[i]; am1[i] = sc[DFF + i]; } }
        else if ((blk & 31) == 0) {
#pragma unroll
            for (int i = 0; i < 8; ++i) { am2[i] = 0.f; am1[i] = 0.f; } }
        else { unpack8(*(const u32x4*)(SA + ((size_t)(blk - 1) * 2) * DFF + c0), am2); unpack8(*(const u32x4*)(SA + ((size_t)(blk - 1) * 2 + 1) * DFF + c0), am1); }
        unpack8(*(const u32x4*)(SB + ((size_t)blk * 2) * DFF + c0), a0); unpack8(*(const u32x4*)(SB + ((size_t)blk * 2 + 1) * DFF + c0), a1);
        unpack8(*(const u32x4*)(SU + ((size_t)blk * 2) * DFF + c0), u0); unpack8(*(const u32x4*)(SU + ((size_t)blk * 2 + 1) * DFF + c0), u1);
        float y0[8], y1[8];
#pragma unroll
        for (int i = 0; i < 8; i += 2) {
            f32x2 c0v, c1v;
            c0v.x = bi[i] + am2[i] * w0[i] + am1[i] * w1[i] + a0[i] * w2[i]; c0v.y = bi[i + 1] + am2[i + 1] * w0[i + 1] + am1[i + 1] * w1[i + 1] + a0[i + 1] * w2[i + 1];
            c1v.x = bi[i] + am1[i] * w0[i] + a0[i] * w1[i] + a1[i] * w2[i]; c1v.y = bi[i + 1] + am1[i + 1] * w0[i + 1] + a0[i + 1] * w1[i + 1] + a1[i + 1] * w2[i + 1];
            const f32x2 g0 = gelu_pk(c0v), g1 = gelu_pk(c1v);
            y0[i] = g0.x * u0[i]; y0[i + 1] = g0.y * u0[i + 1]; y1[i] = g1.x * u1[i]; y1[i + 1] = g1.y * u1[i + 1]; }
        u32x4 o; o.x = cvtpk(y0[0], y0[1]); o.y = cvtpk(y0[2], y0[3]); o.z = cvtpk(y0[4], y0[5]); o.w = cvtpk(y0[6], y0[7]);
        *(u32x4*)(ACT + (size_t)row0 * DFF + c0) = o;
        o.x = cvtpk(y1[0], y1[1]); o.y = cvtpk(y1[2], y1[3]); o.z = cvtpk(y1[4], y1[5]); o.w = cvtpk(y1[6], y1[7]);
        *(u32x4*)(ACT + (size_t)(row0 + 1) * DFF + c0) = o;
        if (smp || (blk & 31) == 31) {
            float l0[8], l1[8];
            unpack8(*(const u32x4*)(SA + ((size_t)blk * 2) * DFF + c0), l0); unpack8(*(const u32x4*)(SA + ((size_t)blk * 2 + 1) * DFF + c0), l1);
            float* co = smp ? p.out + O_CONV_S + ((size_t)(layer * 32 + (blk - MP / 64)) * 2) * DFF + c0
                            : p.out + O_CONV_P + ((size_t)(layer * 16 + (blk >> 5)) * 2) * DFF + c0;
#pragma unroll
            for (int i = 0; i < 8; ++i) { co[i] = l0[i]; co[DFF + i] = l1[i]; }
        }
    }
}

__device__ __forceinline__ void phase_fix(const Params& p, int which, int vb, int nvb) {
    int tid_ = threadIdx.x; asm volatile("" : "+v"(tid_));
    const int tid = tid_, lane = tid & 63, wave = tid >> 6;
    const int gw = vb * 8 + wave, NGW = nvb * 8;
    bf16_t* CKVALL = (bf16_t*)(p.ws + WS_CKVALL); bf16_t* KRALL = (bf16_t*)(p.ws + WS_KRALL);
    const float* ssq = (const float*)(p.ws + WS_SSQ); float* ckv = p.out + O_CKV; const float* gkv = p.in[I_GKV];
    const f32x4 g0 = *(const f32x4*)(gkv + lane * 8), g1 = *(const f32x4*)(gkv + lane * 8 + 4);
    if (which & 1)
    for (int row = gw; row < M; row += NGW) {
        const f32x4* pp = (const f32x4*)(ssq + (size_t)row * 32 + 12);
        const float s = (sum4(pp[0]) + sum4(pp[1])) + (sum4(pp[2]) + sum4(pp[3]));
        const float rs = rsqrtf(s * (1.f / 512.f) + EPS);
        bf16_t* cb = CKVALL + (size_t)kvtok(row) * 512 + lane * 8;
        const u32x4 rw = *(const u32x4*)cb;
        f32x4 a = (f32x4){bflo(rw.x), bfhi(rw.x), bflo(rw.y), bfhi(rw.y)}, b = (f32x4){bflo(rw.z), bfhi(rw.z), bflo(rw.w), bfhi(rw.w)};
        a = a * rs * g0; b = b * rs * g1;
        float* cr = ckv + (size_t)row * 512 + lane * 8;
        __builtin_nontemporal_store(a, (f32x4*)cr); __builtin_nontemporal_store(b, (f32x4*)(cr + 4));
        u32x4 o; o.x = cvtpk(a.x, a.y); o.y = cvtpk(a.z, a.w); o.z = cvtpk(b.x, b.y); o.w = cvtpk(b.z, b.w);
        *(u32x4*)cb = o;
    }
    if (!(which & 2)) return;
    const float* cc = p.in[I_CCKV];
    for (int r = gw; r < 32 * PAST; r += NGW) {
        const int b = r >> 12, s = r & (PAST - 1);
        const f32x4 a = __builtin_nontemporal_load((const f32x4*)(cc + (size_t)r * 512 + lane * 8)), b4 = __builtin_nontemporal_load((const f32x4*)(cc + (size_t)r * 512 + lane * 8 + 4));
        u32x4 o; o.x = cvtpk(a.x, a.y); o.y = cvtpk(a.z, a.w); o.z = cvtpk(b4.x, b4.y); o.w = cvtpk(b4.z, b4.w);
        *(u32x4*)(CKVALL + (size_t)(MP + b * KVS + s) * 512 + lane * 8) = o;
    }
    const float* ck = p.in[I_CKR];
    for (int it = vb * 512 + tid; it < 32 * PAST * 16; it += nvb * 512) {
        const int r = it >> 4, q = it & 15, b = r >> 12, s = r & (PAST - 1);
        const float* src = ck + (size_t)r * 64;
        u32x2 o; o.x = cvtpk(src[2 * q], src[32 + 2 * q]); o.y = cvtpk(src[2 * q + 1], src[33 + 2 * q]);
        *(u32x2*)(KRALL + (size_t)(MP + b * KVS + s) * 64 + q * 4) = o;
    }
}

__device__ __forceinline__ void phase_final(const Params& p) {
    int tid_ = threadIdx.x; asm volatile("" : "+v"(tid_));
    const int tid = tid_, lane = tid & 63, wave = tid >> 6;
    const int gw = blockIdx.x * 8 + wave, NGW = gridDim.x * 8;
    float* Y = p.out + O_Y; const float* g = p.in[I_NFIN]; const bf16_t* XB = (const bf16_t*)(p.ws + WS_XB); const float* ssp = (const float*)(p.ws + WS_SSP);
    for (int row = gw; row < M; row += NGW) {
        const float rs = rstd_from16(ssp, row);
#pragma unroll
        for (int j = 0; j < 4; ++j) { const u32x2 xb = __builtin_nontemporal_load((const u32x2*)(XB + (size_t)row * D + j * 256 + lane * 4));
            const f32x4 v = (f32x4){bflo(xb.x), bfhi(xb.x), bflo(xb.y), bfhi(xb.y)};
            const f32x4 gg = *(const f32x4*)(g + j * 256 + lane * 4); __builtin_nontemporal_store(v * rs * gg, (f32x4*)(Y + (size_t)row * D + j * 256 + lane * 4)); }
    }
}

__device__ __forceinline__ void skinny_res(const Params& p, LAS unsigned char* lds, const bf16_t* A, const bf16_t* Bt, int K, int job) {
    int tid_ = threadIdx.x; asm volatile("" : "+v"(tid_));
    const int tid = tid_, lane = tid & 63, w = tid >> 6, fr = lane & 15, fq = lane >> 4, rt = w >> 2, ct = w & 3;
    bf16_t* XB = (bf16_t*)(p.ws + WS_XB); float* ssp = (float*)(p.ws + WS_SSP);
    LAS float* red = (LAS float*)lds;
    for (int u = blockIdx.x; u < 256; u += gridDim.x) {
        const int rg = u >> 4, cg = u & 15, row0 = MP + rg * 32 + rt * 16, col0 = cg * 64 + ct * 16;
        const bf16_t* ap = A + (size_t)(row0 + fr) * K + fq * 8;
        const bf16_t* bp = Bt + (size_t)(col0 + fr) * K + fq * 8;
        f32x4 acc0 = (f32x4){0.f, 0.f, 0.f, 0.f}, acc1 = (f32x4){0.f, 0.f, 0.f, 0.f};
        const int nks = K >> 5;
#pragma unroll 4
        for (int ks = 0; ks < nks; ks += 2) {
            const bf16x8 a0 = *(const bf16x8*)(ap + ks * 32), b0 = *(const bf16x8*)(bp + ks * 32);
            const bf16x8 a1 = *(const bf16x8*)(ap + ks * 32 + 32), b1 = *(const bf16x8*)(bp + ks * 32 + 32);
            acc0 = __builtin_amdgcn_mfma_f32_16x16x32_bf16(a0, b0, acc0, 0, 0, 0);
            acc1 = __builtin_amdgcn_mfma_f32_16x16x32_bf16(a1, b1, acc1, 0, 0, 0);
        }
        float ssj[4];
#pragma unroll
        for (int j = 0; j < 4; ++j) {
            const int row = row0 + fq * 4 + j, col = col0 + fr;
            const float x = bf2f(XB[(size_t)row * D + col]) + (acc0[j] + acc1[j]);
            XB[(size_t)row * D + col] = (bf16_t)(cvtpk(x, 0.f) & 0xffff);
            float ss = x * x;
            ss += __shfl_xor(ss, 1); ss += __shfl_xor(ss, 2); ss += __shfl_xor(ss, 4); ss += __shfl_xor(ss, 8);
            ssj[j] = ss;
        }
        __syncthreads();
        if (fr == 0) {
#pragma unroll
            for (int j = 0; j < 4; ++j) red[(rt * 16 + fq * 4 + j) * 4 + ct] = ssj[j];
        }
        __syncthreads();
        if (tid < 32) ssp[(size_t)(MP + rg * 32 + tid) * 16 + cg] = (red[tid * 4] + red[tid * 4 + 1]) + (red[tid * 4 + 2] + red[tid * 4 + 3]);
    }
    __syncthreads();
}

#define XB_TMO      128
#define XB_XCNT(j)  (256  + 64 * (j))
#define XB_XSUB(j)  (1280 + 64 * (j))
#define XB_XGEN(j)  (2304 + 64 * (j))
#define XB_TOP      3328
#define XB_TOPGEN   3392
#define XCD_BAR_WORDS 3456
#define XB_SPIN_CAP (1u << 18)

__device__ __forceinline__ unsigned xb_ld(unsigned* p)              { return __hip_atomic_load(p, __ATOMIC_RELAXED, __HIP_MEMORY_SCOPE_AGENT); }
__device__ __forceinline__ unsigned xb_add(unsigned* p, unsigned v) { return __hip_atomic_fetch_add(p, v, __ATOMIC_RELAXED, __HIP_MEMORY_SCOPE_AGENT); }
__device__ __forceinline__ unsigned xb_xcc_id() { return (unsigned)__builtin_amdgcn_s_getreg((3 << 11) | 20) & 0xFu; }
#define XB_SPIN(cond, bar) do { unsigned _sp = 0; while (cond) { __builtin_amdgcn_s_sleep(1); \
    if ((++_sp & 255u) == 0u) { if (xb_ld(&(bar)[XB_TMO])) break; if (_sp > XB_SPIN_CAP) { atomicAdd(&(bar)[XB_TMO], 1u); break; } } } } while (0)

struct XcdBarrier {
    unsigned* bar; unsigned x;
    volatile LAS unsigned* st;
};

__device__ __forceinline__ XcdBarrier xcd_barrier_post(unsigned* bar, volatile LAS unsigned* st) {
    XcdBarrier b; b.bar = bar; b.x = xb_xcc_id(); b.st = st;
    if (threadIdx.x == 0) (void)xb_add(&bar[XB_XCNT(b.x)], 1u);
    return b;
}
__device__ __forceinline__ void xcd_barrier_complete(unsigned* bar, unsigned x, unsigned& nloc, unsigned& nx) {
    const unsigned G = gridDim.x * gridDim.y * gridDim.z;
    unsigned sum, cnt, mine, sp = 0u;
    for (;;) {
        sum = 0u; cnt = 0u; mine = 0u;
#pragma unroll
        for (unsigned j = 0; j < 16; ++j) { const unsigned c = xb_ld(&bar[XB_XCNT(j)]); sum += c; cnt += (c > 0u) ? 1u : 0u; mine = (j == x) ? c : mine; }
        if (sum == G) break;
        __builtin_amdgcn_s_sleep(1);
        if ((++sp & 255u) == 0u) { if (xb_ld(&bar[XB_TMO])) break; if (sp > XB_SPIN_CAP) { atomicAdd(&bar[XB_TMO], 1u); break; } }
    }
    nloc = mine > 0u ? mine : 1u; nx = cnt > 0u ? cnt : 1u;
}

__device__ __forceinline__ void xcd_barrier(const XcdBarrier& b) {
    asm volatile("s_waitcnt vmcnt(0)" ::: "memory");
    __syncthreads();
    if (threadIdx.x == 0) {
        unsigned* bar = b.bar;
        __builtin_amdgcn_s_waitcnt(0);
        unsigned nloc = b.st[0], nx = b.st[1];
        if (nloc == 0u) { xcd_barrier_complete(bar, b.x, nloc, nx); b.st[0] = nloc; b.st[1] = nx; }
        const unsigned old = xb_add(&bar[XB_XSUB(b.x)], 1u);
        const unsigned gen = old / nloc;
        if (old + 1u == (gen + 1u) * nloc) {
            __builtin_amdgcn_fence(__ATOMIC_RELEASE, "agent");
            asm volatile("s_waitcnt vmcnt(0)" ::: "memory");
            const unsigned og = xb_add(&bar[XB_TOP], 1u);
            const unsigned tg = og / nx;
            if (og + 1u == (tg + 1u) * nx) xb_add(&bar[XB_TOPGEN], 1u);
            else XB_SPIN(xb_ld(&bar[XB_TOPGEN]) == tg, bar);
            __builtin_amdgcn_fence(__ATOMIC_ACQUIRE, "agent");
            xb_add(&bar[XB_XGEN(b.x)], 1u);
            asm volatile("s_waitcnt vmcnt(0)" ::: "memory");
        } else {
            XB_SPIN(xb_ld(&bar[XB_XGEN(b.x)]) == gen, bar);
            __builtin_amdgcn_fence(__ATOMIC_ACQUIRE, "agent");
            asm volatile("s_waitcnt vmcnt(0)" ::: "memory");
        }
    }
    __syncthreads();
}


#ifdef DBG_ZERO
constexpr int NPHASE = 17;
#else
constexpr int NPHASE = 16;
#endif
__global__ void __launch_bounds__(512, 2) mega_fwd(Params pk) {
    extern __shared__ __attribute__((aligned(16))) unsigned char smem[];
    LAS unsigned char* lds = (LAS unsigned char*)smem;
    const int G = gridDim.x, bx = blockIdx.x;
#ifndef PHMASK
#define PHMASK 0x1FFFF
#endif
#define PH(k) ((((PHMASK) >> (k)) & 1) && ph == (k))
#ifndef REPMASK
#define REPMASK 0
#endif
    volatile LAS unsigned* bst = (volatile LAS unsigned*)(lds + LDS_BYTES - 64);
    if (threadIdx.x < 2) bst[threadIdx.x] = 0u;
    __syncthreads();
    XcdBarrier xbar; xbar.bar = (unsigned*)pk.ws; xbar.x = 0; xbar.st = bst;
    if (pk.ph_hi - pk.ph_lo > 1) xbar = xcd_barrier_post((unsigned*)pk.ws, bst);
    bool first = true; int nseam = 0;
#pragma unroll 1
    for (int slot = 2 * pk.ph_lo; slot < 2 * pk.ph_hi; ++slot) {
        const int ph = slot >> 1;
        if ((slot & 1) && !((REPMASK >> ph) & 1)) continue;
        if (!first) { if (pk.ph_lo < 0) cg::this_grid().sync(); else xcd_barrier(xbar); ++nseam; }
        first = false;
        const __attribute__((address_space(4))) char* ka = (const __attribute__((address_space(4))) char*)__builtin_amdgcn_kernarg_segment_ptr();
        asm volatile("" : "+s"(ka));
        const Params& p = *(const Params*)(const char*)ka;
        unsigned char* ws = p.ws;
        bf16_t* XB = (bf16_t*)(ws + WS_XB);
        if (PH(0)) { phase_prologue(p, lds, G == 256 ? 1 : 7, bx, G); if (G != 256) fold_wql(p, bx, G); }
        else if (PH(1) || PH(8) || PH(9)) {
            const bool ql8 = (G == 256);
            int nsub = (ph == 9) ? (ql8 ? 3 : 4) : 1;
            if (ph == 8) nsub = (ql8 && bx < 44) ? 1 : 0;
#pragma unroll 1
            for (int sub = 0; sub < nsub; ++sub) {
                pg8::Gemm g; EpiBf E; E.pp = &p;
                if (ph == 1) { g = pg8::Gemm{XB, (const bf16_t*)(ws + WS_W_INAB), M, NAB, 1024}; E.job = 1; }
                else if ((ph == 8 && bx < 32) || sub == 3) { g = pg8::Gemm{(const bf16_t*)(ws + WS_CQ) + (size_t)MP * 384, (const bf16_t*)(ws + WS_W_QL), MS, 4096, 384}; E.job = 93; }
                else if (ph == 8) { g = pg8::Gemm{(const bf16_t*)(ws + WS_CQ) + (size_t)MP * 384, (const bf16_t*)(ws + WS_W_UQ), MS, 1536, 384}; E.job = 94; }
                else if (sub == 0) { g = pg8::Gemm{(const bf16_t*)(ws + WS_CQ), (const bf16_t*)(ws + WS_W_UQ), ql8 ? MP : M, 1536, 384}; E.job = 90; }
                else if (sub == 1) { g = pg8::Gemm{(const bf16_t*)(ws + WS_CKVALL), (const bf16_t*)(ws + WS_W_UK), MP, 1024, 512}; E.job = 91; }
                else { g = pg8::Gemm{(const bf16_t*)(ws + WS_W_UV), (const bf16_t*)(ws + WS_CKVALL), 1024, MP, 512}; E.job = 92; }
                pg8::StaticOrder S; S.init(g.M, g.N, ph == 8 ? (bx < 32 ? 32 : 12) : G, ph == 8 && bx >= 32 ? bx - 32 : bx);
                pg8::gemm_phase(lds, g, S, E);
            }
            if (ph == 8) { if (!ql8) phase_fix(p, 3, bx, G); else if (bx >= 44) phase_fix(p, 1, bx - 44, G - 44); }
        }
        else if (PH(4) || PH(12)) {
            const int layer = ph == 12;
            { int t_ = threadIdx.x; asm volatile("" : "+v"(t_)); const float* ssp = (const float*)(ws + WS_SSP); float* rsp = (float*)(ws + WS_RS);
              for (int row = bx * 512 + t_; row < M; row += G * 512) rsp[row] = rstd_from16(ssp, row); }
            xcd_barrier(xbar);
            pg8::Gemm g{XB, (const bf16_t*)(ws + WS_W_FFNIN) + (size_t)layer * 5632 * 1024, M, 5632, 1024};
            EpiFfn E{&p, layer};
#ifndef WGM_FFNUP
#define WGM_FFNUP 4
#endif
            pg8::StaticOrder S; S.init(g.M, g.N, G, bx, WGM_FFNUP);
            pg8::gemm_phase(lds, g, S, E);
            if (ph == 4 && G == 256 && bx >= 44) phase_prologue(p, lds, 4, bx - 44, G - 44);
        }
        else if (PH(2)) {
#pragma unroll 1
            for (int u = bx; u < 384; u += G) dla_unit(p, lds, u);
            if (G == 256 && bx >= 128) { __syncthreads(); phase_prologue(p, lds, 2, bx - 128, G - 128); fold_wql(p, bx - 128, G - 128); }
        }
        else if (PH(3) || PH(6) || PH(11) || PH(14)) {
            if (ph == 11) {
#pragma unroll 1
                for (int u = bx; u < 256; u += G) attn_latent_combine(p, lds, u >> 3, u & 7);
                xcd_barrier(xbar);
            }
            pg8::Gemm g; EpiRes E; E.pp = &p; E.job = ph;
            if (ph == 3) { g = pg8::Gemm{(const bf16_t*)(ws + WS_MIX), (const bf16_t*)(ws + WS_W_OUTAB), MP, 1024, 1024}; }
            else if (ph == 11) { g = pg8::Gemm{(const bf16_t*)(ws + WS_AO), (const bf16_t*)(ws + WS_W_OUTC), MP, 1024, 1024}; }
            else { const int layer = ph == 14; g = pg8::Gemm{(const bf16_t*)(ws + WS_ACT), (const bf16_t*)(ws + WS_W_FFNOUT) + (size_t)layer * 1024 * 2816, MP, 1024, 2816}; }
            pg8::StaticOrder S; S.init(g.M, g.N, G, bx);
            pg8::gemm_phase(lds, g, S, E);
            skinny_res(p, lds, g.A, g.Bt, g.K, ph);
        }
        else if (PH(5) || PH(13)) { phase_ffn_fix(p, ph == 13); }
        else if (PH(7)) {
            pg8::Gemm g{XB, (const bf16_t*)(ws + WS_W_INC), M, 1024, 1024}; pg8::StaticOrder S; S.init(M, 1024, G, bx);
            EpiInC E{&p};
            pg8::gemm_phase(lds, g, S, E);
            if (G == 256 && bx >= 8) phase_fix(p, 2, bx - 8, G - 8);
        }
        else if (PH(10)) {
#pragma unroll 1
            for (int u = bx; u < 1280; u += G) {
                const int c = u & 255, i = u >> 8;
                if (i < 4) { const int bh = c >> 1, par = c & 1; const int qb = par ? (i == 0 ? 1 : i == 1 ? 2 : i == 2 ? 5 : 6) : (i == 0 ? 0 : i == 1 ? 3 : i == 2 ? 4 : 7);
                    const int b = bh >> 3, h = bh & 7;
                    attn_unit(p, lds, b * SEQ + qb * 256, 256, b * SEQ, (qb + 1) * 256, h, true); }
                else attn_latent_unit(p, lds, c >> 3, (c >> 2) & 1, c & 3);
            }
        }
        else if (PH(15)) { phase_final(p); }
#ifdef DBG_ZERO
        else if (ph == 16) {
            int tz_ = threadIdx.x; asm volatile("" : "+v"(tz_));
#define DZ(o, lo, hi) if ((DBG_ZERO >> (o)) & 1) { for (size_t i = (size_t)(lo) + (size_t)bx * 512 + tz_; i < (size_t)(hi); i += (size_t)G * 512) p.out[i] = 0.f; }
        DZ(0, 0, (size_t)MP * D) DZ(1, (size_t)MP * D, O_GLA_P) DZ(2, O_GLA_P, O_GLA_S) DZ(3, O_GLA_S, O_RET_P) DZ(4, O_RET_P, O_RET_S) DZ(5, O_RET_S, O_CKV)
        DZ(6, O_CKV, O_CKV + (size_t)MP * 512) DZ(7, O_CKV + (size_t)MP * 512, O_KR) DZ(8, O_KR, O_KR + (size_t)MP * 64) DZ(9, O_KR + (size_t)MP * 64, O_CONV_P)
        DZ(10, O_CONV_P, O_CONV_S) DZ(11, O_CONV_S, O_CONV_S + 2 * 32 * 2 * DFF)
        }
#endif
    }
}

extern "C" void kernel_launch(void* const* d_in, const int* in_sizes, int n_in, void* d_out, int out_size, void* d_ws, size_t ws_size, hipStream_t stream) {
    static int grid = 0;
    if (grid == 0) {
        int dev = 0, cus = 0, per_cu = 0;
        (void)hipGetDevice(&dev);
        (void)hipDeviceGetAttribute(&cus, hipDeviceAttributeMultiprocessorCount, dev);
        (void)hipFuncSetAttribute((const void*)mega_fwd, hipFuncAttributeMaxDynamicSharedMemorySize, LDS_BYTES);
        (void)hipOccupancyMaxActiveBlocksPerMultiprocessor(&per_cu, (const void*)mega_fwd, 512, LDS_BYTES);
        if (per_cu < 1) per_cu = 1;
        grid = cus * per_cu;
        (void)hipGetLastError();
        if (n_in != 27 || ws_size < WS_END) { fprintf(stderr, "kernel_launch: unexpected n_in %d / ws_size %zu\n", n_in, ws_size); }
    }
    Params p{};
    for (int i = 0; i < 27; ++i) p.in[i] = (const float*)d_in[i];
    p.out = (float*)d_out; p.ws = (unsigned char*)d_ws;
#if ONE_LAUNCH
    (void)hipMemsetAsync(d_ws, 0, 16384, stream);
    p.ph_lo = 0; p.ph_hi = NPHASE;
    void* args[] = {&p};
    hipError_t e = hipLaunchCooperativeKernel((const void*)mega_fwd, dim3(grid), dim3(512), args, LDS_BYTES, stream);
    if (e != hipSuccess) fprintf(stderr, "cooperative launch failed: %s (grid %d)\n", hipGetErrorString(e), grid);
#else
    for (int ph = 0; ph < NPHASE; ++ph) {
        p.ph_lo = ph; p.ph_hi = ph + 1;
        hipLaunchKernelGGL(mega_fwd, dim3(grid), dim3(512), LDS_BYTES, stream, p);
    }
#endif
}
```

```cpp
#include <hip/hip_runtime.h>
#include <hip/hip_cooperative_groups.h>
#include <cstdio>
#include <cstdint>
namespace cg = cooperative_groups;

#ifndef ONE_LAUNCH
#define ONE_LAUNCH 1


#endif

#define LAS __attribute__((address_space(3)))
typedef unsigned short bf16_t;
typedef short bf16x8 __attribute__((ext_vector_type(8)));
typedef float f32x4 __attribute__((ext_vector_type(4)));
typedef float f32x2 __attribute__((ext_vector_type(2)));
typedef unsigned u32x4 __attribute__((ext_vector_type(4)));
typedef unsigned u32x2 __attribute__((ext_vector_type(2)));
typedef __bf16 bf16x2_t __attribute__((ext_vector_type(2)));

__device__ __forceinline__ unsigned cvtpk(float lo, float hi) { f32x2 v = {lo, hi}; bf16x2_t b = __builtin_convertvector(v, bf16x2_t); return __builtin_bit_cast(unsigned, b); }
__device__ __forceinline__ float bf2f(unsigned short h) { return __uint_as_float(((unsigned)h) << 16); }
__device__ __forceinline__ float bflo(unsigned w) { return __uint_as_float(w << 16); }
__device__ __forceinline__ float bfhi(unsigned w) { return __uint_as_float(w & 0xffff0000u); }

constexpr int D = 1024, MP = 32768, MS = 512, M = MP + MS, SEQ = 2048, DSEQ = 16, PAST = 4096;
constexpr int KVS = PAST + DSEQ;
constexpr int NKV = MP + 32 * KVS;
constexpr int NAB = 3328;
constexpr int DFF = 2816;
constexpr float EPS = 1e-6f;
constexpr int NPOS = SEQ + DSEQ;

constexpr size_t O_Y = 0;
constexpr size_t O_GLA_P = (size_t)M * D;
constexpr size_t O_GLA_S = O_GLA_P + 16 * 4 * 64 * 128;
constexpr size_t O_RET_P = O_GLA_S + 32 * 4 * 64 * 128;
constexpr size_t O_RET_S = O_RET_P + 16 * 4 * 64 * 128;
constexpr size_t O_CKV = O_RET_S + 32 * 4 * 64 * 128;
constexpr size_t O_KR = O_CKV + (size_t)M * 512;
constexpr size_t O_CONV_P = O_KR + (size_t)M * 64;
constexpr size_t O_CONV_S = O_CONV_P + 2 * 16 * 2 * DFF;

constexpr size_t MiB = 1u << 20;
constexpr size_t WS_W_INAB = 1 * MiB;
constexpr size_t WS_W_OUTAB = 8 * MiB;
constexpr size_t WS_W_FFNIN = 10 * MiB;
constexpr size_t WS_W_FFNOUT = 32 * MiB;
constexpr size_t WS_W_INC = 43 * MiB;
constexpr size_t WS_W_UQ = 45 * MiB;
constexpr size_t WS_W_UK = 47 * MiB;
constexpr size_t WS_W_UV = 48 * MiB;
constexpr size_t WS_W_OUTC = 49 * MiB;
constexpr size_t WS_ROT = 51 * MiB;
constexpr size_t WS_SSP = 52 * MiB;
constexpr size_t WS_SSQ = 55 * MiB;
constexpr size_t WS_RS = 60 * MiB;
constexpr size_t WS_W_QL = 61 * MiB;
constexpr size_t WS_R = 64 * MiB;
constexpr size_t WS_P = WS_R;
constexpr size_t WS_MIX = WS_R + 212 * MiB;
constexpr int NBLK = MP / 64 + 32;
constexpr size_t WS_SIDEA = WS_R;
constexpr size_t WS_SIDEB = WS_R + 8 * MiB;
constexpr size_t WS_SIDEU = WS_R + 16 * MiB;
constexpr size_t WS_ACT = WS_R + 358 * MiB;
constexpr size_t WS_XB = WS_R + 540 * MiB;
constexpr size_t WS_CKVALL = WS_R;
constexpr size_t WS_AO = WS_R + 430 * MiB;
constexpr size_t WS_CQ = WS_R + 161 * MiB;
constexpr size_t WS_KRALL = WS_R + 186 * MiB;
constexpr size_t WS_Q = WS_R + 207 * MiB;
constexpr size_t WS_KN = WS_R + 305 * MiB;
constexpr size_t WS_VT = WS_R + 626 * MiB;
constexpr size_t WS_QL = WS_R + 370 * MiB;
constexpr size_t WS_PO = WS_R + 380 * MiB;
constexpr size_t WS_PM = WS_R + 420 * MiB;
constexpr size_t WS_PL = WS_R + 421 * MiB;
constexpr size_t WS_END = WS_R + 948 * MiB;
static_assert(WS_END <= 1024 * MiB, "ws map");

constexpr int LDS_BYTES = 147456;

__device__ __forceinline__ int kvtok(int row) { return row < MP ? row : MP + ((row - MP) >> 4) * KVS + PAST + ((row - MP) & 15); }
__device__ __forceinline__ int posidx(int row) { return row < MP ? (row & (SEQ - 1)) : SEQ + ((row - MP) & 15); }

namespace pg8 {
constexpr int BM = 256, BK = 64, HALF = 128, HTB = HALF * BK * 2, STAGE_BYTES = 8 * HTB, NXCD = 8, WGM = 4;
__host__ __device__ __forceinline__ int lds_byte(int r, int c) { const int st = (r >> 4) * 2 + (c >> 5), rr = r & 15, cc = c & 31, ob = rr * 64 + cc * 2; return st * 1024 + (ob ^ (((ob >> 9) & 1) << 5)); }
__host__ __device__ __forceinline__ void stage_rc(int b, int& R, int& C) { const int st = b / 1024, sb = b % 1024, swz = sb ^ (((sb >> 9) & 1) << 5); R = (st >> 1) * 16 + swz / 64; C = (st & 1) * 32 + (swz % 64) / 2; }
__host__ __device__ __forceinline__ int perm32(int rho) { const int n = rho >> 4, i = rho & 15; return 8 * (i >> 2) + 4 * n + (i & 3); }
struct Unit { int pm, pn; };
struct Gemm { const bf16_t* A; const bf16_t* Bt; int M, N, K; };
struct StaticOrder {
    int nM, nN, nwg, G, c, wgm;
    __host__ __device__ void init(int M_, int N_, int G_, int c_, int wgm_ = WGM) { nM = M_ / BM; nN = N_ / BM; nwg = nM * nN; G = G_; c = c_; wgm = wgm_; }
    __host__ __device__ bool next(int i, Unit& u) const {
        const long L = (long)i * G + c; if (L >= nwg) return false;
        int wgid = (int)L; { const int q = nwg / NXCD, r = nwg % NXCD, xcd = wgid % NXCD, off = wgid / NXCD; wgid = (xcd < r ? xcd * (q + 1) : r * (q + 1) + (xcd - r) * q) + off; }
        const int nig = wgm * nN, gid = wgid / nig, fm = gid * wgm, gsz = (nM - fm) < wgm ? (nM - fm) : wgm;
        u.pm = fm + ((wgid % nig) % gsz); u.pn = (wgid % nig) / gsz; return true;
    }
};
template <class Epi>
__device__ __forceinline__ void gemm_phase(LAS unsigned char* lds, const Gemm g, const StaticOrder& S, const Epi& E) {
    int tid_ = threadIdx.x; asm volatile("" : "+v"(tid_));
    const int tid = tid_, wid = __builtin_amdgcn_readfirstlane(tid >> 6), lane = tid & 63, wr = wid >> 2, wc = wid & 3, fr = lane & 15, fq = lane >> 4;
    const int K = g.K, nt = K / BK;
    unsigned voffA[2], voffB[2];
#pragma unroll
    for (int i = 0; i < 2; ++i) { int R, C; stage_rc(tid * 16 + i * 8192, R, C); const int Rb = Epi::PERM ? ((R & ~31) + perm32(R & 31)) : R;
        voffA[i] = (unsigned)(R * K + C) * 2u; voffB[i] = (unsigned)(Rb * K + C) * 2u; }
    const size_t kstep = (size_t)(BK * 2);
    const size_t hstep = (size_t)HALF * K * 2;
    const size_t tstep = 2 * hstep;
    const unsigned ldsw = (unsigned)wid * 1024u;
    const int aoff = lds_byte(wr * 64 + fr, fq * 8), boff = lds_byte(wc * 32 + fr, fq * 8);
#define PG8_SA(b, h) (((b) * 2 + (h)) * HTB)
#define PG8_SB(b, h) ((4 + (b) * 2 + (h)) * HTB)
#define PG8_STAGE(bufoff, gbase, voff) do { _Pragma("unroll") for (int _i = 0; _i < 2; ++_i) \
        __builtin_amdgcn_global_load_lds((const unsigned*)((const char*)(gbase) + (voff)[_i]), (LAS unsigned*)(lds + (bufoff) + ldsw + _i * 8192), 16, 0, 0); } while (0)
#define PG8_LDA(dst, b, h) do { _Pragma("unroll") for (int m = 0; m < 4; ++m) _Pragma("unroll") for (int k = 0; k < 2; ++k) dst[m][k] = *(const LAS bf16x8*)(lds + PG8_SA(b, h) + aoff + m * 2048 + k * 1024); } while (0)
#define PG8_LDB(dst, b, h) do { _Pragma("unroll") for (int n = 0; n < 2; ++n) _Pragma("unroll") for (int k = 0; k < 2; ++k) dst[n][k] = *(const LAS bf16x8*)(lds + PG8_SB(b, h) + boff + n * 2048 + k * 1024); } while (0)
#define PG8_MMA(ai, bj, At, Bt) do { __builtin_amdgcn_s_setprio(1); _Pragma("unroll") for (int m = 0; m < 4; ++m) _Pragma("unroll") for (int n = 0; n < 2; ++n) _Pragma("unroll") for (int k = 0; k < 2; ++k) \
        acc[ai][bj][m][n] = __builtin_amdgcn_mfma_f32_16x16x32_bf16(Bt[n][k], At[m][k], acc[ai][bj][m][n], 0, 0, 0); __builtin_amdgcn_s_setprio(0); } while (0)
#define PG8_WAIT_V(n) asm volatile("s_waitcnt vmcnt(" #n ")" ::: "memory")
#define PG8_WAIT_L(n) asm volatile("s_waitcnt lgkmcnt(" #n ")" ::: "memory")
#define PG8_BAR __builtin_amdgcn_s_barrier()
#define PG8_SCHED __builtin_amdgcn_sched_barrier(0)
    Unit cur, nxt; int ui = 0;
    if (!S.next(0, cur)) return;
    f32x4 acc[2][2][4][2];
#pragma unroll
    for (int a = 0; a < 2; ++a)
#pragma unroll
        for (int b = 0; b < 2; ++b)
#pragma unroll
            for (int m = 0; m < 4; ++m)
#pragma unroll
                for (int n = 0; n < 2; ++n) acc[a][b][m][n] = (f32x4){0.f, 0.f, 0.f, 0.f};
    bf16x8 At[4][2], B0[2][2], B1[2][2];
    const char* cA = (const char*)g.A + (size_t)cur.pm * tstep; const char* cB = (const char*)g.Bt + (size_t)cur.pn * tstep;
    PG8_STAGE(PG8_SB(0, 0), cB, voffB); PG8_STAGE(PG8_SB(0, 1), cB + hstep, voffB); PG8_STAGE(PG8_SA(0, 0), cA, voffA); PG8_STAGE(PG8_SA(0, 1), cA + hstep, voffA);
    if (wr == 1) PG8_BAR;
    PG8_WAIT_V(2); PG8_BAR;
    PG8_STAGE(PG8_SB(1, 0), cB + kstep, voffB); PG8_STAGE(PG8_SA(1, 0), cA + kstep, voffA); PG8_STAGE(PG8_SB(1, 1), cB + hstep + kstep, voffB);
    PG8_WAIT_V(6); PG8_BAR;
    for (;;) {
        const bool has_next = S.next(ui + 1, nxt);
        const char* nA = has_next ? (const char*)g.A + (size_t)nxt.pm * tstep : cA; const char* nB = has_next ? (const char*)g.Bt + (size_t)nxt.pn * tstep : cB;
        for (int t = 0; t < nt; t += 2) {
            const bool last = (t == nt - 2);
            const char* a1 = cA + (size_t)(t + 1) * kstep;
            const char* a2 = last ? nA : cA + (size_t)(t + 2) * kstep; const char* b2 = last ? nB : cB + (size_t)(t + 2) * kstep;
            const char* a3 = a2 + kstep; const char* b3 = b2 + kstep;
            PG8_LDB(B0, 0, 0); PG8_LDB(B1, 0, 1); PG8_SCHED; PG8_LDA(At, 0, 0); PG8_STAGE(PG8_SA(1, 1), a1 + hstep, voffA);
            PG8_WAIT_V(8); PG8_WAIT_L(0); PG8_BAR; PG8_MMA(0, 0, At, B0); PG8_MMA(0, 1, At, B1); PG8_BAR; PG8_SCHED;
            PG8_LDA(At, 0, 1); PG8_STAGE(PG8_SB(0, 0), b2, voffB); PG8_STAGE(PG8_SB(0, 1), b2 + hstep, voffB); PG8_STAGE(PG8_SA(0, 0), a2, voffA);
            PG8_WAIT_V(8); PG8_WAIT_L(0); PG8_BAR; PG8_MMA(1, 0, At, B0); PG8_MMA(1, 1, At, B1); PG8_BAR; PG8_SCHED;
            PG8_LDB(B0, 1, 0); PG8_LDB(B1, 1, 1); PG8_SCHED; PG8_LDA(At, 1, 0); PG8_STAGE(PG8_SA(0, 1), a2 + hstep, voffA);
            PG8_WAIT_V(8); PG8_WAIT_L(0); PG8_BAR; PG8_MMA(0, 0, At, B0); PG8_MMA(0, 1, At, B1); PG8_BAR; PG8_SCHED;
            PG8_LDA(At, 1, 1); PG8_STAGE(PG8_SB(1, 0), b3, voffB); PG8_STAGE(PG8_SB(1, 1), b3 + hstep, voffB); PG8_STAGE(PG8_SA(1, 0), a3, voffA);
            PG8_WAIT_V(8); PG8_WAIT_L(0); PG8_BAR; PG8_MMA(1, 0, At, B0); PG8_MMA(1, 1, At, B1); PG8_BAR; PG8_SCHED;
        }
        if (wr == 0) PG8_BAR;
        E(acc, cur, wr, wc, fr, fq);
        if (!has_next) break;
#pragma unroll
        for (int a = 0; a < 2; ++a)
#pragma unroll
            for (int b = 0; b < 2; ++b)
#pragma unroll
                for (int m = 0; m < 4; ++m)
#pragma unroll
                    for (int n = 0; n < 2; ++n) acc[a][b][m][n] = (f32x4){0.f, 0.f, 0.f, 0.f};
        cur = nxt; cA = nA; cB = nB; ++ui;
        if (wr == 1) PG8_BAR;
    }
    PG8_WAIT_V(0);
    PG8_BAR;
#undef PG8_SA
#undef PG8_SB
#undef PG8_STAGE
#undef PG8_LDA
#undef PG8_LDB
#undef PG8_MMA
#undef PG8_WAIT_V
#undef PG8_WAIT_L
#undef PG8_BAR
#undef PG8_SCHED
}
}

struct Params { const float* in[27]; float* out; unsigned char* ws; int ph_lo, ph_hi; };
enum { I_XP = 0, I_XS, I_SGLA, I_SRET, I_CCKV, I_CKR, I_SCONV, I_NMIX, I_NFFN, I_NFIN, I_WINAB, I_WGU, I_BG, I_GGLA, I_GRET, I_WOUTAB, I_WINC, I_GQ, I_GKV, I_WUQ, I_WUK, I_WUV, I_WOUTC, I_WFFNIN, I_WDW, I_BDW, I_WFFNOUT };

__device__ __forceinline__ float sum4(f32x4 a) { return (a.x + a.y) + (a.z + a.w); }
__device__ __forceinline__ float rstd_from16(const float* ssp, int row) {
    const f32x4* p = (const f32x4*)(ssp + (size_t)row * 16);
    const f32x4 a = p[0], b = p[1], c = p[2], d = p[3];
    const float s = (sum4(a) + sum4(b)) + (sum4(c) + sum4(d));
    return rsqrtf(s * (1.0f / 1024.0f) + EPS);
}
__device__ __forceinline__ f32x4 rope4(f32x4 v, f32x4 cs) { f32x4 r; r.x = v.x * cs.x - v.y * cs.y; r.y = v.x * cs.y + v.y * cs.x; r.z = v.z * cs.z - v.w * cs.w; r.w = v.z * cs.w + v.w * cs.z; return r; }
__device__ __forceinline__ float logsig(float x) { return fminf(x, 0.f) - log1pf(__expf(-fabsf(x))); }

struct EpiBf {
    static constexpr bool PERM = true;
    const Params* pp; int job;
    __device__ __forceinline__ void operator()(const f32x4 (&acc)[2][2][4][2], const pg8::Unit& u, int wr, int wc, int fr, int fq) const {
        const Params* q_ = pp; asm volatile("" : "+s"(q_));
        unsigned char* ws = q_->ws;
        const int MODE = job == 1 ? 2 : (job == 90 || job == 93 || job == 94) ? 3 : 0;
        bf16_t* O = (bf16_t*)(ws + (job == 1 ? WS_P : (job == 90 || job == 94) ? WS_Q : job == 91 ? WS_KN : job == 93 ? WS_QL : WS_VT)) + (job == 94 ? (size_t)MP * 1536 : 0);
        const int ldc = job == 1 ? NAB : (job == 90 || job == 94) ? 1536 : job == 91 ? 1024 : job == 93 ? 4096 : NKV;
        const int rowoff = (job == 93 || job == 94) ? MP : 0;
        const float* ssp = (const float*)(ws + ((job == 90 || job == 93 || job == 94) ? WS_SSQ : WS_SSP));
        const float* rot = (const float*)(ws + WS_ROT);
        const float* bgate = q_->in[I_BG];
        const int row0 = u.pm * 256 + wr * 64 + fr, col0 = u.pn * 256 + wc * 32 + 8 * fq;
        float rsv[2][4];
#pragma unroll
        for (int ai = 0; ai < 2; ++ai) {
#pragma unroll
            for (int m = 0; m < 4; ++m) {
                const int row = row0 + ai * 128 + m * 16;
                float r_ = 1.f;
                if (MODE == 1 || MODE == 2) r_ = rstd_from16(ssp, row);
                if (MODE == 3) { const f32x4* p = (const f32x4*)(ssp + (size_t)(row + rowoff) * 32); const float s = sum4(p[0]) + sum4(p[1]) + sum4(p[2]); r_ = rsqrtf(s * (1.0f / 384.0f) + EPS); }
                rsv[ai][m] = r_;
                if (m & 1) asm volatile("" ::: "memory");
            }
        }
#pragma unroll
        for (int ai = 0; ai < 2; ++ai)
#pragma unroll
            for (int m = 0; m < 4; ++m) {
                const int row = row0 + ai * 128 + m * 16;
                const float rs = rsv[ai][m];
#pragma unroll
                for (int bj = 0; bj < 2; ++bj) {
                    const int col = col0 + bj * 128;
                    f32x4 v0 = acc[ai][bj][m][0] * rs, v1 = acc[ai][bj][m][1] * rs;
                    bool dorope = false; int i0 = 0;
                    if (MODE == 2) { if (u.pn == 6 || u.pn == 7) { dorope = true; i0 = (col & 63) >> 1; } }
                    if (MODE == 3 && job != 93) { const int within = col % 192; if (within >= 128) { dorope = true; i0 = (within - 128) >> 1; } }
                    if (dorope) {
                        const f32x4* cs = (const f32x4*)(rot + ((size_t)posidx(row + rowoff) * 32 + i0) * 2);
                        const f32x4 c0 = cs[0], c1 = cs[1];
                        v0 = rope4(v0, c0);
                        v1 = rope4(v1, c1);
                    }
                    if (MODE == 2) { if (u.pn == 12) {
                        const f32x4 b0 = *(const f32x4*)(bgate + (col - 3072)), b1 = *(const f32x4*)(bgate + (col - 3072) + 4);
                        v0.x = logsig(v0.x + b0.x) * 0.0625f; v0.y = logsig(v0.y + b0.y) * 0.0625f; v0.z = logsig(v0.z + b0.z) * 0.0625f; v0.w = logsig(v0.w + b0.w) * 0.0625f;
                        v1.x = logsig(v1.x + b1.x) * 0.0625f; v1.y = logsig(v1.y + b1.y) * 0.0625f; v1.z = logsig(v1.z + b1.z) * 0.0625f; v1.w = logsig(v1.w + b1.w) * 0.0625f;
                    } }
                    u32x4 w; w.x = cvtpk(v0.x, v0.y); w.y = cvtpk(v0.z, v0.w); w.z = cvtpk(v1.x, v1.y); w.w = cvtpk(v1.z, v1.w);
                    *(u32x4*)(O + (size_t)row * ldc + col) = w;
                }
            }
    }
};

struct EpiRes {
    static constexpr bool PERM = false;
    const Params* pp; int job;
    __device__ __forceinline__ void operator()(const f32x4 (&acc)[2][2][4][2], const pg8::Unit& u, int wr, int wc, int fr, int fq) const {
        const Params* q_ = pp; asm volatile("" : "+s"(q_));
        bf16_t* XB = (bf16_t*)(q_->ws + WS_XB); float* ssp = (float*)(q_->ws + WS_SSP);
        const int row0 = u.pm * 256 + wr * 64 + fr, col0 = u.pn * 256 + wc * 32 + 4 * fq;
#pragma unroll
        for (int ai = 0; ai < 2; ++ai)
#pragma unroll
            for (int m = 0; m < 4; ++m) {
                const int row = row0 + ai * 128 + m * 16;
                float ss = 0.f;
#pragma unroll
                for (int bj = 0; bj < 2; ++bj)
#pragma unroll
                    for (int n = 0; n < 2; ++n) {
                        const int col = col0 + bj * 128 + n * 16;
                        const u32x2 rb = *(const u32x2*)(XB + (size_t)row * D + col);
                        const f32x4 r = (f32x4){bflo(rb.x), bfhi(rb.x), bflo(rb.y), bfhi(rb.y)};
                        const f32x4 x = r + acc[ai][bj][m][n];
                        { u32x2 w; w.x = cvtpk(x.x, x.y); w.y = cvtpk(x.z, x.w); *(u32x2*)(XB + (size_t)row * D + col) = w; }
                        ss += (x.x * x.x + x.y * x.y) + (x.z * x.z + x.w * x.w);
                    }
                ss += __shfl_xor(ss, 16); ss += __shfl_xor(ss, 32);
                if (fq == 0) ssp[(size_t)row * 16 + u.pn * 4 + wc] = ss;
                if (m & 1) asm volatile("" ::: "memory");
            }
    }
};

struct EpiInC {
    static constexpr bool PERM = false;
    const Params* pp;
    __device__ __forceinline__ void operator()(const f32x4 (&acc)[2][2][4][2], const pg8::Unit& u, int wr, int wc, int fr, int fq) const {
        const Params* q_ = pp; asm volatile("" : "+s"(q_));
        unsigned char* ws = q_->ws;
        const float* ssp = (const float*)(ws + WS_SSP); const float* rot = (const float*)(ws + WS_ROT); bf16_t* CQ = (bf16_t*)(ws + WS_CQ);
        bf16_t* CKVALL = (bf16_t*)(ws + WS_CKVALL); float* krout = q_->out + O_KR; bf16_t* KRALL = (bf16_t*)(ws + WS_KRALL); float* ssq = (float*)(ws + WS_SSQ);
        const int row0 = u.pm * 256 + wr * 64 + fr, col0 = u.pn * 256 + wc * 32 + 4 * fq;

#pragma unroll
        for (int ai = 0; ai < 2; ++ai)
#pragma unroll
            for (int m = 0; m < 4; ++m) {
                const int row = row0 + ai * 128 + m * 16;
                const float rs = rstd_from16(ssp, row);
#pragma unroll
                for (int bj = 0; bj < 2; ++bj) {
                    const int blk = u.pn * 2 + bj;
                    float ss = 0.f;
#pragma unroll
                    for (int n = 0; n < 2; ++n) {
                        const int col = col0 + bj * 128 + n * 16;
                        f32x4 v = acc[ai][bj][m][n] * rs;
                        if (blk < 3) {
                            u32x2 w; w.x = cvtpk(v.x, v.y); w.y = cvtpk(v.z, v.w);
                            *(u32x2*)(CQ + (size_t)row * 384 + col) = w;
                        } else if (blk < 7) {
                            u32x2 w; w.x = cvtpk(v.x, v.y); w.y = cvtpk(v.z, v.w);
                            *(u32x2*)(CKVALL + (size_t)kvtok(row) * 512 + (col - 384)) = w;
                        } else if (col < 960) {
                            const int j = col - 896, i0 = j >> 1;
                            const f32x4 cs = *(const f32x4*)(rot + ((size_t)posidx(row) * 32 + i0) * 2);
                            v = rope4(v, cs);
                            float* ko = krout + (size_t)row * 64;
                            ko[i0] = v.x; ko[32 + i0] = v.y; ko[i0 + 1] = v.z; ko[33 + i0] = v.w;
                            u32x2 w; w.x = cvtpk(v.x, v.y); w.y = cvtpk(v.z, v.w);
                            *(u32x2*)(KRALL + (size_t)kvtok(row) * 64 + j) = w;
                        }
                        ss += (v.x * v.x + v.y * v.y) + (v.z * v.z + v.w * v.w);
                    }
                    ss += __shfl_xor(ss, 16); ss += __shfl_xor(ss, 32);
                    if (fq == 0) ssq[(size_t)row * 32 + blk * 4 + wc] = ss;
                }
                asm volatile("" ::: "memory");
            }
    }
};

__device__ __forceinline__ f32x2 gelu_pk(f32x2 v) {
    const f32x2 av = __builtin_elementwise_abs(v), d = av * 0.2316418882f + 1.0f;
    f32x2 t; t.x = __builtin_amdgcn_rcpf(d.x); t.y = __builtin_amdgcn_rcpf(d.y);
    f32x2 q = t * 0.5307027145f + (-0.7265760135f); q = q * t + 0.7107068705f; q = q * t + (-0.142248368f); q = q * t + 0.127414796f; q = q * t;
    const f32x2 sx = (v * v) * (-0.72134752044f);
    f32x2 e; e.x = __builtin_amdgcn_exp2f(sx.x); e.y = __builtin_amdgcn_exp2f(sx.y);
    const f32x2 m = v * (q * e), r = v - m;
    f32x2 o; o.x = v.x < 0.f ? m.x : r.x; o.y = v.y < 0.f ? m.y : r.y; return o;
}
__device__ __forceinline__ void attn_sample_unit(const Params& p, LAS unsigned char* lds, int b, int h) {
    int tid_ = threadIdx.x; asm volatile("" : "+v"(tid_));
    const int tid = tid_, lane = tid & 63, w = tid >> 6, fr = lane & 15, fq = lane >> 4;
    const bf16_t* Q = (const bf16_t*)(p.ws + WS_Q); const bf16_t* KN = (const bf16_t*)(p.ws + WS_KN);
    const bf16_t* KRA = (const bf16_t*)(p.ws + WS_KRALL); const bf16_t* VT = (const bf16_t*)(p.ws + WS_VT);
    bf16_t* AO = (bf16_t*)(p.ws + WS_AO);
    const int qrow0 = MP + b * DSEQ, kv0 = MP + b * KVS;
    bf16x8 qf[6];
#pragma unroll
    for (int ks = 0; ks < 6; ++ks) qf[ks] = *(const bf16x8*)(Q + (size_t)(qrow0 + fr) * 1536 + h * 192 + ks * 32 + fq * 8);
    f32x4 oacc[8];
#pragma unroll
    for (int dt = 0; dt < 8; ++dt) oacc[dt] = (f32x4){0.f, 0.f, 0.f, 0.f};
    float mrun = -1e30f, lrun = 0.f;
    constexpr int NSTEP = (KVS + 31) / 32;
    bf16x8 kf[2][6];
#define SMP_KLOAD(ss) do { const int kb_ = (ss) * 32; \
        _Pragma("unroll") for (int e = 0; e < 2; ++e) { const size_t tok = (size_t)(kv0 + kb_ + e * 16 + fr); \
            _Pragma("unroll") for (int ks = 0; ks < 4; ++ks) kf[e][ks] = *(const bf16x8*)(KN + tok * 1024 + h * 128 + ks * 32 + fq * 8); \
            _Pragma("unroll") for (int ks = 4; ks < 6; ++ks) kf[e][ks] = *(const bf16x8*)(KRA + tok * 64 + (ks - 4) * 32 + fq * 8); } } while (0)
    if (w < NSTEP) SMP_KLOAD(w);
    for (int st = w; st < NSTEP; st += 8) {
        const int kb = st * 32;
        u32x2 va0[8], va1[8];
#pragma unroll
        for (int dt = 0; dt < 8; ++dt) { const bf16_t* vp = VT + (size_t)(h * 128 + dt * 16 + fr) * NKV + kv0 + kb + fq * 4;
            va0[dt] = *(const u32x2*)vp; va1[dt] = *(const u32x2*)(vp + 16); }
        f32x4 s0 = (f32x4){0.f, 0.f, 0.f, 0.f}, s1 = (f32x4){0.f, 0.f, 0.f, 0.f};
#pragma unroll
        for (int ks = 0; ks < 6; ++ks) { s0 = __builtin_amdgcn_mfma_f32_16x16x32_bf16(kf[0][ks], qf[ks], s0, 0, 0, 0); s1 = __builtin_amdgcn_mfma_f32_16x16x32_bf16(kf[1][ks], qf[ks], s1, 0, 0, 0); }
        if (st + 8 < NSTEP) SMP_KLOAD(st + 8);
        if (kb + 32 > KVS) {
#pragma unroll
            for (int j = 0; j < 4; ++j) { if (kb + fq * 4 + j >= KVS) s0[j] = -1e30f; if (kb + 16 + fq * 4 + j >= KVS) s1[j] = -1e30f; }
        }
        float mx = fmaxf(fmaxf(fmaxf(s0[0], s0[1]), fmaxf(s0[2], s0[3])), fmaxf(fmaxf(s1[0], s1[1]), fmaxf(s1[2], s1[3])));
        mx = fmaxf(mx, __shfl_xor(mx, 16)); mx = fmaxf(mx, __shfl_xor(mx, 32));
        const float mnew = fmaxf(mrun, mx), alpha = __builtin_amdgcn_exp2f(mrun - mnew);
        mrun = mnew;
        float ps = 0.f;
#pragma unroll
        for (int j = 0; j < 4; ++j) { s0[j] = __builtin_amdgcn_exp2f(s0[j] - mnew); s1[j] = __builtin_amdgcn_exp2f(s1[j] - mnew); ps += s0[j] + s1[j]; }
        lrun = lrun * alpha + ps;
        u32x4 wv; wv.x = cvtpk(s0[0], s0[1]); wv.y = cvtpk(s0[2], s0[3]); wv.z = cvtpk(s1[0], s1[1]); wv.w = cvtpk(s1[2], s1[3]);
        const bf16x8 pf = __builtin_bit_cast(bf16x8, wv);
#pragma unroll
        for (int dt = 0; dt < 8; ++dt) {
            const bf16x8 vf = __builtin_bit_cast(bf16x8, (u32x4){va0[dt].x, va0[dt].y, va1[dt].x, va1[dt].y});
            oacc[dt] = __builtin_amdgcn_mfma_f32_16x16x32_bf16(vf, pf, oacc[dt] * alpha, 0, 0, 0);
        }
    }
#undef SMP_KLOAD
    { float l = lrun; l += __shfl_xor(l, 16); l += __shfl_xor(l, 32);
      LAS float* OW = (LAS float*)(lds + w * 8192); LAS float* ML = (LAS float*)(lds + 65536 + w * 128);
#pragma unroll
      for (int dt = 0; dt < 8; ++dt)
#pragma unroll
          for (int j = 0; j < 4; ++j) OW[(dt * 16 + fq * 4 + j) * 16 + fr] = oacc[dt][j];
      if (fq == 0) { ML[fr] = mrun; ML[16 + fr] = l; } }
    __syncthreads();
    { const int q = tid & 15, dc = tid >> 4;
      float mw[8], M_ = -1e30f;
#pragma unroll
      for (int ww = 0; ww < 8; ++ww) { mw[ww] = ((LAS float*)(lds + 65536 + ww * 128))[q]; M_ = fmaxf(M_, mw[ww]); }
      float L_ = 0.f, o[4] = {0.f, 0.f, 0.f, 0.f};
#pragma unroll
      for (int ww = 0; ww < 8; ++ww) { const float sc = __builtin_amdgcn_exp2f(mw[ww] - M_); L_ += sc * ((LAS float*)(lds + 65536 + ww * 128))[16 + q];
          const LAS float* OW = (LAS float*)(lds + ww * 8192);
#pragma unroll
          for (int i = 0; i < 4; ++i) o[i] += sc * OW[(dc * 4 + i) * 16 + q]; }
      const float inv = 1.f / L_;
      u32x2 wv; wv.x = cvtpk(o[0] * inv, o[1] * inv); wv.y = cvtpk(o[2] * inv, o[3] * inv);
      *(u32x2*)(AO + (size_t)(qrow0 + q) * D + h * 128 + dc * 4) = wv; }
    __syncthreads();
}

struct EpiFfn {
    static constexpr bool PERM = true;
    const Params* pp; int layer;
    __device__ __forceinline__ void operator()(f32x4 (&acc)[2][2][4][2], const pg8::Unit& u, int wr_, int wc_, int fr_, int fq_) const {
        const Params* q_ = pp; asm volatile("" : "+s"(q_));
        int wr = wr_, wc = wc_, fr = fr_, fq = fq_;
        asm volatile("" : "+s"(wr), "+s"(wc), "+v"(fr), "+v"(fq));
        unsigned char* ws = q_->ws;
        const float* rsp = (const float*)(ws + WS_RS);
        const int row0 = u.pm * 256 + wr * 64 + fr;
#pragma unroll
        for (int ai = 0; ai < 2; ++ai)
#pragma unroll
            for (int m = 0; m < 4; ++m) {
                const float rs = rsp[row0 + ai * 128 + m * 16];
#pragma unroll
                for (int bj = 0; bj < 2; ++bj)
#pragma unroll
                    for (int n = 0; n < 2; ++n) acc[ai][bj][m][n] *= rs;
                if (m & 1) asm volatile("" ::: "memory");
            }
        bf16_t* ACT = (bf16_t*)(ws + WS_ACT); bf16_t* SA = (bf16_t*)(ws + WS_SIDEA); bf16_t* SB = (bf16_t*)(ws + WS_SIDEB); bf16_t* SU = (bf16_t*)(ws + WS_SIDEU);
        const float* wd = q_->in[I_WDW] + (size_t)layer * 3 * DFF; const float* bd = q_->in[I_BDW] + (size_t)layer * DFF;
        const int lane = fq * 16 + fr, src1 = (lane & 48) | ((fr + 15) & 15), src2 = (lane & 48) | ((fr + 14) & 15);
        const bool smp = u.pm * 256 >= MP;
#pragma unroll
        for (int n = 0; n < 2; ++n) {
            asm volatile("" ::: "memory");
            int col = u.pn * 128 + wc * 32 + 8 * fq + 4 * n;
            asm volatile("" : "+v"(col));
            const f32x4 w0 = *(const f32x4*)(wd + col), w1 = *(const f32x4*)(wd + DFF + col), w2 = *(const f32x4*)(wd + 2 * DFF + col), bi = *(const f32x4*)(bd + col);
#pragma unroll
            for (int ai = 0; ai < 2; ++ai) {
                f32x4 pr1 = (f32x4){0.f, 0.f, 0.f, 0.f}, pr2 = pr1;
#pragma unroll
                for (int m = 0; m < 4; ++m) {
                    int row = row0 + ai * 128 + m * 16;
                    asm volatile("" : "+v"(row));
                    const f32x4 a = acc[ai][0][m][n], uu = acc[ai][1][m][n];
                    f32x4 r1, r2;
#pragma unroll
                    for (int e = 0; e < 4; ++e) { r1[e] = __shfl(a[e], src1); r2[e] = __shfl(a[e], src2); }
                    const f32x4 p1 = fr >= 1 ? r1 : pr1, p2 = fr >= 2 ? r2 : pr2;
                    const bool deferred = smp ? (fr < 2) : (m == 0 && fr < 2);
                    const int blk = smp ? (MP / 64 + ((row - MP) >> 4)) : (row >> 6);
                    if (!deferred) {
                        const f32x4 cv = bi + p2 * w0 + p1 * w1 + a * w2;
                        const f32x2 g0 = gelu_pk((f32x2){cv.x, cv.y}), g1 = gelu_pk((f32x2){cv.z, cv.w});
                        u32x2 o; o.x = cvtpk(g0.x * uu.x, g0.y * uu.y); o.y = cvtpk(g1.x * uu.z, g1.y * uu.w);
                        *(u32x2*)(ACT + (size_t)row * DFF + col) = o;
                    } else {
                        u32x2 oa, ou; oa.x = cvtpk(a.x, a.y); oa.y = cvtpk(a.z, a.w); ou.x = cvtpk(uu.x, uu.y); ou.y = cvtpk(uu.z, uu.w);
                        *(u32x2*)(SB + ((size_t)blk * 2 + fr) * DFF + col) = oa; *(u32x2*)(SU + ((size_t)blk * 2 + fr) * DFF + col) = ou;
                    }
                    if (fr >= 14 && (smp || m == 3)) { u32x2 oa; oa.x = cvtpk(a.x, a.y); oa.y = cvtpk(a.z, a.w); *(u32x2*)(SA + ((size_t)blk * 2 + (fr - 14)) * DFF + col) = oa; }
                    pr1 = r1; pr2 = r2;
                    __builtin_amdgcn_sched_barrier(0);
                }
            }
        }
    }
};

template <class F> __device__ __forceinline__ void tr_item(const F& f, int K, bf16_t* WT, int item, int nblk, LAS float* scr, int lane) {
    const int kb = item / nblk, nb = item % nblk, k0 = 64 * kb, n0 = 32 * nb;
#pragma unroll 4
    for (int i = 0; i < 32; ++i) { const int kk = 2 * i + (lane >> 5); scr[kk * 33 + (lane & 31)] = f(k0 + kk, n0 + (lane & 31)); }
    asm volatile("s_waitcnt lgkmcnt(0)" ::: "memory");
    const int c = lane & 7;
#pragma unroll
    for (int j = 0; j < 4; ++j) { const int n = (lane >> 3) + 8 * j; const LAS float* s = scr + (8 * c) * 33 + n;
        u32x4 o; o.x = cvtpk(s[0 * 33], s[1 * 33]); o.y = cvtpk(s[2 * 33], s[3 * 33]); o.z = cvtpk(s[4 * 33], s[5 * 33]); o.w = cvtpk(s[6 * 33], s[7 * 33]);
        *(u32x4*)(WT + (size_t)(n0 + n) * K + k0 + 8 * c) = o; }
    asm volatile("s_waitcnt lgkmcnt(0)" ::: "memory");
}
template <bool FFNPERM = false>
__device__ __forceinline__ void tr_item_plain(const float* W, int ldw, const float* g, int K, bf16_t* WT, int item, int nblk, LAS float* scr, int lane) {
    const int kb = item / nblk, nb = item % nblk, k0 = 64 * kb, n0 = 32 * nb;
    const int c4 = (lane & 7) * 4, kr = lane >> 3;
    const int ns = FFNPERM ? (((n0 & 255) >> 7) * DFF + (n0 >> 8) * 128 + (n0 & 127)) : n0;
#pragma unroll
    for (int i = 0; i < 8; ++i) { const int kk = i * 8 + kr; f32x4 v = __builtin_nontemporal_load((const f32x4*)(W + (size_t)(k0 + kk) * ldw + ns + c4));
        if (g) v = v * g[k0 + kk];
        scr[kk * 33 + c4] = v.x; scr[kk * 33 + c4 + 1] = v.y; scr[kk * 33 + c4 + 2] = v.z; scr[kk * 33 + c4 + 3] = v.w; }
    asm volatile("s_waitcnt lgkmcnt(0)" ::: "memory");
    const int c = lane & 7;
#pragma unroll
    for (int j = 0; j < 4; ++j) { const int n = (lane >> 3) + 8 * j; const LAS float* s = scr + (8 * c) * 33 + n;
        u32x4 o; o.x = cvtpk(s[0 * 33], s[1 * 33]); o.y = cvtpk(s[2 * 33], s[3 * 33]); o.z = cvtpk(s[4 * 33], s[5 * 33]); o.w = cvtpk(s[6 * 33], s[7 * 33]);
        *(u32x4*)(WT + (size_t)(n0 + n) * K + k0 + 8 * c) = o; }
    asm volatile("s_waitcnt lgkmcnt(0)" ::: "memory");
}
struct FPlain { const float* W; int ldw; const float* g; float sc;
    __device__ __forceinline__ float operator()(int k, int n) const { float v = W[(size_t)k * ldw + n] * sc; if (g) v *= g[k]; return v; } };
struct FInAB { const float* W; const float* g; const float* wgu;
    __device__ __forceinline__ float operator()(int k, int n) const {
        const float* wr = W + (size_t)k * 3088; float v;
        if (n < 1536) { v = wr[n]; if (n < 256) v *= 0.125f; }
        else if (n < 2048) { const int q = n - 1536, isk = q >> 8, r = q & 255, h = r >> 6, j = r & 63, i = j >> 1, hf = j & 1;
            v = wr[(isk ? 1808 : 1552) + h * 64 + hf * 32 + i]; if (isk) v *= 0.125f; }
        else if (n < 3072) { v = wr[n + 16]; }
        else { const int c = n - 3072; float s = 0.f;
#pragma unroll
            for (int r = 0; r < 16; ++r) s += wr[1536 + r] * wgu[r * 256 + c];
            v = s; }
        return v * g[k];
    } };
struct FInC { const float* W; const float* g;
    __device__ __forceinline__ float operator()(int k, int n) const {
        const float* wr = W + (size_t)k * 960; float v;
        if (n < 896) v = wr[n];
        else if (n < 960) { const int j = n - 896; v = wr[896 + (j & 1) * 32 + (j >> 1)]; }
        else v = 0.f;
        return v * g[k];
    } };
struct FUq { const float* W; const float* g; float sc;
    __device__ __forceinline__ float operator()(int k, int n) const {
        const int h = n / 192, j = n % 192; int src = n;
        if (j >= 128) { const int jj = j - 128; src = h * 192 + 128 + (jj & 1) * 32 + (jj >> 1); }
        return W[(size_t)k * 1536 + src] * g[k] * sc;
    } };

struct FQl { const float* wuq; const float* wuk; const float* g; float sc;
    __device__ __forceinline__ float operator()(int k, int n) const {
        const int h = n >> 9, l = n & 511; const float* a = wuq + (size_t)k * 1536 + h * 192; const float* b = wuk + ((size_t)l * 8 + h) * 128;
        float s0 = 0.f, s1 = 0.f;
#pragma unroll 8
        for (int q = 0; q < 128; q += 2) { s0 += a[q] * b[q]; s1 += a[q + 1] * b[q + 1]; }
        return (s0 + s1) * g[k] * sc;
    } };

__device__ __forceinline__ bf16x8 cvt8(const float* p) { const f32x4 a = *(const f32x4*)p, b = *(const f32x4*)(p + 4); u32x4 w; w.x = cvtpk(a.x, a.y); w.y = cvtpk(a.z, a.w); w.z = cvtpk(b.x, b.y); w.w = cvtpk(b.z, b.w); return __builtin_bit_cast(bf16x8, w); }
__device__ __forceinline__ void fold_wql(const Params& p, int vb, int nvb) {
    int tid_ = threadIdx.x; asm volatile("" : "+v"(tid_));
    const int lane = tid_ & 63, wave = tid_ >> 6, fr = lane & 15, fq = lane >> 4;
    const float* wuq = p.in[I_WUQ]; const float* wuk = p.in[I_WUK]; const float* g = p.in[I_GQ];
    bf16_t* WQL = (bf16_t*)(p.ws + WS_W_QL);
    const float sc = 0.07216878364870322f * 1.4426950408889634f;
    for (int it = vb * 8 + wave; it < 8 * 32 * 24; it += nvb * 8) {
        const int h = it / (32 * 24), lt = (it / 24) % 32, kt = it % 24;
        const float* ap = wuk + ((size_t)(lt * 16 + fr) * 8 + h) * 128 + fq * 8;
        const float* bp = wuq + (size_t)(kt * 16 + fr) * 1536 + h * 192 + fq * 8;
        f32x4 acc = (f32x4){0.f, 0.f, 0.f, 0.f};
#pragma unroll
        for (int ks = 0; ks < 4; ++ks) acc = __builtin_amdgcn_mfma_f32_16x16x32_bf16(cvt8(ap + ks * 32), cvt8(bp + ks * 32), acc, 0, 0, 0);
        const int kk = kt * 16 + fr; const float gs = g[kk] * sc;
#pragma unroll
        for (int j = 0; j < 4; ++j) WQL[(size_t)(h * 512 + lt * 16 + fq * 4 + j) * 384 + kk] = (bf16_t)(cvtpk(acc[j] * gs, 0.f) & 0xffff);
    }
}

__device__ __forceinline__ float wave_sum(float v) {
#pragma unroll
    for (int o = 1; o < 64; o <<= 1) v += __shfl_xor(v, o);
    return v;
}

__device__ __forceinline__ void phase_prologue(const Params& p, LAS unsigned char* lds, int which, int vb, int nvb) {
    int tid_ = threadIdx.x; asm volatile("" : "+v"(tid_));
    const int tid = tid_, lane = tid & 63, wave = tid >> 6;
    const int gw = vb * 8 + wave, NGW = nvb * 8;
    LAS float* scr = (LAS float*)(lds + wave * 16384);
    unsigned char* ws = p.ws;
    constexpr int I1 = 16 * (NAB / 32), I2 = 16 * 32, I3 = 16 * (5632 / 32), I4 = 44 * 32, I5 = 16 * 32, I6 = 6 * 48, I7 = 8 * 32, I8 = 8 * 32, I9 = 16 * 32;
    constexpr int NIT = I1 + I2 + 2 * I3 + 2 * I4 + I5 + I6 + I7 + I8 + I9;
    for (int it = gw; it < NIT; it += NGW) {
        int r = it;
        { int cls = it < I1 ? 0 : 1;
          const int r3 = it - (I1 + I2); if (r3 >= I3 && r3 < 2 * I3) cls = 2;
          const int r4 = r3 - 2 * I3; if (r4 >= I4 && r4 < 2 * I4) cls = 2;
          if (!((which >> cls) & 1)) continue; }
        if (r < I1) { FInAB f{p.in[I_WINAB], p.in[I_NMIX], p.in[I_WGU]}; tr_item(f, 1024, (bf16_t*)(ws + WS_W_INAB), r, NAB / 32, scr, lane); continue; } r -= I1;
        if (r < I2) { tr_item_plain(p.in[I_WOUTAB], 1024, nullptr, 1024, (bf16_t*)(ws + WS_W_OUTAB), r, 32, scr, lane); continue; } r -= I2;
        if (r < 2 * I3) { const int l = r / I3; r -= l * I3; tr_item_plain<true>(p.in[I_WFFNIN] + (size_t)l * 1024 * 5632, 5632, p.in[I_NFFN] + l * 1024, 1024, (bf16_t*)(ws + WS_W_FFNIN) + (size_t)l * 5632 * 1024, r, 176, scr, lane); continue; } r -= 2 * I3;
        if (r < 2 * I4) { const int l = r / I4; r -= l * I4; tr_item_plain(p.in[I_WFFNOUT] + (size_t)l * 2816 * 1024, 1024, nullptr, 2816, (bf16_t*)(ws + WS_W_FFNOUT) + (size_t)l * 1024 * 2816, r, 32, scr, lane); continue; } r -= 2 * I4;
        if (r < I5) { FInC f{p.in[I_WINC], p.in[I_NMIX] + 1024}; tr_item(f, 1024, (bf16_t*)(ws + WS_W_INC), r, 32, scr, lane); continue; } r -= I5;
        if (r < I6) { FUq f{p.in[I_WUQ], p.in[I_GQ], 0.07216878364870322f * 1.4426950408889634f}; tr_item(f, 384, (bf16_t*)(ws + WS_W_UQ), r, 48, scr, lane); continue; } r -= I6;
        if (r < I7) { tr_item_plain(p.in[I_WUK], 1024, nullptr, 512, (bf16_t*)(ws + WS_W_UK), r, 32, scr, lane); continue; } r -= I7;
        if (r < I8) { tr_item_plain(p.in[I_WUV], 1024, nullptr, 512, (bf16_t*)(ws + WS_W_UV), r, 32, scr, lane); continue; } r -= I8;
        { tr_item_plain(p.in[I_WOUTC], 1024, nullptr, 1024, (bf16_t*)(ws + WS_W_OUTC), r, 32, scr, lane); }
    }
    if (!(which & 1)) return;
    bf16_t* XB = (bf16_t*)(ws + WS_XB); float* ssp = (float*)(ws + WS_SSP);
    for (int row = gw; row < M; row += NGW) {
        const float* x = row < MP ? p.in[I_XP] + (size_t)row * D : p.in[I_XS] + (size_t)(row - MP) * D;
        float ss = 0.f;
#pragma unroll
        for (int j = 0; j < 4; ++j) { const f32x4 v = __builtin_nontemporal_load((const f32x4*)(x + j * 256 + lane * 4)); ss += (v.x * v.x + v.y * v.y) + (v.z * v.z + v.w * v.w);
            u32x2 w; w.x = cvtpk(v.x, v.y); w.y = cvtpk(v.z, v.w); *(u32x2*)(XB + (size_t)row * D + j * 256 + lane * 4) = w; }
        ss = wave_sum(ss);
        if (lane < 16) ssp[(size_t)row * 16 + lane] = lane == 0 ? ss : 0.f;
    }
    float* rot = (float*)(ws + WS_ROT);
    for (int idx = vb * 512 + tid; idx < NPOS * 32; idx += nvb * 512) {
        const int pi = idx >> 5, i = idx & 31; const double pos = (double)(pi < SEQ ? pi : PAST + (pi - SEQ));
        double fr = 1.0; for (int q = 0; q < i; ++q) fr *= 0.7498942093324559;
        const double ang = pos * fr; const double TWO_PI = 6.283185307179586476925287;
        const double kq = __builtin_rint(ang / TWO_PI); const double r = ang - kq * TWO_PI; const double r2 = r * r;
        double sn = 0.0, cn = 0.0, ts = r, tc = 1.0;
        for (int q = 0; q < 15; ++q) { sn += ts; cn += tc; tc = -tc * r2 / (double)((2 * q + 1) * (2 * q + 2)); ts = -ts * r2 / (double)((2 * q + 2) * (2 * q + 3)); }
        rot[(size_t)idx * 2] = (float)cn; rot[(size_t)idx * 2 + 1] = (float)sn;
    }
}

constexpr int SK = 72;
constexpr int L_QR = 0, L_KR = 9216, L_QD = 18432, L_KD = 27648, L_SC = 36864, L_VT = 46080, L_ST = 64512, L_O = 82944, L_SEG = 116736, L_BREF = 118784, L_BLAST = 119040;
constexpr int OS = 132;

__device__ __forceinline__ bf16x8 ldfrag(const LAS unsigned char* base, int row, int col) { return *(const LAS bf16x8*)(base + (row * SK + col) * 2); }

__device__ __forceinline__ void dla_unit(const Params& p, LAS unsigned char* lds, int u) {
    int tid_ = threadIdx.x; asm volatile("" : "+v"(tid_));
    const int tid = tid_, lane = tid & 63, w = tid >> 6, fr = lane & 15, fq = lane >> 4;
    int mixer, b, h, row0, T, c; const float* s_in; float* s_out;
    if (u < 128) { mixer = u >> 6; b = (u & 63) >> 2; h = u & 3; row0 = b * SEQ; T = SEQ; c = 64; s_in = nullptr;
        s_out = p.out + (mixer ? O_RET_P : O_GLA_P) + (size_t)(b * 4 + h) * 64 * 128; }
    else { const int v = u - 128; mixer = v >> 7; b = (v & 127) >> 2; h = v & 3; row0 = MP + b * DSEQ; T = DSEQ; c = 16;
        s_in = p.in[mixer ? I_SRET : I_SGLA] + (size_t)(b * 4 + h) * 64 * 128;
        s_out = p.out + (mixer ? O_RET_S : O_GLA_S) + (size_t)(b * 4 + h) * 64 * 128; }
    const bf16_t* P = (const bf16_t*)(p.ws + WS_P);
    bf16_t* MIX = (bf16_t*)(p.ws + WS_MIX);
    const int qc = (mixer ? 1536 : 0) + h * 64, kc = (mixer ? 1792 : 256) + h * 64, vc0 = (mixer ? 2048 : 512) + h * 128, gc0 = (mixer ? 2560 : 1024) + h * 128, lac = 3072 + h * 64;
    const float* gn = p.in[mixer ? I_GRET : I_GGLA] + h * 128;
    const float lgam = log1pf(-exp2f(-5.0f - (float)h));
    const int tref = (c - 1) >> 1;
    LAS float* SEG = (LAS float*)(lds + L_SEG); LAS float* BREF = (LAS float*)(lds + L_BREF); LAS float* BLAST = (LAS float*)(lds + L_BLAST);
    LAS float* OL = (LAS float*)(lds + L_O);
    const int kr = w & 3, vt0 = (w >> 2) * 4;
    f32x4 Sacc[4];
#pragma unroll
    for (int i = 0; i < 4; ++i) {
        if (s_in) { for (int j = 0; j < 4; ++j) { const int km = kr * 16 + fq * 4 + j, ko = mixer ? ((km & 1) * 32 + (km >> 1)) : km;
            Sacc[i][j] = s_in[(size_t)ko * 128 + (vt0 + i) * 16 + fr]; } }
        else Sacc[i] = (f32x4){0.f, 0.f, 0.f, 0.f};
    }
    __syncthreads();
#pragma unroll
    for (int i = 0; i < 4; ++i) { u32x2 wv; wv.x = cvtpk(Sacc[i][0], Sacc[i][1]); wv.y = cvtpk(Sacc[i][2], Sacc[i][3]);
        *(LAS u32x2*)(lds + L_ST + (((vt0 + i) * 16 + fr) * SK + kr * 16 + fq * 4) * 2) = wv; }
    const int kcol = lane, seg = w;
    const int nch = T / c;
    unsigned short la_r[8], q_r[8], k_r[8], v_r[16];
    const int vv_ = tid & 127, sg_ = tid >> 7;
#define DLA_LOAD(rr) do { \
        _Pragma("unroll") for (int i = 0; i < 8; ++i) { const int t = seg * 8 + i; const bool ok = t < c; const size_t ro = (size_t)((rr) + (ok ? t : 0)) * NAB; \
            la_r[i] = (ok && !mixer) ? __builtin_nontemporal_load(P + ro + lac + kcol) : (unsigned short)0; q_r[i] = ok ? __builtin_nontemporal_load(P + ro + qc + kcol) : (unsigned short)0; k_r[i] = ok ? __builtin_nontemporal_load(P + ro + kc + kcol) : (unsigned short)0; } \
        _Pragma("unroll") for (int i = 0; i < 16; ++i) { const int s_ = sg_ * 16 + i; v_r[i] = (s_ < c) ? __builtin_nontemporal_load(P + (size_t)((rr) + s_) * NAB + vc0 + vv_) : (unsigned short)0; } } while (0)
    DLA_LOAD(row0);
    float gnv[16];
#pragma unroll
    for (int i = 0; i < 16; ++i) gnv[i] = gn[(tid & 7) * 16 + i];
    for (int n = 0; n < nch; ++n) {
        const int r0 = row0 + n * c;
        float bb[8];
        {
            float run = 0.f;
#pragma unroll
            for (int i = 0; i < 8; ++i) { const int t = seg * 8 + i; float la = 0.f;
                if (t < c) la = mixer ? lgam : bf2f(la_r[i]);
                run += la; bb[i] = run; }
            SEG[seg * 64 + kcol] = run;
        }
        __syncthreads();
        {
            float off = 0.f;
            for (int s = 0; s < seg; ++s) off += SEG[s * 64 + kcol];
#pragma unroll
            for (int i = 0; i < 8; ++i) { bb[i] += off; if (seg * 8 + i == tref) BREF[kcol] = bb[i]; if (seg * 8 + i == 63) BLAST[kcol] = bb[i]; }
        }
        __syncthreads();
        {
            const float bref = BREF[kcol], blast = BLAST[kcol];
            float kd[8];
#pragma unroll
            for (int i = 0; i < 8; ++i) { const int t = seg * 8 + i; const float q = bf2f(q_r[i]), k = bf2f(k_r[i]);
                const float e1 = __expf(bb[i] - bref), e2 = __expf(bref - bb[i]), e3 = __expf(bb[i]), e4 = __expf(blast - bb[i]);
                *(LAS bf16_t*)(lds + L_QR + (t * SK + kcol) * 2) = (bf16_t)(cvtpk(q * e1, 0.f) & 0xffff);
                *(LAS bf16_t*)(lds + L_KR + (t * SK + kcol) * 2) = (bf16_t)(cvtpk(k * e2, 0.f) & 0xffff);
                *(LAS bf16_t*)(lds + L_QD + (t * SK + kcol) * 2) = (bf16_t)(cvtpk(q * e3, 0.f) & 0xffff);
                kd[i] = k * e4; }
            u32x4 wv; wv.x = cvtpk(kd[0], kd[1]); wv.y = cvtpk(kd[2], kd[3]); wv.z = cvtpk(kd[4], kd[5]); wv.w = cvtpk(kd[6], kd[7]);
            *(LAS u32x4*)(lds + L_KD + (kcol * SK + seg * 8) * 2) = wv;
            const int v = tid & 127, sg = tid >> 7;
            float vv[16];
#pragma unroll
            for (int i = 0; i < 16; ++i) vv[i] = bf2f(v_r[i]);
            u32x4 w0, w1; w0.x = cvtpk(vv[0], vv[1]); w0.y = cvtpk(vv[2], vv[3]); w0.z = cvtpk(vv[4], vv[5]); w0.w = cvtpk(vv[6], vv[7]);
            w1.x = cvtpk(vv[8], vv[9]); w1.y = cvtpk(vv[10], vv[11]); w1.z = cvtpk(vv[12], vv[13]); w1.w = cvtpk(vv[14], vv[15]);
            *(LAS u32x4*)(lds + L_VT + (v * SK + sg * 16) * 2) = w0; *(LAS u32x4*)(lds + L_VT + (v * SK + sg * 16 + 8) * 2) = w1;
        }
        if (n + 1 < nch) DLA_LOAD(r0 + c);
        u32x4 gate0, gate1;
        { const int tj = tid >> 3, vsj = (tid & 7) * 16; const size_t rowg = (size_t)(r0 + (tj < c ? tj : 0));
          gate0 = __builtin_nontemporal_load((const u32x4*)(P + rowg * NAB + gc0 + vsj)); gate1 = __builtin_nontemporal_load((const u32x4*)(P + rowg * NAB + gc0 + vsj + 8)); }
        __syncthreads();
        {
            const int tr = w & 3;
#pragma unroll
            for (int e = 0; e < 2; ++e) { const int sc = (w >> 2) * 2 + e; f32x4 a = (f32x4){0.f, 0.f, 0.f, 0.f};
#pragma unroll
                for (int ks = 0; ks < 2; ++ks) a = __builtin_amdgcn_mfma_f32_16x16x32_bf16(ldfrag(lds + L_QR, tr * 16 + fr, ks * 32 + fq * 8), ldfrag(lds + L_KR, sc * 16 + fr, ks * 32 + fq * 8), a, 0, 0, 0);
#pragma unroll
                for (int j = 0; j < 4; ++j) { const int t = tr * 16 + fq * 4 + j, s = sc * 16 + fr; const float val = (s <= t) ? a[j] : 0.f;
                    *(LAS bf16_t*)(lds + L_SC + (t * SK + s) * 2) = (bf16_t)(cvtpk(val, 0.f) & 0xffff); } }
        }
        __syncthreads();
        {
            const int tr = w & 3;
#pragma unroll
            for (int i = 0; i < 4; ++i) { const int vt = vt0 + i; f32x4 a = (f32x4){0.f, 0.f, 0.f, 0.f};
#pragma unroll
                for (int ks = 0; ks < 2; ++ks) {
                    a = __builtin_amdgcn_mfma_f32_16x16x32_bf16(ldfrag(lds + L_SC, tr * 16 + fr, ks * 32 + fq * 8), ldfrag(lds + L_VT, vt * 16 + fr, ks * 32 + fq * 8), a, 0, 0, 0);
                    a = __builtin_amdgcn_mfma_f32_16x16x32_bf16(ldfrag(lds + L_QD, tr * 16 + fr, ks * 32 + fq * 8), ldfrag(lds + L_ST, vt * 16 + fr, ks * 32 + fq * 8), a, 0, 0, 0); }
#pragma unroll
                for (int j = 0; j < 4; ++j) OL[(tr * 16 + fq * 4 + j) * OS + vt * 16 + fr] = a[j]; }
            float dec[4];
#pragma unroll
            for (int j = 0; j < 4; ++j) dec[j] = __expf(BLAST[kr * 16 + fq * 4 + j]);
#pragma unroll
            for (int i = 0; i < 4; ++i) { const int vt = vt0 + i; f32x4 a = Sacc[i];
#pragma unroll
                for (int j = 0; j < 4; ++j) a[j] *= dec[j];
#pragma unroll
                for (int ks = 0; ks < 2; ++ks) a = __builtin_amdgcn_mfma_f32_16x16x32_bf16(ldfrag(lds + L_KD, kr * 16 + fr, ks * 32 + fq * 8), ldfrag(lds + L_VT, vt * 16 + fr, ks * 32 + fq * 8), a, 0, 0, 0);
                Sacc[i] = a; }
        }
        __syncthreads();
#pragma unroll
        for (int i = 0; i < 4; ++i) { u32x2 wv; wv.x = cvtpk(Sacc[i][0], Sacc[i][1]); wv.y = cvtpk(Sacc[i][2], Sacc[i][3]);
            *(LAS u32x2*)(lds + L_ST + (((vt0 + i) * 16 + fr) * SK + kr * 16 + fq * 4) * 2) = wv; }
        {
            const int t = tid >> 3, vs = (tid & 7) * 16;
            float o[16]; float s1 = 0.f, s2 = 0.f;
#pragma unroll
            for (int i = 0; i < 16; ++i) { o[i] = OL[t * OS + vs + i]; s1 += o[i]; s2 += o[i] * o[i]; }
            s1 += __shfl_xor(s1, 1); s1 += __shfl_xor(s1, 2); s1 += __shfl_xor(s1, 4);
            s2 += __shfl_xor(s2, 1); s2 += __shfl_xor(s2, 2); s2 += __shfl_xor(s2, 4);
            float mu = 0.f, rs;
            if (mixer) { mu = s1 * (1.f / 128.f); const float var = fmaxf(s2 * (1.f / 128.f) - mu * mu, 0.f); rs = rsqrtf(var + EPS); }
            else rs = rsqrtf(s2 * (1.f / 128.f) + EPS);
            if (t < c) {
                const size_t rowg = (size_t)(r0 + t);
                const unsigned gw[8] = {gate0.x, gate0.y, gate0.z, gate0.w, gate1.x, gate1.y, gate1.z, gate1.w};
                unsigned ow[8];
#pragma unroll
                for (int i = 0; i < 8; ++i) {
                    const float ga = bflo(gw[i]), gb = bfhi(gw[i]);
                    const float ya = (o[2 * i] - mu) * rs * gnv[2 * i] * (ga / (1.f + __expf(-ga)));
                    const float yb = (o[2 * i + 1] - mu) * rs * gnv[2 * i + 1] * (gb / (1.f + __expf(-gb)));
                    ow[i] = cvtpk(ya, yb); }
                bf16_t* mo = MIX + rowg * D + mixer * 512 + h * 128 + vs;
                *(u32x4*)mo = (u32x4){ow[0], ow[1], ow[2], ow[3]}; *(u32x4*)(mo + 8) = (u32x4){ow[4], ow[5], ow[6], ow[7]};
            }
        }
    }
#pragma unroll
    for (int i = 0; i < 4; ++i)
#pragma unroll
        for (int j = 0; j < 4; ++j) { const int km = kr * 16 + fq * 4 + j, ko = mixer ? ((km & 1) * 32 + (km >> 1)) : km;
            s_out[(size_t)ko * 128 + (vt0 + i) * 16 + fr] = Sacc[i][j]; }
    __syncthreads();
}

constexpr int KST = 200;
constexpr int L_AK = 0, L_AV = 64 * KST * 2;

__device__ __forceinline__ void attn_tile(const LAS unsigned char* lds, int kb, int klim, int fr, int fq, const bf16x8 (&qf)[2][6], f32x4 (&oacc)[8][2], float (&mrun)[2], float (&lrun)[2]) {
#pragma unroll 1
        for (int half = 0; half < 2; ++half) {
            const int kb2 = kb + half * 32;
            if (kb2 >= klim) break;
            const bool first0 = mrun[0] < -1e29f, first1 = mrun[1] < -1e29f;
            const float mref0 = first0 ? 0.f : mrun[0], mref1 = first1 ? 0.f : mrun[1];
            f32x4 s[2][2];
#pragma unroll
            for (int e = 0; e < 2; ++e) {
                s[e][0] = (f32x4){-mref0, -mref0, -mref0, -mref0}; s[e][1] = (f32x4){-mref1, -mref1, -mref1, -mref1};
#pragma unroll
                for (int kg = 0; kg < 2; ++kg) {
                    bf16x8 kfr[3];
#pragma unroll
                    for (int k3 = 0; k3 < 3; ++k3) kfr[k3] = *(const LAS bf16x8*)(lds + L_AK + (((half * 2 + e) * 16 + fr) * KST + (kg * 3 + k3) * 32 + fq * 8) * 2);
                    __builtin_amdgcn_sched_barrier(0);
#pragma unroll
                    for (int k3 = 0; k3 < 3; ++k3) {
                        s[e][0] = __builtin_amdgcn_mfma_f32_16x16x32_bf16(kfr[k3], qf[0][kg * 3 + k3], s[e][0], 0, 0, 0);
                        s[e][1] = __builtin_amdgcn_mfma_f32_16x16x32_bf16(kfr[k3], qf[1][kg * 3 + k3], s[e][1], 0, 0, 0); }
                    __builtin_amdgcn_sched_barrier(0);
                }
            }
            if (kb2 + 32 > klim) {
#pragma unroll
                for (int e = 0; e < 2; ++e)
#pragma unroll
                    for (int j = 0; j < 4; ++j) if (kb2 + e * 16 + fq * 4 + j >= klim) { s[e][0][j] = -1e30f; s[e][1][j] = -1e30f; }
            }
            float dl[2];
#pragma unroll
            for (int qt = 0; qt < 2; ++qt) {
                float mx = fmaxf(fmaxf(fmaxf(s[0][qt][0], s[0][qt][1]), fmaxf(s[0][qt][2], s[0][qt][3])), fmaxf(fmaxf(s[1][qt][0], s[1][qt][1]), fmaxf(s[1][qt][2], s[1][qt][3])));
                mx = fmaxf(mx, __shfl_xor(mx, 16)); mx = fmaxf(mx, __shfl_xor(mx, 32));
                dl[qt] = (qt ? first1 : first0) ? mx : fmaxf(mx, 0.f);
            }
            if (__any(dl[0] != 0.f || dl[1] != 0.f)) {
#pragma unroll
                for (int qt = 0; qt < 2; ++qt) {
                    const float alpha = __builtin_amdgcn_exp2f(-dl[qt]);
                    const float al = (qt ? first1 : first0) ? 0.f : alpha;
                    mrun[qt] = (qt ? mref1 : mref0) + dl[qt];
                    lrun[qt] *= al;
#pragma unroll
                    for (int dt = 0; dt < 8; ++dt) oacc[dt][qt] *= al;
#pragma unroll
                    for (int e = 0; e < 2; ++e)
#pragma unroll
                        for (int j = 0; j < 4; ++j) s[e][qt][j] -= dl[qt];
                }
            }
            bf16x8 pf[2];
#pragma unroll
            for (int qt = 0; qt < 2; ++qt) {
                float ps = 0.f;
#pragma unroll
                for (int e = 0; e < 2; ++e)
#pragma unroll
                    for (int j = 0; j < 4; ++j) { const float ex = __builtin_amdgcn_exp2f(s[e][qt][j]); s[e][qt][j] = ex; ps += ex; }
                lrun[qt] += ps;
                u32x4 wv;
                wv.x = cvtpk(s[0][qt][0], s[0][qt][1]); wv.y = cvtpk(s[0][qt][2], s[0][qt][3]);
                wv.z = cvtpk(s[1][qt][0], s[1][qt][1]); wv.w = cvtpk(s[1][qt][2], s[1][qt][3]);
                pf[qt] = __builtin_bit_cast(bf16x8, wv);
            }
#pragma unroll
            for (int dg = 0; dg < 2; ++dg) {
                u32x2 va0[4], va1[4];
#pragma unroll
                for (int d4 = 0; d4 < 4; ++d4) { const int dt = dg * 4 + d4;
                    va0[d4] = *(const LAS u32x2*)(lds + L_AV + ((dt * 16 + fr) * SK + half * 32 + fq * 4) * 2);
                    va1[d4] = *(const LAS u32x2*)(lds + L_AV + ((dt * 16 + fr) * SK + half * 32 + 16 + fq * 4) * 2); }
                __builtin_amdgcn_sched_barrier(0);
#pragma unroll
                for (int d4 = 0; d4 < 4; ++d4) { const int dt = dg * 4 + d4;
                    const bf16x8 vf = __builtin_bit_cast(bf16x8, (u32x4){va0[d4].x, va0[d4].y, va1[d4].x, va1[d4].y});
                    oacc[dt][0] = __builtin_amdgcn_mfma_f32_16x16x32_bf16(vf, pf[0], oacc[dt][0], 0, 0, 0);
                    oacc[dt][1] = __builtin_amdgcn_mfma_f32_16x16x32_bf16(vf, pf[1], oacc[dt][1], 0, 0, 0); }
                __builtin_amdgcn_sched_barrier(0);
            }
        }
}

__device__ __forceinline__ void attn_unit(const Params& p, LAS unsigned char* lds, int qrow0, int nqv, int kv0, int nkeys_unit, int h, bool causal) {
    int tid_ = threadIdx.x; asm volatile("" : "+v"(tid_));
    const int tid = tid_, lane = tid & 63, w = tid >> 6, fr = lane & 15, fq = lane >> 4;
    const bf16_t* Q = (const bf16_t*)(p.ws + WS_Q); const bf16_t* KN = (const bf16_t*)(p.ws + WS_KN);
    const bf16_t* KRA = (const bf16_t*)(p.ws + WS_KRALL); const bf16_t* VT = (const bf16_t*)(p.ws + WS_VT);
    bf16_t* AO = (bf16_t*)(p.ws + WS_AO);
    const int klim = causal ? 64 * ((w >> 1) + 1) + (nkeys_unit - 256) : nkeys_unit;
    const bool active = (w * 32) < nqv;
    bf16x8 qf[2][6];
#pragma unroll
    for (int qt = 0; qt < 2; ++qt) { int qi = w * 32 + qt * 16 + fr; if (qi >= nqv) qi = 0;
#pragma unroll
        for (int ks = 0; ks < 6; ++ks) qf[qt][ks] = __builtin_nontemporal_load((const bf16x8*)(Q + (size_t)(qrow0 + qi) * 1536 + h * 192 + ks * 32 + fq * 8)); }
    f32x4 oacc[8][2];
#pragma unroll
    for (int dt = 0; dt < 8; ++dt) { oacc[dt][0] = (f32x4){0.f, 0.f, 0.f, 0.f}; oacc[dt][1] = (f32x4){0.f, 0.f, 0.f, 0.f}; }
    float mrun[2] = {-1e30f, -1e30f}, lrun[2] = {0.f, 0.f};
    const int ntile = (nkeys_unit + 63) >> 6;
    u32x4 kregA[3], vregA[2];
#define ATT_LOAD(KR_, VR_, tt) do { const int kb_ = (tt) * 64; \
        _Pragma("unroll") for (int i = 0; i < 3; ++i) { const int ch = tid + i * 512, r = ch / 24, cc = ch % 24; const size_t tok = (size_t)(kv0 + kb_ + r); \
            KR_[i] = (cc < 16) ? *(const u32x4*)(KN + tok * 1024 + h * 128 + cc * 8) : *(const u32x4*)(KRA + tok * 64 + (cc - 16) * 8); } \
        _Pragma("unroll") for (int i = 0; i < 2; ++i) { const int ch = tid + i * 512, r = ch >> 3, cc = ch & 7; \
            VR_[i] = *(const u32x4*)(VT + (size_t)(h * 128 + r) * NKV + kv0 + kb_ + cc * 8); } } while (0)
#define ATT_STORE(KR_, VR_) do { \
        _Pragma("unroll") for (int i = 0; i < 3; ++i) { const int ch = tid + i * 512, r = ch / 24, cc = ch % 24; *(LAS u32x4*)(lds + L_AK + (r * KST + cc * 8) * 2) = KR_[i]; } \
        _Pragma("unroll") for (int i = 0; i < 2; ++i) { const int ch = tid + i * 512, r = ch >> 3, cc = ch & 7; *(LAS u32x4*)(lds + L_AV + (r * SK + cc * 8) * 2) = VR_[i]; } } while (0)
#define ATT_BAR() asm volatile("s_waitcnt lgkmcnt(0)\n\ts_barrier" ::: "memory")
    u32x4 kregB[3], vregB[2];
    ATT_LOAD(kregA, vregA, 0);
    if (ntile > 1) ATT_LOAD(kregB, vregB, 1);
    for (int t = 0; t < ntile; t += 2) {
        ATT_BAR();
        ATT_STORE(kregA, vregA);
        ATT_BAR();
        if (t + 2 < ntile) ATT_LOAD(kregA, vregA, t + 2);
        if (active && t * 64 < klim) attn_tile(lds, t * 64, klim, fr, fq, qf, oacc, mrun, lrun);
        if (t + 1 < ntile) {
            ATT_BAR();
            ATT_STORE(kregB, vregB);
            ATT_BAR();
            if (t + 3 < ntile) ATT_LOAD(kregB, vregB, t + 3);
            if (active && (t + 1) * 64 < klim) attn_tile(lds, (t + 1) * 64, klim, fr, fq, qf, oacc, mrun, lrun);
        }
    }
    if (active) {
#pragma unroll
        for (int qt = 0; qt < 2; ++qt) {
            float l = lrun[qt]; l += __shfl_xor(l, 16); l += __shfl_xor(l, 32);
            const float inv = 1.f / l; const int qi = w * 32 + qt * 16 + fr;
            if (qi < nqv) {
#pragma unroll
                for (int dt = 0; dt < 8; ++dt) { u32x2 wv; wv.x = cvtpk(oacc[dt][qt][0] * inv, oacc[dt][qt][1] * inv); wv.y = cvtpk(oacc[dt][qt][2] * inv, oacc[dt][qt][3] * inv);
                    *(u32x2*)(AO + (size_t)(qrow0 + qi) * D + h * 128 + dt * 16 + fq * 4) = wv; }
            }
        }
    }
    __syncthreads();
}

constexpr int LKS = 584;
constexpr int LVS = 40;
constexpr int LKT = 5 * 512 * 16;
constexpr int L_LK = 0, L_LV = 3 * LKT;
constexpr int KSPLIT = KVS / 4;
__device__ __forceinline__ void attn_latent_unit(const Params& p, LAS unsigned char* lds, int b, int dh, int ks) {
    int tid_ = threadIdx.x; asm volatile("" : "+v"(tid_));
    const int tid = tid_, lane = tid & 63, fr = lane & 15, fq = lane >> 4;
    const int w = __builtin_amdgcn_readfirstlane(tid >> 6);
    const bf16_t* CK = (const bf16_t*)(p.ws + WS_CKVALL); const bf16_t* KRA = (const bf16_t*)(p.ws + WS_KRALL);
    const bf16_t* QL = (const bf16_t*)(p.ws + WS_QL); const bf16_t* Q = (const bf16_t*)(p.ws + WS_Q);
    float* PO = (float*)(p.ws + WS_PO); float* PM = (float*)(p.ws + WS_PM); float* PL = (float*)(p.ws + WS_PL);
    const int kv0 = MP + b * KVS + ks * KSPLIT;
    bf16x8 qf[18];
#pragma unroll
    for (int kq = 0; kq < 16; ++kq) qf[kq] = *(const bf16x8*)(QL + (size_t)(b * 16 + fr) * 4096 + w * 512 + kq * 32 + fq * 8);
#pragma unroll
    for (int kq = 16; kq < 18; ++kq) qf[kq] = *(const bf16x8*)(Q + (size_t)(MP + b * 16 + fr) * 1536 + w * 192 + 128 + (kq - 16) * 32 + fq * 8);
    f32x4 oacc[16];
#pragma unroll
    for (int dt = 0; dt < 16; ++dt) oacc[dt] = (f32x4){0.f, 0.f, 0.f, 0.f};
    float mrun = -1e30f, lrun = 0.f;
    constexpr int NST = (KSPLIT + 31) / 32;
#define LAT_DMA(ss, bufi) do { _Pragma("unroll") for (int i = 0; i < 5; ++i) { const int slot = i * 512 + tid; int r = slot / 73, cc = slot % 73; if (r > 31) { r = 31; cc = 0; } if (cc > 71) cc = 0; \
            const size_t tok = (size_t)(kv0 + (ss) * 32 + r); const bf16_t* src = (cc < 64) ? CK + tok * 512 + cc * 8 : KRA + tok * 64 + (cc - 64) * 8; \
            __builtin_amdgcn_global_load_lds((const unsigned*)src, (LAS unsigned*)(lds + L_LK + (bufi) * LKT + (i * 512 + w * 64) * 16), 16, 0, 0); } } while (0)
    LAT_DMA(0, 0);
    LAT_DMA(1, 1);
    int bufc = 0, bufn = 2;
    for (int st = 0; st < NST; ++st) {
        if (st + 1 < NST) asm volatile("s_waitcnt vmcnt(5) lgkmcnt(0)\n\ts_barrier" ::: "memory");
        else asm volatile("s_waitcnt vmcnt(0) lgkmcnt(0)\n\ts_barrier" ::: "memory");
        if (st + 2 < NST) LAT_DMA(st + 2, bufn);
        const LAS unsigned char* kt = lds + L_LK + bufc * LKT;
#pragma unroll
        for (int ps_ = 0; ps_ < 2; ++ps_) {
            const int r = tid & 31, c32 = (tid >> 5) + ps_ * 16;
            const u32x4 v = *(const LAS u32x4*)(kt + (r * LKS + dh * 256 + c32 * 8) * 2);
            const unsigned ww[4] = {v.x, v.y, v.z, v.w};
#pragma unroll
            for (int e = 0; e < 4; ++e) { *(LAS bf16_t*)(lds + L_LV + ((c32 * 8 + 2 * e) * LVS + r) * 2) = (bf16_t)(ww[e] & 0xffffu); *(LAS bf16_t*)(lds + L_LV + ((c32 * 8 + 2 * e + 1) * LVS + r) * 2) = (bf16_t)(ww[e] >> 16); }
        }
        asm volatile("s_waitcnt lgkmcnt(0)\n\ts_barrier" ::: "memory");
        const int kb = st * 32;
        f32x4 s0 = (f32x4){0.f, 0.f, 0.f, 0.f}, s1 = (f32x4){0.f, 0.f, 0.f, 0.f};
#pragma unroll
        for (int kg = 0; kg < 9; ++kg) {
            bf16x8 k0[2], k1[2];
#pragma unroll
            for (int k3 = 0; k3 < 2; ++k3) { const int kq = kg * 2 + k3;
                k0[k3] = *(const LAS bf16x8*)(kt + (fr * LKS + kq * 32 + fq * 8) * 2);
                k1[k3] = *(const LAS bf16x8*)(kt + ((16 + fr) * LKS + kq * 32 + fq * 8) * 2); }
            __builtin_amdgcn_sched_barrier(0);
#pragma unroll
            for (int k3 = 0; k3 < 2; ++k3) { const int kq = kg * 2 + k3;
                s0 = __builtin_amdgcn_mfma_f32_16x16x32_bf16(k0[k3], qf[kq], s0, 0, 0, 0); s1 = __builtin_amdgcn_mfma_f32_16x16x32_bf16(k1[k3], qf[kq], s1, 0, 0, 0); }
            __builtin_amdgcn_sched_barrier(0);
        }
        if (kb + 32 > KSPLIT) {
#pragma unroll
            for (int j = 0; j < 4; ++j) { if (kb + fq * 4 + j >= KSPLIT) s0[j] = -1e30f; if (kb + 16 + fq * 4 + j >= KSPLIT) s1[j] = -1e30f; }
        }
        float mx = fmaxf(fmaxf(fmaxf(s0[0], s0[1]), fmaxf(s0[2], s0[3])), fmaxf(fmaxf(s1[0], s1[1]), fmaxf(s1[2], s1[3])));
        mx = fmaxf(mx, __shfl_xor(mx, 16)); mx = fmaxf(mx, __shfl_xor(mx, 32));
        const float mnew = fmaxf(mrun, mx), alpha = __builtin_amdgcn_exp2f(mrun - mnew);
        mrun = mnew;
        float ps = 0.f;
#pragma unroll
        for (int j = 0; j < 4; ++j) { s0[j] = __builtin_amdgcn_exp2f(s0[j] - mnew); s1[j] = __builtin_amdgcn_exp2f(s1[j] - mnew); ps += s0[j] + s1[j]; }
        lrun = lrun * alpha + ps;
        u32x4 wv; wv.x = cvtpk(s0[0], s0[1]); wv.y = cvtpk(s0[2], s0[3]); wv.z = cvtpk(s1[0], s1[1]); wv.w = cvtpk(s1[2], s1[3]);
        const bf16x8 pf = __builtin_bit_cast(bf16x8, wv);
#pragma unroll
        for (int dg = 0; dg < 8; ++dg) {
            u32x2 va0[2], va1[2];
#pragma unroll
            for (int d4 = 0; d4 < 2; ++d4) { const int dt = dg * 2 + d4;
                va0[d4] = *(const LAS u32x2*)(lds + L_LV + ((dt * 16 + fr) * LVS + fq * 4) * 2);
                va1[d4] = *(const LAS u32x2*)(lds + L_LV + ((dt * 16 + fr) * LVS + 16 + fq * 4) * 2); }
            __builtin_amdgcn_sched_barrier(0);
#pragma unroll
            for (int d4 = 0; d4 < 2; ++d4) { const int dt = dg * 2 + d4;
                const bf16x8 vf = __builtin_bit_cast(bf16x8, (u32x4){va0[d4].x, va0[d4].y, va1[d4].x, va1[d4].y});
                oacc[dt] = __builtin_amdgcn_mfma_f32_16x16x32_bf16(vf, pf, oacc[dt] * alpha, 0, 0, 0); }
            __builtin_amdgcn_sched_barrier(0);
        }
        bufc = bufc == 2 ? 0 : bufc + 1; bufn = bufn == 2 ? 0 : bufn + 1;
    }
#undef LAT_DMA
    { float l = lrun; l += __shfl_xor(l, 16); l += __shfl_xor(l, 32);
      const size_t prow = (size_t)((b * 4 + ks) * 8 + w) * 16 + fr;
#pragma unroll
      for (int dt = 0; dt < 16; ++dt) *(f32x4*)(PO + prow * 512 + dh * 256 + dt * 16 + fq * 4) = oacc[dt];
      if (dh == 0 && fq == 0) { PM[prow] = mrun; PL[prow] = l; } }
    asm volatile("s_waitcnt vmcnt(0) lgkmcnt(0)\n\ts_barrier" ::: "memory");
}

constexpr int OLS = 520;
__device__ __forceinline__ void attn_latent_combine(const Params& p, LAS unsigned char* lds, int b, int h) {
    int tid_ = threadIdx.x; asm volatile("" : "+v"(tid_));
    const int tid = tid_, lane = tid & 63, w = tid >> 6, fr = lane & 15, fq = lane >> 4;
    const float* PO = (const float*)(p.ws + WS_PO); const float* PM = (const float*)(p.ws + WS_PM); const float* PL = (const float*)(p.ws + WS_PL);
    const bf16_t* WUV = (const bf16_t*)(p.ws + WS_W_UV); bf16_t* AO = (bf16_t*)(p.ws + WS_AO);
    {
        const int t = tid >> 5, d0 = (tid & 31) * 16;
        float mk[4], M_ = -1e30f;
#pragma unroll
        for (int k = 0; k < 4; ++k) { mk[k] = PM[(size_t)((b * 4 + k) * 8 + h) * 16 + t]; M_ = fmaxf(M_, mk[k]); }
        float L_ = 0.f; f32x4 o[4];
#pragma unroll
        for (int i = 0; i < 4; ++i) o[i] = (f32x4){0.f, 0.f, 0.f, 0.f};
#pragma unroll
        for (int k = 0; k < 4; ++k) { const size_t prow = (size_t)((b * 4 + k) * 8 + h) * 16 + t; const float sc = __builtin_amdgcn_exp2f(mk[k] - M_); L_ += sc * PL[prow];
#pragma unroll
            for (int i = 0; i < 4; ++i) o[i] += *(const f32x4*)(PO + prow * 512 + d0 + i * 4) * sc; }
        const float inv = 1.f / L_;
        u32x4 w0, w1; w0.x = cvtpk(o[0].x * inv, o[0].y * inv); w0.y = cvtpk(o[0].z * inv, o[0].w * inv); w0.z = cvtpk(o[1].x * inv, o[1].y * inv); w0.w = cvtpk(o[1].z * inv, o[1].w * inv);
        w1.x = cvtpk(o[2].x * inv, o[2].y * inv); w1.y = cvtpk(o[2].z * inv, o[2].w * inv); w1.z = cvtpk(o[3].x * inv, o[3].y * inv); w1.w = cvtpk(o[3].z * inv, o[3].w * inv);
        *(LAS u32x4*)(lds + (t * OLS + d0) * 2) = w0; *(LAS u32x4*)(lds + (t * OLS + d0 + 8) * 2) = w1;
    }
    __syncthreads();
    {
        f32x4 acc = (f32x4){0.f, 0.f, 0.f, 0.f};
#pragma unroll 4
        for (int kq = 0; kq < 16; ++kq) {
            const bf16x8 a = *(const LAS bf16x8*)(lds + (fr * OLS + kq * 32 + fq * 8) * 2);
            const bf16x8 bb = *(const bf16x8*)(WUV + (size_t)(h * 128 + w * 16 + fr) * 512 + kq * 32 + fq * 8);
            acc = __builtin_amdgcn_mfma_f32_16x16x32_bf16(a, bb, acc, 0, 0, 0);
        }
#pragma unroll
        for (int j = 0; j < 4; ++j) AO[(size_t)(MP + b * 16 + fq * 4 + j) * D + h * 128 + w * 16 + fr] = (bf16_t)(cvtpk(acc[j], 0.f) & 0xffff);
    }
    __syncthreads();
}

__device__ __forceinline__ void unpack8(const u32x4 w, float (&f)[8]) { f[0] = bflo(w.x); f[1] = bfhi(w.x); f[2] = bflo(w.y); f[3] = bfhi(w.y); f[4] = bflo(w.z); f[5] = bfhi(w.z); f[6] = bflo(w.w); f[7] = bfhi(w.w); }
__device__ __forceinline__ void phase_ffn_fix(const Params& p, int layer) {
    const bf16_t* SA = (const bf16_t*)(p.ws + WS_SIDEA); const bf16_t* SB = (const bf16_t*)(p.ws + WS_SIDEB); const bf16_t* SU = (const bf16_t*)(p.ws + WS_SIDEU);
    bf16_t* ACT = (bf16_t*)(p.ws + WS_ACT);
    const float* wd = p.in[I_WDW] + (size_t)layer * 3 * DFF; const float* bd = p.in[I_BDW] + (size_t)layer * DFF;
    constexpr int NCC = DFF / 8;
    int tid_ = threadIdx.x; asm volatile("" : "+v"(tid_));
    for (int item = blockIdx.x * 512 + tid_; item < NBLK * NCC; item += gridDim.x * 512) {
        const int blk = item / NCC, cc = item % NCC, c0 = cc * 8;
        const bool smp = blk >= MP / 64;
        const int row0 = smp ? MP + (blk - MP / 64) * 16 : blk * 64;
        float w0[8], w1[8], w2[8], bi[8], am2[8], am1[8], a0[8], a1[8], u0[8], u1[8];
#pragma unroll
        for (int i = 0; i < 8; ++i) { w0[i] = wd[c0 + i]; w1[i] = wd[DFF + c0 + i]; w2[i] = wd[2 * DFF + c0 + i]; bi[i] = bd[c0 + i]; }
        if (smp) { const float* sc = p.in[I_SCONV] + ((size_t)(layer * 32 + (blk - MP / 64)) * 2) * DFF + c0;
#pragma unroll
            for (int i = 0; i < 8; ++i) { am2[i] = sc[i]; am1[i] = sc[DFF + i]; } }
        else if ((blk & 31) == 0) {
#pragma unroll
            for (int i = 0; i < 8; ++i) { am2[i] = 0.f; am1[i] = 0.f; } }
        else { unpack8(*(const u32x4*)(SA + ((size_t)(blk - 1) * 2) * DFF + c0), am2); unpack8(*(const u32x4*)(SA + ((size_t)(blk - 1) * 2 + 1) * DFF + c0), am1); }
        unpack8(*(const u32x4*)(SB + ((size_t)blk * 2) * DFF + c0), a0); unpack8(*(const u32x4*)(SB + ((size_t)blk * 2 + 1) * DFF + c0), a1);
        unpack8(*(const u32x4*)(SU + ((size_t)blk * 2) * DFF + c0), u0); unpack8(*(const u32x4*)(SU + ((size_t)blk * 2 + 1) * DFF + c0), u1);
        float y0[8], y1[8];
#pragma unroll
        for (int i = 0; i < 8; i += 2) {
            f32x2 c0v, c1v;
            c0v.x = bi[i] + am2[i] * w0[i] + am1[i] * w1[i] + a0[i] * w2[i]; c0v.y = bi[i + 1] + am2[i + 1] * w0[i + 1] + am1[i + 1] * w1[i + 1] + a0[i + 1] * w2[i + 1];
            c1v.x = bi[i] + am1[i] * w0[i] + a0[i] * w1[i] + a1[i] * w2[i]; c1v.y = bi[i + 1] + am1[i + 1] * w0[i + 1] + a0[i + 1] * w1[i + 1] + a1[i + 1] * w2[i + 1];
            const f32x2 g0 = gelu_pk(c0v), g1 = gelu_pk(c1v);
            y0[i] = g0.x * u0[i]; y0[i + 1] = g0.y * u0[i + 1]; y1[i] = g1.x * u1[i]; y1[i + 1] = g1.y * u1[i + 1]; }
        u32x4 o; o.x = cvtpk(y0[0], y0[1]); o.y = cvtpk(y0[2], y0[3]); o.z = cvtpk(y0[4], y0[5]); o.w = cvtpk(y0[6], y0[7]);
        *(u32x4*)(ACT + (size_t)row0 * DFF + c0) = o;
        o.x = cvtpk(y1[0], y1[1]); o.y = cvtpk(y1[2], y1[3]); o.z = cvtpk(y1[4], y1[5]); o.w = cvtpk(y1[6], y1[7]);
        *(u32x4*)(ACT + (size_t)(row0 + 1) * DFF + c0) = o;
        if (smp || (blk & 31) == 31) {
            float l0[8], l1[8];
            unpack8(*(const u32x4*)(SA + ((size_t)blk * 2) * DFF + c0), l0); unpack8(*(const u32x4*)(SA + ((size_t)blk * 2 + 1) * DFF + c0), l1);
            float* co = smp ? p.out + O_CONV_S + ((size_t)(layer * 32 + (blk - MP / 64)) * 2) * DFF + c0
                            : p.out + O_CONV_P + ((size_t)(layer * 16 + (blk >> 5)) * 2) * DFF + c0;
#pragma unroll
            for (int i = 0; i < 8; ++i) { co[i] = l0[i]; co[DFF + i] = l1[i]; }
        }
    }
}

__device__ __forceinline__ void phase_fix(const Params& p, int which, int vb, int nvb) {
    int tid_ = threadIdx.x; asm volatile("" : "+v"(tid_));
    const int tid = tid_, lane = tid & 63, wave = tid >> 6;
    const int gw = vb * 8 + wave, NGW = nvb * 8;
    bf16_t* CKVALL = (bf16_t*)(p.ws + WS_CKVALL); bf16_t* KRALL = (bf16_t*)(p.ws + WS_KRALL);
    const float* ssq = (const float*)(p.ws + WS_SSQ); float* ckv = p.out + O_CKV; const float* gkv = p.in[I_GKV];
    const f32x4 g0 = *(const f32x4*)(gkv + lane * 8), g1 = *(const f32x4*)(gkv + lane * 8 + 4);
    if (which & 1)
    for (int row = gw; row < M; row += NGW) {
        const f32x4* pp = (const f32x4*)(ssq + (size_t)row * 32 + 12);
        const float s = (sum4(pp[0]) + sum4(pp[1])) + (sum4(pp[2]) + sum4(pp[3]));
        const float rs = rsqrtf(s * (1.f / 512.f) + EPS);
        bf16_t* cb = CKVALL + (size_t)kvtok(row) * 512 + lane * 8;
        const u32x4 rw = *(const u32x4*)cb;
        f32x4 a = (f32x4){bflo(rw.x), bfhi(rw.x), bflo(rw.y), bfhi(rw.y)}, b = (f32x4){bflo(rw.z), bfhi(rw.z), bflo(rw.w), bfhi(rw.w)};
        a = a * rs * g0; b = b * rs * g1;
        float* cr = ckv + (size_t)row * 512 + lane * 8;
        __builtin_nontemporal_store(a, (f32x4*)cr); __builtin_nontemporal_store(b, (f32x4*)(cr + 4));
        u32x4 o; o.x = cvtpk(a.x, a.y); o.y = cvtpk(a.z, a.w); o.z = cvtpk(b.x, b.y); o.w = cvtpk(b.z, b.w);
        *(u32x4*)cb = o;
    }
    if (!(which & 2)) return;
    const float* cc = p.in[I_CCKV];
    for (int r = gw; r < 32 * PAST; r += NGW) {
        const int b = r >> 12, s = r & (PAST - 1);
        const f32x4 a = __builtin_nontemporal_load((const f32x4*)(cc + (size_t)r * 512 + lane * 8)), b4 = __builtin_nontemporal_load((const f32x4*)(cc + (size_t)r * 512 + lane * 8 + 4));
        u32x4 o; o.x = cvtpk(a.x, a.y); o.y = cvtpk(a.z, a.w); o.z = cvtpk(b4.x, b4.y); o.w = cvtpk(b4.z, b4.w);
        *(u32x4*)(CKVALL + (size_t)(MP + b * KVS + s) * 512 + lane * 8) = o;
    }
    const float* ck = p.in[I_CKR];
    for (int it = vb * 512 + tid; it < 32 * PAST * 16; it += nvb * 512) {
        const int r = it >> 4, q = it & 15, b = r >> 12, s = r & (PAST - 1);
        const float* src = ck + (size_t)r * 64;
        u32x2 o; o.x = cvtpk(__builtin_nontemporal_load(src + 2 * q), __builtin_nontemporal_load(src + 32 + 2 * q)); o.y = cvtpk(__builtin_nontemporal_load(src + 2 * q + 1), __builtin_nontemporal_load(src + 33 + 2 * q));
        *(u32x2*)(KRALL + (size_t)(MP + b * KVS + s) * 64 + q * 4) = o;
    }
}

__device__ __forceinline__ void phase_final(const Params& p) {
    int tid_ = threadIdx.x; asm volatile("" : "+v"(tid_));
    const int tid = tid_, lane = tid & 63, wave = tid >> 6;
    const int gw = blockIdx.x * 8 + wave, NGW = gridDim.x * 8;
    float* Y = p.out + O_Y; const float* g = p.in[I_NFIN]; const bf16_t* XB = (const bf16_t*)(p.ws + WS_XB); const float* ssp = (const float*)(p.ws + WS_SSP);
    for (int row = gw; row < M; row += NGW) {
        const float rs = rstd_from16(ssp, row);
#pragma unroll
        for (int j = 0; j < 4; ++j) { const u32x2 xb = __builtin_nontemporal_load((const u32x2*)(XB + (size_t)row * D + j * 256 + lane * 4));
            const f32x4 v = (f32x4){bflo(xb.x), bfhi(xb.x), bflo(xb.y), bfhi(xb.y)};
            const f32x4 gg = *(const f32x4*)(g + j * 256 + lane * 4); __builtin_nontemporal_store(v * rs * gg, (f32x4*)(Y + (size_t)row * D + j * 256 + lane * 4)); }
    }
}

__device__ __forceinline__ void skinny_res(const Params& p, LAS unsigned char* lds, const bf16_t* A, const bf16_t* Bt, int K, int job) {
    int tid_ = threadIdx.x; asm volatile("" : "+v"(tid_));
    const int tid = tid_, lane = tid & 63, w = tid >> 6, fr = lane & 15, fq = lane >> 4, rt = w >> 2, ct = w & 3;
    bf16_t* XB = (bf16_t*)(p.ws + WS_XB); float* ssp = (float*)(p.ws + WS_SSP);
    LAS float* red = (LAS float*)lds;
    for (int u = blockIdx.x; u < 256; u += gridDim.x) {
        const int rg = u >> 4, cg = u & 15, row0 = MP + rg * 32 + rt * 16, col0 = cg * 64 + ct * 16;
        const bf16_t* ap = A + (size_t)(row0 + fr) * K + fq * 8;
        const bf16_t* bp = Bt + (size_t)(col0 + fr) * K + fq * 8;
        f32x4 acc0 = (f32x4){0.f, 0.f, 0.f, 0.f}, acc1 = (f32x4){0.f, 0.f, 0.f, 0.f};
        const int nks = K >> 5;
#pragma unroll 4
        for (int ks = 0; ks < nks; ks += 2) {
            const bf16x8 a0 = *(const bf16x8*)(ap + ks * 32), b0 = *(const bf16x8*)(bp + ks * 32);
            const bf16x8 a1 = *(const bf16x8*)(ap + ks * 32 + 32), b1 = *(const bf16x8*)(bp + ks * 32 + 32);
            acc0 = __builtin_amdgcn_mfma_f32_16x16x32_bf16(a0, b0, acc0, 0, 0, 0);
            acc1 = __builtin_amdgcn_mfma_f32_16x16x32_bf16(a1, b1, acc1, 0, 0, 0);
        }
        float ssj[4];
#pragma unroll
        for (int j = 0; j < 4; ++j) {
            const int row = row0 + fq * 4 + j, col = col0 + fr;
            const float x = bf2f(XB[(size_t)row * D + col]) + (acc0[j] + acc1[j]);
            XB[(size_t)row * D + col] = (bf16_t)(cvtpk(x, 0.f) & 0xffff);
            float ss = x * x;
            ss += __shfl_xor(ss, 1); ss += __shfl_xor(ss, 2); ss += __shfl_xor(ss, 4); ss += __shfl_xor(ss, 8);
            ssj[j] = ss;
        }
        __syncthreads();
        if (fr == 0) {
#pragma unroll
            for (int j = 0; j < 4; ++j) red[(rt * 16 + fq * 4 + j) * 4 + ct] = ssj[j];
        }
        __syncthreads();
        if (tid < 32) ssp[(size_t)(MP + rg * 32 + tid) * 16 + cg] = (red[tid * 4] + red[tid * 4 + 1]) + (red[tid * 4 + 2] + red[tid * 4 + 3]);
    }
    __syncthreads();
}

#define XB_TMO      128
#define XB_XCNT(j)  (256  + 64 * (j))
#define XB_XSUB(j)  (1280 + 64 * (j))
#define XB_XGEN(j)  (2304 + 64 * (j))
#define XB_TOP      3328
#define XB_TOPGEN   3392
#define XCD_BAR_WORDS 3456
#define XB_SPIN_CAP (1u << 18)

__device__ __forceinline__ unsigned xb_ld(unsigned* p)              { return __hip_atomic_load(p, __ATOMIC_RELAXED, __HIP_MEMORY_SCOPE_AGENT); }
__device__ __forceinline__ unsigned xb_add(unsigned* p, unsigned v) { return __hip_atomic_fetch_add(p, v, __ATOMIC_RELAXED, __HIP_MEMORY_SCOPE_AGENT); }
__device__ __forceinline__ unsigned xb_xcc_id() { return (unsigned)__builtin_amdgcn_s_getreg((3 << 11) | 20) & 0xFu; }
#define XB_SPIN(cond, bar) do { unsigned _sp = 0; while (cond) { __builtin_amdgcn_s_sleep(1); \
    if ((++_sp & 255u) == 0u) { if (xb_ld(&(bar)[XB_TMO])) break; if (_sp > XB_SPIN_CAP) { atomicAdd(&(bar)[XB_TMO], 1u); break; } } } } while (0)

struct XcdBarrier {
    unsigned* bar; unsigned x;
    volatile LAS unsigned* st;
};

__device__ __forceinline__ XcdBarrier xcd_barrier_post(unsigned* bar, volatile LAS unsigned* st) {
    XcdBarrier b; b.bar = bar; b.x = xb_xcc_id(); b.st = st;
    if (threadIdx.x == 0) (void)xb_add(&bar[XB_XCNT(b.x)], 1u);
    return b;
}
__device__ __forceinline__ void xcd_barrier_complete(unsigned* bar, unsigned x, unsigned& nloc, unsigned& nx) {
    const unsigned G = gridDim.x * gridDim.y * gridDim.z;
    unsigned sum, cnt, mine, sp = 0u;
    for (;;) {
        sum = 0u; cnt = 0u; mine = 0u;
#pragma unroll
        for (unsigned j = 0; j < 16; ++j) { const unsigned c = xb_ld(&bar[XB_XCNT(j)]); sum += c; cnt += (c > 0u) ? 1u : 0u; mine = (j == x) ? c : mine; }
        if (sum == G) break;
        __builtin_amdgcn_s_sleep(1);
        if ((++sp & 255u) == 0u) { if (xb_ld(&bar[XB_TMO])) break; if (sp > XB_SPIN_CAP) { atomicAdd(&bar[XB_TMO], 1u); break; } }
    }
    nloc = mine > 0u ? mine : 1u; nx = cnt > 0u ? cnt : 1u;
}

__device__ __forceinline__ void xcd_barrier(const XcdBarrier& b) {
    asm volatile("s_waitcnt vmcnt(0)" ::: "memory");
    __syncthreads();
    if (threadIdx.x == 0) {
        unsigned* bar = b.bar;
        __builtin_amdgcn_s_waitcnt(0);
        unsigned nloc = b.st[0], nx = b.st[1];
        if (nloc == 0u) { xcd_barrier_complete(bar, b.x, nloc, nx); b.st[0] = nloc; b.st[1] = nx; }
        const unsigned old = xb_add(&bar[XB_XSUB(b.x)], 1u);
        const unsigned gen = old / nloc;
        if (old + 1u == (gen + 1u) * nloc) {
            __builtin_amdgcn_fence(__ATOMIC_RELEASE, "agent");
            asm volatile("s_waitcnt vmcnt(0)" ::: "memory");
            const unsigned og = xb_add(&bar[XB_TOP], 1u);
            const unsigned tg = og / nx;
            if (og + 1u == (tg + 1u) * nx) xb_add(&bar[XB_TOPGEN], 1u);
            else XB_SPIN(xb_ld(&bar[XB_TOPGEN]) == tg, bar);
            __builtin_amdgcn_fence(__ATOMIC_ACQUIRE, "agent");
            xb_add(&bar[XB_XGEN(b.x)], 1u);
            asm volatile("s_waitcnt vmcnt(0)" ::: "memory");
        } else {
            XB_SPIN(xb_ld(&bar[XB_XGEN(b.x)]) == gen, bar);
            __builtin_amdgcn_fence(__ATOMIC_ACQUIRE, "agent");
            asm volatile("s_waitcnt vmcnt(0)" ::: "memory");
        }
    }
    __syncthreads();
}


#ifdef DBG_ZERO
constexpr int NPHASE = 17;
#else
constexpr int NPHASE = 16;
#endif
__global__ void __launch_bounds__(512, 2) mega_fwd(Params pk) {
    extern __shared__ __attribute__((aligned(16))) unsigned char smem[];
    LAS unsigned char* lds = (LAS unsigned char*)smem;
    const int G = gridDim.x, bx = blockIdx.x;
#ifndef PHMASK
#define PHMASK 0x1FFFF
#endif
#define PH(k) ((((PHMASK) >> (k)) & 1) && ph == (k))
#ifndef REPMASK
#define REPMASK 0
#endif
    volatile LAS unsigned* bst = (volatile LAS unsigned*)(lds + LDS_BYTES - 64);
    if (threadIdx.x < 2) bst[threadIdx.x] = 0u;
    __syncthreads();
    XcdBarrier xbar; xbar.bar = (unsigned*)pk.ws; xbar.x = 0; xbar.st = bst;
    if (pk.ph_hi - pk.ph_lo > 1) xbar = xcd_barrier_post((unsigned*)pk.ws, bst);
    bool first = true; int nseam = 0;
#pragma unroll 1
    for (int slot = 2 * pk.ph_lo; slot < 2 * pk.ph_hi; ++slot) {
        const int ph = slot >> 1;
        if ((slot & 1) && !((REPMASK >> ph) & 1)) continue;
        if (!first) { if (pk.ph_lo < 0) cg::this_grid().sync(); else xcd_barrier(xbar); ++nseam; }
        first = false;
        const __attribute__((address_space(4))) char* ka = (const __attribute__((address_space(4))) char*)__builtin_amdgcn_kernarg_segment_ptr();
        asm volatile("" : "+s"(ka));
        const Params& p = *(const Params*)(const char*)ka;
        unsigned char* ws = p.ws;
        bf16_t* XB = (bf16_t*)(ws + WS_XB);
        if (PH(0)) { phase_prologue(p, lds, G == 256 ? 1 : 7, bx, G); if (G != 256) fold_wql(p, bx, G); }
        else if (PH(1) || PH(8) || PH(9)) {
            const bool ql8 = (G == 256);
            int nsub = (ph == 9) ? (ql8 ? 3 : 4) : 1;
            if (ph == 8) nsub = (ql8 && bx < 44) ? 1 : 0;
#pragma unroll 1
            for (int sub = 0; sub < nsub; ++sub) {
                pg8::Gemm g; EpiBf E; E.pp = &p;
                if (ph == 1) { g = pg8::Gemm{XB, (const bf16_t*)(ws + WS_W_INAB), M, NAB, 1024}; E.job = 1; }
                else if ((ph == 8 && bx < 32) || sub == 3) { g = pg8::Gemm{(const bf16_t*)(ws + WS_CQ) + (size_t)MP * 384, (const bf16_t*)(ws + WS_W_QL), MS, 4096, 384}; E.job = 93; }
                else if (ph == 8) { g = pg8::Gemm{(const bf16_t*)(ws + WS_CQ) + (size_t)MP * 384, (const bf16_t*)(ws + WS_W_UQ), MS, 1536, 384}; E.job = 94; }
                else if (sub == 0) { g = pg8::Gemm{(const bf16_t*)(ws + WS_CQ), (const bf16_t*)(ws + WS_W_UQ), ql8 ? MP : M, 1536, 384}; E.job = 90; }
                else if (sub == 1) { g = pg8::Gemm{(const bf16_t*)(ws + WS_CKVALL), (const bf16_t*)(ws + WS_W_UK), MP, 1024, 512}; E.job = 91; }
                else { g = pg8::Gemm{(const bf16_t*)(ws + WS_W_UV), (const bf16_t*)(ws + WS_CKVALL), 1024, MP, 512}; E.job = 92; }
                pg8::StaticOrder S; S.init(g.M, g.N, ph == 8 ? (bx < 32 ? 32 : 12) : G, ph == 8 && bx >= 32 ? bx - 32 : bx);
                pg8::gemm_phase(lds, g, S, E);
            }
            if (ph == 8) { if (!ql8) phase_fix(p, 3, bx, G); else if (bx >= 44) phase_fix(p, 1, bx - 44, G - 44); }
        }
        else if (PH(4) || PH(12)) {
            const int layer = ph == 12;
            { int t_ = threadIdx.x; asm volatile("" : "+v"(t_)); const float* ssp = (const float*)(ws + WS_SSP); float* rsp = (float*)(ws + WS_RS);
              for (int row = bx * 512 + t_; row < M; row += G * 512) rsp[row] = rstd_from16(ssp, row); }
            xcd_barrier(xbar);
            pg8::Gemm g{XB, (const bf16_t*)(ws + WS_W_FFNIN) + (size_t)layer * 5632 * 1024, M, 5632, 1024};
            EpiFfn E{&p, layer};
#ifndef WGM_FFNUP
#define WGM_FFNUP 4
#endif
            pg8::StaticOrder S; S.init(g.M, g.N, G, bx, WGM_FFNUP);
            pg8::gemm_phase(lds, g, S, E);
            if (ph == 4 && G == 256 && bx >= 44) phase_prologue(p, lds, 4, bx - 44, G - 44);
        }
        else if (PH(2)) {
#pragma unroll 1
            for (int u = bx; u < 384; u += G) dla_unit(p, lds, u);
            if (G == 256 && bx >= 128) { __syncthreads(); phase_prologue(p, lds, 2, bx - 128, G - 128); fold_wql(p, bx - 128, G - 128); }
        }
        else if (PH(3) || PH(6) || PH(11) || PH(14)) {
            if (ph == 11) {
#pragma unroll 1
                for (int u = bx; u < 256; u += G) attn_latent_combine(p, lds, u >> 3, u & 7);
                xcd_barrier(xbar);
            }
            pg8::Gemm g; EpiRes E; E.pp = &p; E.job = ph;
            if (ph == 3) { g = pg8::Gemm{(const bf16_t*)(ws + WS_MIX), (const bf16_t*)(ws + WS_W_OUTAB), MP, 1024, 1024}; }
            else if (ph == 11) { g = pg8::Gemm{(const bf16_t*)(ws + WS_AO), (const bf16_t*)(ws + WS_W_OUTC), MP, 1024, 1024}; }
            else { const int layer = ph == 14; g = pg8::Gemm{(const bf16_t*)(ws + WS_ACT), (const bf16_t*)(ws + WS_W_FFNOUT) + (size_t)layer * 1024 * 2816, MP, 1024, 2816}; }
            pg8::StaticOrder S; S.init(g.M, g.N, G, bx);
            pg8::gemm_phase(lds, g, S, E);
            skinny_res(p, lds, g.A, g.Bt, g.K, ph);
        }
        else if (PH(5) || PH(13)) { phase_ffn_fix(p, ph == 13); }
        else if (PH(7)) {
            pg8::Gemm g{XB, (const bf16_t*)(ws + WS_W_INC), M, 1024, 1024}; pg8::StaticOrder S; S.init(M, 1024, G, bx);
            EpiInC E{&p};
            pg8::gemm_phase(lds, g, S, E);
            if (G == 256 && bx >= 8) phase_fix(p, 2, bx - 8, G - 8);
        }
        else if (PH(10)) {
#pragma unroll 1
            for (int u = bx; u < 1280; u += G) {
                const int c = u & 255, i = u >> 8;
                if (i < 4) { const int bh = c >> 1, par = c & 1; const int qb = par ? (i == 0 ? 1 : i == 1 ? 2 : i == 2 ? 5 : 6) : (i == 0 ? 0 : i == 1 ? 3 : i == 2 ? 4 : 7);
                    const int b = bh >> 3, h = bh & 7;
                    attn_unit(p, lds, b * SEQ + qb * 256, 256, b * SEQ, (qb + 1) * 256, h, true); }
                else attn_latent_unit(p, lds, c >> 3, (c >> 2) & 1, c & 3);
            }
        }
        else if (PH(15)) { phase_final(p); }
#ifdef DBG_ZERO
        else if (ph == 16) {
            int tz_ = threadIdx.x; asm volatile("" : "+v"(tz_));
#define DZ(o, lo, hi) if ((DBG_ZERO >> (o)) & 1) { for (size_t i = (size_t)(lo) + (size_t)bx * 512 + tz_; i < (size_t)(hi); i += (size_t)G * 512) p.out[i] = 0.f; }
        DZ(0, 0, (size_t)MP * D) DZ(1, (size_t)MP * D, O_GLA_P) DZ(2, O_GLA_P, O_GLA_S) DZ(3, O_GLA_S, O_RET_P) DZ(4, O_RET_P, O_RET_S) DZ(5, O_RET_S, O_CKV)
        DZ(6, O_CKV, O_CKV + (size_t)MP * 512) DZ(7, O_CKV + (size_t)MP * 512, O_KR) DZ(8, O_KR, O_KR + (size_t)MP * 64) DZ(9, O_KR + (size_t)MP * 64, O_CONV_P)
        DZ(10, O_CONV_P, O_CONV_S) DZ(11, O_CONV_S, O_CONV_S + 2 * 32 * 2 * DFF)
        }
#endif
    }
}

extern "C" void kernel_launch(void* const* d_in, const int* in_sizes, int n_in, void* d_out, int out_size, void* d_ws, size_t ws_size, hipStream_t stream) {
    static int grid = 0;
    if (grid == 0) {
        int dev = 0, cus = 0, per_cu = 0;
        (void)hipGetDevice(&dev);
        (void)hipDeviceGetAttribute(&cus, hipDeviceAttributeMultiprocessorCount, dev);
        (void)hipFuncSetAttribute((const void*)mega_fwd, hipFuncAttributeMaxDynamicSharedMemorySize, LDS_BYTES);
        (void)hipOccupancyMaxActiveBlocksPerMultiprocessor(&per_cu, (const void*)mega_fwd, 512, LDS_BYTES);
        if (per_cu < 1) per_cu = 1;
        grid = cus * per_cu;
        (void)hipGetLastError();
        if (n_in != 27 || ws_size < WS_END) { fprintf(stderr, "kernel_launch: unexpected n_in %d / ws_size %zu\n", n_in, ws_size); }
    }
    Params p{};
    for (int i = 0; i < 27; ++i) p.in[i] = (const float*)d_in[i];
    p.out = (float*)d_out; p.ws = (unsigned char*)d_ws;
#if ONE_LAUNCH
    (void)hipMemsetAsync(d_ws, 0, 16384, stream);
    p.ph_lo = 0; p.ph_hi = NPHASE;
    void* args[] = {&p};
    hipError_t e = hipLaunchCooperativeKernel((const void*)mega_fwd, dim3(grid), dim3(512), args, LDS_BYTES, stream);
    if (e != hipSuccess) fprintf(stderr, "cooperative launch failed: %s (grid %d)\n", hipGetErrorString(e), grid);
#else
    for (int ph = 0; ph < NPHASE; ++ph) {
        p.ph_lo = ph; p.ph_hi = ph + 1;
        hipLaunchKernelGGL(mega_fwd, dim3(grid), dim3(512), LDS_BYTES, stream, p);
    }
#endif
}
```
